# Optimizing an MI355X kernel written in HIP

```python
import jax, jax.numpy as jnp
from jax import lax
import numpy as np

D_MODEL = 2048
BATCH = 16
SEQ = 256
DEPTH = 4
DEC_BATCH = 4
DEC_SEQ = 1024
PAST_LEN = 256

GRID_W = 64
HEAD_DIM = 128
N_Q_HEADS = 8
N_KV_HEADS = 2
N_GROUP = N_Q_HEADS // N_KV_HEADS
ATTN_DIM = N_Q_HEADS * HEAD_DIM
KV_DIM = N_KV_HEADS * HEAD_DIM
Q_BLOCK = 128
ROPE_THETA = 10000.0
ROPE_AXIS_DIM = HEAD_DIM // 2
F_GROUPS = 8
F_GROUP_DIM = 128
F_DIM = F_GROUPS * F_GROUP_DIM
GLA_HEADS = 4
GLA_DK = 128
GLA_DV = 256
GLA_K_DIM = GLA_HEADS * GLA_DK
GLA_V_DIM = GLA_HEADS * GLA_DV
GLA_GATE_RANK = 16
GLA_GATE_TAU = 16.0
GLA_CHUNK = 64
D_FF = 5632
CONV_W = 3
N_MOD = 6
N_BRANCH = 3
EPS = 1e-6

IN_SPLITS = (F_DIM, ATTN_DIM, KV_DIM, KV_DIM, GLA_K_DIM, GLA_K_DIM, GLA_V_DIM, GLA_V_DIM,
             GLA_GATE_RANK, GLA_GATE_RANK, N_BRANCH * D_MODEL)
N_IN = F_DIM + ATTN_DIM + 2 * KV_DIM + 2 * GLA_K_DIM + 2 * GLA_V_DIM + 2 * GLA_GATE_RANK + N_BRANCH * D_MODEL

kernel_name = 'hybrid_fnet_gqa_gla_convffn_diffusion_step'

F32 = jnp.float32


def rms_norm(x, g):
    xf = x.astype(F32)
    y = xf * lax.rsqrt(jnp.mean(xf * xf, axis=-1, keepdims=True) + EPS)
    return (y * g.astype(F32)).astype(x.dtype)


def split_cols(z):
    idx = np.cumsum(np.array(IN_SPLITS))[:-1].tolist()
    return jnp.split(z, idx, axis=-1)


def grid_angles(T):
    rows = T // GRID_W
    row = jnp.repeat(jnp.arange(rows, dtype=F32), GRID_W)
    col = jnp.tile(jnp.arange(GRID_W, dtype=F32), rows)
    inv = ROPE_THETA ** (-jnp.arange(0, ROPE_AXIS_DIM, 2, dtype=F32) / ROPE_AXIS_DIM)
    return row[:, None] * inv, col[:, None] * inv


def _rotate(x, ang):
    cos = jnp.cos(ang)[None, :, None, :]
    sin = jnp.sin(ang)[None, :, None, :]
    x1, x2 = jnp.split(x, 2, axis=-1)
    return jnp.concatenate([x1 * cos - x2 * sin, x2 * cos + x1 * sin], axis=-1)


def axial_rope(x, ang_row, ang_col):
    xf = x.astype(F32)
    out = jnp.concatenate([_rotate(xf[..., :ROPE_AXIS_DIM], ang_row),
                           _rotate(xf[..., ROPE_AXIS_DIM:], ang_col)], axis=-1)
    return out.astype(x.dtype)


def block_attention(q, k, v):
    B, T = q.shape[0], q.shape[1]
    nb = T // Q_BLOCK
    qb = q.reshape(B, nb, Q_BLOCK, N_KV_HEADS, N_GROUP, HEAD_DIM).transpose(1, 0, 2, 3, 4, 5)
    kf = k.astype(F32)
    vf = v.astype(F32)
    scale = HEAD_DIM ** -0.5

    def one_block(qblk):
        s = jnp.einsum('bqkgd,bskd->bkgqs', qblk.astype(F32), kf) * scale
        p = jax.nn.softmax(s, axis=-1)
        return jnp.einsum('bkgqs,bskd->bqkgd', p, vf).astype(q.dtype)

    o = lax.map(one_block, qb)
    return o.transpose(1, 0, 2, 3, 4, 5).reshape(B, T, ATTN_DIM)


def gla_scan(q, k, v, log_a, s0):
    B, T = q.shape[0], q.shape[1]
    nc = T // GLA_CHUNK

    def chunks(a):
        return a.astype(F32).reshape(B, nc, GLA_CHUNK, GLA_HEADS, a.shape[-1]).transpose(1, 0, 3, 2, 4)

    mask = jnp.tril(jnp.ones((GLA_CHUNK, GLA_CHUNK), dtype=bool))

    def step(S, inp):
        qc, kc, vc, ac = inp
        b = jnp.cumsum(ac, axis=2)
        o_inter = jnp.einsum('bhtd,bhdv->bhtv', qc * jnp.exp(b), S)
        diff = b[:, :, :, None, :] - b[:, :, None, :, :]
        dec = jnp.exp(jnp.where(mask[:, :, None], diff, -jnp.inf))
        att = jnp.einsum('bhtd,bhsd,bhtsd->bhts', qc, kc, dec)
        o = o_inter + jnp.einsum('bhts,bhsv->bhtv', att, vc)
        b_last = b[:, :, -1:, :]
        S_new = jnp.exp(b_last[:, :, 0, :])[..., None] * S + jnp.einsum(
            'bhsd,bhsv->bhdv', kc * jnp.exp(b_last - b), vc)
        return S_new, o

    s_fin, o = lax.scan(step, s0.astype(F32), (chunks(q), chunks(k), chunks(v), chunks(log_a)))
    o = o.transpose(1, 0, 3, 2, 4).reshape(B, T, GLA_HEADS, GLA_DV)
    return o, s_fin


def gla_bidirectional(q, k, v, la_f, la_b, sf0, sb0):
    o_f, sf = gla_scan(q, k, v, la_f, sf0)
    o_b, sb = gla_scan(q[:, ::-1], k[:, ::-1], v[:, ::-1], la_b[:, ::-1], sb0)
    return o_f + o_b[:, ::-1], sf, sb


def token_mixers(h, lw, is_latent, ctx_k, ctx_v, sf0, sb0):
    B, T, _ = h.shape
    z = h @ lw['w_in']
    f_in, q, k, v, gq, gk, gv, gr, gaf, gab, gates = split_cols(z)

    fa = f_in.reshape(B, T, F_GROUPS, F_GROUP_DIM).astype(F32)
    fa = jnp.real(jnp.fft.fft2(fa, axes=(1, 3), norm='ortho')).reshape(B, T, F_DIM).astype(h.dtype)
    br_a = fa @ lw['w_fourier']

    q = rms_norm(q.reshape(B, T, N_Q_HEADS, HEAD_DIM), lw['q_norm'])
    k = rms_norm(k.reshape(B, T, N_KV_HEADS, HEAD_DIM), lw['k_norm'])
    v = v.reshape(B, T, N_KV_HEADS, HEAD_DIM)
    if is_latent:
        ang_r, ang_c = grid_angles(T)
        q = axial_rope(q, ang_r, ang_c)
        keys = jnp.concatenate([ctx_k.astype(k.dtype), axial_rope(k, ang_r, ang_c)], axis=1)
        vals = jnp.concatenate([ctx_v.astype(v.dtype), v], axis=1)
    else:
        keys, vals = k, v
    br_b = block_attention(q, keys, vals) @ lw['w_attn']

    gq = gq.reshape(B, T, GLA_HEADS, GLA_DK) * (GLA_DK ** -0.5)
    gk = gk.reshape(B, T, GLA_HEADS, GLA_DK)
    gv = gv.reshape(B, T, GLA_HEADS, GLA_DV)
    la_f = jax.nn.log_sigmoid((gaf @ lw['w_gate_f'] + lw['b_gate_f']).astype(F32)) / GLA_GATE_TAU
    la_b = jax.nn.log_sigmoid((gab @ lw['w_gate_b'] + lw['b_gate_b']).astype(F32)) / GLA_GATE_TAU
    la_f = la_f.reshape(B, T, GLA_HEADS, GLA_DK)
    la_b = la_b.reshape(B, T, GLA_HEADS, GLA_DK)
    o, sf, sb = gla_bidirectional(gq, gk, gv, la_f, la_b, sf0, sb0)
    o = rms_norm(o, lw['gla_norm']).reshape(B, T, GLA_V_DIM).astype(h.dtype) * jax.nn.silu(gr)
    br_c = o @ lw['w_gla']

    g_a, g_b, g_c = jnp.split(gates, N_BRANCH, axis=-1)
    merged = jax.nn.sigmoid(g_a) * br_a + jax.nn.sigmoid(g_b) * br_b + jax.nn.sigmoid(g_c) * br_c
    return merged @ lw['w_out'], k, v, sf, sb


def conv_ffn(h, lw):
    u = h @ lw['w_up']
    up = jnp.pad(u, ((0, 0), (1, 1), (0, 0)))
    cw = lw['conv_w']
    u = up[:, :-2] * cw[0] + up[:, 1:-1] * cw[1] + up[:, 2:] * cw[2] + lw['conv_b']
    g, val = jnp.split(u, 2, axis=-1)
    return (jax.nn.silu(g) * val) @ lw['w_down']


def trunk_layer(x, mod, lw, is_latent, ctx_k, ctx_v, sf0, sb0):
    shift1, scale1, gate1, shift2, scale2, gate2 = jnp.split(mod, N_MOD, axis=-1)
    h = rms_norm(x, lw['norm1']) * (1 + scale1) + shift1
    mix, k, v, sf, sb = token_mixers(h, lw, is_latent, ctx_k, ctx_v, sf0, sb0)
    x = x + gate1 * mix
    h = rms_norm(x, lw['norm2']) * (1 + scale2) + shift2
    x = x + gate2 * conv_ffn(h, lw)
    return x, k, v, sf, sb


def setup_inputs(seed: int = 0) -> dict:
    key = jax.random.key(seed)
    ks = iter(jax.random.split(key, 40))
    nrm = lambda shape, s: jax.random.normal(next(ks), shape, F32) * s
    gain = lambda shape: 1.0 + 0.01 * jax.random.normal(next(ks), shape, F32)
    return {
        'x_prompt': nrm((BATCH, SEQ, D_MODEL), 1.0),
        'x_sample': nrm((DEC_BATCH, DEC_SEQ, D_MODEL), 1.0),
        'cache_k': nrm((DEC_BATCH, DEPTH, PAST_LEN, N_KV_HEADS, HEAD_DIM), 1.0),
        'cache_v': nrm((DEC_BATCH, DEPTH, PAST_LEN, N_KV_HEADS, HEAD_DIM), 1.0),
        'state_gla_fwd': nrm((DEC_BATCH, DEPTH, GLA_HEADS, GLA_DK, GLA_DV), 2.0),
        'state_gla_bwd': nrm((DEC_BATCH, DEPTH, GLA_HEADS, GLA_DK, GLA_DV), 2.0),
        'c': nrm((DEC_BATCH, D_MODEL), 1.0),
        'c_ctx': nrm((D_MODEL,), 1.0),
        'w_ada': nrm((DEPTH, D_MODEL, N_MOD * D_MODEL), 0.5 * D_MODEL ** -0.5),
        'b_ada': nrm((DEPTH, N_MOD * D_MODEL), 0.01),
        'norm1': gain((DEPTH, D_MODEL)),
        'w_in': nrm((DEPTH, D_MODEL, N_IN), D_MODEL ** -0.5),
        'q_norm': gain((DEPTH, HEAD_DIM)),
        'k_norm': gain((DEPTH, HEAD_DIM)),
        'w_fourier': nrm((DEPTH, F_DIM, D_MODEL), F_DIM ** -0.5),
        'w_attn': nrm((DEPTH, ATTN_DIM, D_MODEL), ATTN_DIM ** -0.5),
        'w_gate_f': nrm((DEPTH, GLA_GATE_RANK, GLA_K_DIM), GLA_GATE_RANK ** -0.5),
        'b_gate_f': nrm((DEPTH, GLA_K_DIM), 0.01),
        'w_gate_b': nrm((DEPTH, GLA_GATE_RANK, GLA_K_DIM), GLA_GATE_RANK ** -0.5),
        'b_gate_b': nrm((DEPTH, GLA_K_DIM), 0.01),
        'gla_norm': gain((DEPTH, GLA_DV)),
        'w_gla': nrm((DEPTH, GLA_V_DIM, D_MODEL), GLA_V_DIM ** -0.5),
        'w_out': nrm((DEPTH, D_MODEL, D_MODEL), D_MODEL ** -0.5),
        'norm2': gain((DEPTH, D_MODEL)),
        'w_up': nrm((DEPTH, D_MODEL, 2 * D_FF), D_MODEL ** -0.5),
        'conv_w': nrm((DEPTH, CONV_W, 2 * D_FF), CONV_W ** -0.5),
        'conv_b': nrm((DEPTH, 2 * D_FF), 0.01),
        'w_down': nrm((DEPTH, D_FF, D_MODEL), D_FF ** -0.5),
        'final_norm': gain((D_MODEL,)),
    }


def reference(x_prompt, x_sample, cache_k, cache_v, state_gla_fwd, state_gla_bwd, c, c_ctx,
              w_ada, b_ada, norm1, w_in, q_norm, k_norm, w_fourier, w_attn, w_gate_f, b_gate_f,
              w_gate_b, b_gate_b, gla_norm, w_gla, w_out, norm2, w_up, conv_w, conv_b, w_down,
              final_norm):
    xp = x_prompt
    xs = x_sample
    zero_state = jnp.zeros((xp.shape[0], GLA_HEADS, GLA_DK, GLA_DV), F32)
    new_k, new_v, new_sf, new_sb = [], [], [], []
    for l in range(DEPTH):
        lw = {
            'norm1': norm1[l], 'w_in': w_in[l], 'q_norm': q_norm[l], 'k_norm': k_norm[l],
            'w_fourier': w_fourier[l], 'w_attn': w_attn[l], 'w_gate_f': w_gate_f[l],
            'b_gate_f': b_gate_f[l], 'w_gate_b': w_gate_b[l], 'b_gate_b': b_gate_b[l],
            'gla_norm': gla_norm[l], 'w_gla': w_gla[l], 'w_out': w_out[l], 'norm2': norm2[l],
            'w_up': w_up[l], 'conv_w': conv_w[l], 'conv_b': conv_b[l], 'w_down': w_down[l],
        }
        mod_ctx = (jax.nn.silu(c_ctx) @ w_ada[l] + b_ada[l])[None, None, :]
        xp, k_ctx, v_ctx, sf, sb = trunk_layer(xp, mod_ctx, lw, False, None, None, zero_state, zero_state)
        new_k.append(k_ctx)
        new_v.append(v_ctx)
        new_sf.append(sf.astype(xp.dtype))
        new_sb.append(sb.astype(xp.dtype))
        mod_lat = (jax.nn.silu(c) @ w_ada[l] + b_ada[l])[:, None, :]
        xs, _, _, _, _ = trunk_layer(xs, mod_lat, lw, True, cache_k[:, l], cache_v[:, l],
                                     state_gla_fwd[:, l], state_gla_bwd[:, l])
    y_prompt = rms_norm(xp, final_norm)
    y_sample = rms_norm(xs, final_norm)
    new_cache_k = jnp.stack(new_k, axis=1)
    new_cache_v = jnp.stack(new_v, axis=1)
    new_state_gla_fwd = jnp.stack(new_sf, axis=1)
    new_state_gla_bwd = jnp.stack(new_sb, axis=1)
    return (y_prompt, y_sample, new_cache_k, new_cache_v, new_state_gla_fwd, new_state_gla_bwd)
```

```cpp
#include <hip/hip_runtime.h>
#include <cstdio>
#include <cstdint>

#define GAS __attribute__((address_space(1)))
#define LAS __attribute__((address_space(3)))
typedef unsigned short bf16;
typedef short bf16x8 __attribute__((ext_vector_type(8)));
typedef float f32x4 __attribute__((ext_vector_type(4)));
typedef float f32x2 __attribute__((ext_vector_type(2)));
typedef unsigned u32x4 __attribute__((ext_vector_type(4)));
typedef unsigned u32x2 __attribute__((ext_vector_type(2)));
typedef GAS unsigned gu32;

constexpr int DM = 2048, NTOK = 8192, NCTX = 4096, TC = 256, TL = 1024, BCTX = 16, BLAT = 4, PAST = 256, DEPTH = 4;
constexpr int N_IN = 11808, NZ = 12032;
constexpr int ZF = 0, ZQ = 1024, ZK = 2048, ZV = 2304, ZGQ = 2560, ZGK = 3072, ZGV = 3584, ZGR = 4608, ZGAF = 5632, ZGAB = 5648, ZPAD = 5664, ZGATE = 5888;
constexpr int NUP = 11264, DFF = 5632, NMOD = 12288, KMRG = 4096;
constexpr int NMODV = 5;
constexpr float EPS = 1e-6f;

constexpr size_t MiB = 1u << 20;
constexpr size_t WS_CTL = 0, CTL_ZERO_BYTES = 1 * MiB;
constexpr size_t WS_MOD = 1 * MiB;
constexpr size_t WS_MODP = 2 * MiB;
constexpr size_t WS_DT = 17 * MiB;
constexpr size_t WS_ACTX = 21 * MiB;
constexpr size_t WS_ALAT = 22 * MiB;
constexpr size_t WS_WIN = 26 * MiB;
constexpr size_t WS_WMRG = 214 * MiB;
constexpr size_t WS_WFT = 278 * MiB;
constexpr size_t WS_WOUT = 294 * MiB;
constexpr size_t WS_WUP = 326 * MiB;
constexpr size_t WS_WDN = 502 * MiB;
constexpr size_t WS_X = 590 * MiB;
constexpr size_t WS_H = 654 * MiB;
constexpr size_t WS_Z = 686 * MiB;
constexpr size_t WS_XT = 874 * MiB;
constexpr size_t WS_KC = 890 * MiB, WS_VC = 892 * MiB;
constexpr size_t WS_KL = 894 * MiB, WS_VL = 897 * MiB;
constexpr size_t WS_AM = 900 * MiB;
constexpr size_t WS_OF = 964 * MiB, WS_OB = 996 * MiB;
constexpr size_t WS_MG = 1028 * MiB;
constexpr size_t WS_ACT = 1060 * MiB;
constexpr size_t WS_QN = 1148 * MiB;
constexpr size_t WS_END = 1164 * MiB;
constexpr size_t SZ_WIN = (size_t)NZ * DM * 2, SZ_WMRG = (size_t)DM * KMRG * 2, SZ_WFT = (size_t)DM * 1024 * 2, SZ_WOUT = (size_t)DM * DM * 2, SZ_WUP = (size_t)NUP * DM * 2, SZ_WDN = (size_t)DM * DFF * 2;
static_assert(WS_WIN + 4 * SZ_WIN <= WS_WMRG && WS_WMRG + 4 * SZ_WMRG <= WS_WFT && WS_WFT + 4 * SZ_WFT <= WS_WOUT && WS_WOUT + 4 * SZ_WOUT <= WS_WUP && WS_WUP + 4 * SZ_WUP <= WS_WDN && WS_WDN + 4 * SZ_WDN <= WS_X, "ws map (weights)");
static_assert(WS_Z + (size_t)NTOK * NZ * 2 <= WS_XT && WS_MODP + (size_t)16 * 4 * 5 * NMOD * 4 <= WS_DT && WS_AM + (size_t)NTOK * KMRG * 2 <= WS_OF && WS_ACT + (size_t)NTOK * DFF * 2 <= WS_END, "ws map (activations)");
constexpr int CW_BAR = 4096;

constexpr int LDS_BYTES = 163840;
constexpr int MISC_OFF = LDS_BYTES - 256;
constexpr int NWAVES = 8;

#define RLX_AGENT __ATOMIC_RELAXED, __HIP_MEMORY_SCOPE_AGENT
#define LDS_WAIT() asm volatile("s_waitcnt lgkmcnt(0)" ::: "memory")
#define VM_WAIT() asm volatile("s_waitcnt vmcnt(0)" ::: "memory")
__device__ __forceinline__ unsigned cvt_pk_bf16(float lo, float hi) { unsigned r; asm volatile("v_cvt_pk_bf16_f32 %0, %1, %2" : "=v"(r) : "v"(lo), "v"(hi)); return r; }
__device__ __forceinline__ float bf_lo(unsigned w) { return __builtin_bit_cast(float, w << 16); }
__device__ __forceinline__ float bf_hi(unsigned w) { return __builtin_bit_cast(float, w & 0xffff0000u); }
__device__ __forceinline__ float bf2f(bf16 h) { return __builtin_bit_cast(float, (unsigned)h << 16); }
__device__ __forceinline__ bf16 f2bf(float f) { return (bf16)(cvt_pk_bf16(f, 0.f) & 0xffffu); }
#ifndef MK_F16
#define MK_F16 1
#endif
typedef _Float16 h16x2 __attribute__((ext_vector_type(2)));
typedef _Float16 h16x8 __attribute__((ext_vector_type(8)));
typedef float f32x16_t __attribute__((ext_vector_type(16)));
#if MK_F16
__device__ __forceinline__ unsigned pk_act(float lo, float hi) { h16x2 v; v[0] = (_Float16)lo; v[1] = (_Float16)hi; return __builtin_bit_cast(unsigned, v); }
__device__ __forceinline__ float lo_act(unsigned w) { return (float)__builtin_bit_cast(h16x2, w)[0]; }
__device__ __forceinline__ float hi_act(unsigned w) { return (float)__builtin_bit_cast(h16x2, w)[1]; }
__device__ __forceinline__ float act2f(bf16 h) { return (float)__builtin_bit_cast(_Float16, h); }
__device__ __forceinline__ bf16 f2act(float f) { return __builtin_bit_cast(bf16, (_Float16)f); }
__device__ __forceinline__ f32x4 mma16_act(bf16x8 a, bf16x8 b, f32x4 c) { return __builtin_amdgcn_mfma_f32_16x16x32_f16(__builtin_bit_cast(h16x8, a), __builtin_bit_cast(h16x8, b), c, 0, 0, 0); }
__device__ __forceinline__ f32x16_t mma32_act(bf16x8 a, bf16x8 b, f32x16_t c) { return __builtin_amdgcn_mfma_f32_32x32x16_f16(__builtin_bit_cast(h16x8, a), __builtin_bit_cast(h16x8, b), c, 0, 0, 0); }
#else
__device__ __forceinline__ unsigned pk_act(float lo, float hi) { return cvt_pk_bf16(lo, hi); }
__device__ __forceinline__ float lo_act(unsigned w) { return bf_lo(w); }
__device__ __forceinline__ float hi_act(unsigned w) { return bf_hi(w); }
__device__ __forceinline__ float act2f(bf16 h) { return bf2f(h); }
__device__ __forceinline__ bf16 f2act(float f) { return f2bf(f); }
__device__ __forceinline__ f32x4 mma16_act(bf16x8 a, bf16x8 b, f32x4 c) { return __builtin_amdgcn_mfma_f32_16x16x32_bf16(a, b, c, 0, 0, 0); }
__device__ __forceinline__ f32x16_t mma32_act(bf16x8 a, bf16x8 b, f32x16_t c) { return __builtin_amdgcn_mfma_f32_32x32x16_bf16(a, b, c, 0, 0, 0); }
#endif
template <int M> __device__ __forceinline__ float swz_xor(float v) { return __builtin_bit_cast(float, __builtin_amdgcn_ds_swizzle(__builtin_bit_cast(int, v), (M << 10) | 0x1f)); }
__device__ __forceinline__ float half_sum(float v) { v += swz_xor<1>(v); v += swz_xor<2>(v); v += swz_xor<4>(v); v += swz_xor<8>(v); v += swz_xor<16>(v); return v; }
__device__ __forceinline__ float wave_sum(float v) { v = half_sum(v);
    auto rr = __builtin_amdgcn_permlane32_swap(__float_as_uint(v), __float_as_uint(v), false, false); return __uint_as_float(rr[0]) + __uint_as_float(rr[1]); }
__device__ __forceinline__ float sigmoidf_(float x) { return __builtin_amdgcn_rcpf(1.f + __expf(-x)); }
__device__ __forceinline__ float siluf_(float x) { return x * sigmoidf_(x); }
__device__ __forceinline__ int opaque_tid() { int t = threadIdx.x; asm volatile("" : "+v"(t)); return t; }
__device__ __forceinline__ int mod_row(int r) { return r < NCTX ? 0 : 1 + ((r - NCTX) >> 10); }

namespace pg8 {
#define PG8_LAS __attribute__((address_space(3)))
typedef unsigned short bf16_t;
constexpr int BM = 256, BK = 64, HALF = 128, HTB = HALF * BK * 2  , STAGE_BYTES = 8 * HTB, NXCD = 8, WGM = 8;

__host__ __device__ __forceinline__ int lds_byte(int r, int c) { const int st = (r >> 4) * 2 + (c >> 5), rr = r & 15, cc = c & 31, ob = rr * 64 + cc * 2; return st * 1024 + (ob ^ (((ob >> 9) & 1) << 5)); }
__host__ __device__ __forceinline__ void stage_rc(int b, int& R, int& C) { const int st = b / 1024, sb = b % 1024, swz = sb ^ (((sb >> 9) & 1) << 5); R = (st >> 1) * 16 + swz / 64; C = (st & 1) * 32 + (swz % 64) / 2; }
__host__ __device__ __forceinline__ int perm32(int rho) { const int n = rho >> 4, i = rho & 15; return 8 * (i >> 2) + 4 * n + (i & 3); }

struct Unit { int pm, pn; };
struct Gemm { const bf16_t* A; const bf16_t* Bt; int M, N, K; };

struct StaticOrder {
    int nM, nN, nwg, G, c;
    __host__ __device__ void init(int M, int N, int G_, int c_) { nM = M / BM; nN = N / BM; nwg = nM * nN; G = G_; c = c_; }
    __host__ __device__ bool next(int i, Unit& u) const {
        const long L = (long)i * G + c; if (L >= nwg) return false;
        int wgid = (int)L; { const int q = nwg / NXCD, r = nwg % NXCD, xcd = wgid % NXCD, off = wgid / NXCD; wgid = (xcd < r ? xcd * (q + 1) : r * (q + 1) + (xcd - r) * q) + off; }
        const int nig = WGM * nN, gid = wgid / nig, fm = gid * WGM, gsz = (nM - fm) < WGM ? (nM - fm) : WGM;
        u.pm = fm + ((wgid % nig) % gsz); u.pn = (wgid % nig) / gsz; return true;
    }
    __device__ __forceinline__ void a_ready(const Unit&) const {}
    __device__ __forceinline__ void done(const Unit&) const {}
};

template <class Epi, class Sched, bool ALIGN_EPI = false, bool SP2 = false>
__device__ __forceinline__ void gemm_phase(PG8_LAS unsigned char* lds, const Gemm g, const Sched& S, const Epi& E) {
    const int tid = opaque_tid(), wid = __builtin_amdgcn_readfirstlane(tid >> 6), lane = tid & 63, wr = wid >> 2, wc = wid & 3, fr = lane & 15, fq = lane >> 4;
    const int K = g.K, nt = K / BK;
    unsigned voffA[2], voffB[2];
#pragma unroll
    for (int i = 0; i < 2; ++i) { int R, C; stage_rc(tid * 16 + i * 8192, R, C); const int Rb = Epi::PERM ? ((R & ~31) + perm32(R & 31)) : R;
        voffA[i] = (unsigned)(R * K + C) * 2u; voffB[i] = (unsigned)(Rb * K + C) * 2u; }
    const size_t kstep = (size_t)(BK * 2);
    const size_t hstep = (size_t)HALF * K * 2;
    const size_t tstep = 2 * hstep;
    const unsigned ldsw = (unsigned)wid * 1024u;
    const int aoff = lds_byte(wr * 64 + fr, fq * 8), boff = lds_byte(wc * 32 + fr, fq * 8);
#define PG8_SA(b, h) (((b) * 2 + (h)) * HTB)
#define PG8_SB(b, h) ((4 + (b) * 2 + (h)) * HTB)
#define PG8_STAGE(bufoff, gbase, voff) do { _Pragma("unroll") for (int _i = 0; _i < 2; ++_i) \
        __builtin_amdgcn_global_load_lds((const unsigned*)((const char*)(gbase) + (voff)[_i]), (PG8_LAS unsigned*)(lds + (bufoff) + ldsw + _i * 8192), 16, 0, 0); } while (0)
#define PG8_LDA(dst, b, h) do { _Pragma("unroll") for (int m = 0; m < 4; ++m) _Pragma("unroll") for (int k = 0; k < 2; ++k) dst[m][k] = *(const PG8_LAS bf16x8*)(lds + PG8_SA(b, h) + aoff + m * 2048 + k * 1024); } while (0)
#define PG8_LDB(dst, b, h) do { _Pragma("unroll") for (int n = 0; n < 2; ++n) _Pragma("unroll") for (int k = 0; k < 2; ++k) dst[n][k] = *(const PG8_LAS bf16x8*)(lds + PG8_SB(b, h) + boff + n * 2048 + k * 1024); } while (0)
#define PG8_MMA(ai, bj, At, Bt) do { __builtin_amdgcn_s_setprio(1); _Pragma("unroll") for (int m = 0; m < 4; ++m) _Pragma("unroll") for (int n = 0; n < 2; ++n) _Pragma("unroll") for (int k = 0; k < 2; ++k) \
        acc[ai][bj][m][n] = mma16_act(Bt[n][k], At[m][k], acc[ai][bj][m][n]); __builtin_amdgcn_s_setprio(0); } while (0)
#define PG8_WAIT_V(n) asm volatile("s_waitcnt vmcnt(" #n ")" ::: "memory")
#define PG8_WAIT_L(n) asm volatile("s_waitcnt lgkmcnt(" #n ")" ::: "memory")
#define PG8_BAR __builtin_amdgcn_s_barrier()
#define PG8_SCHED __builtin_amdgcn_sched_barrier(0)
    Unit cur, nxt; int ui = 0;
    if (!S.next(0, cur)) return;
    f32x4 acc[2][2][4][2];
#pragma unroll
    for (int a = 0; a < 2; ++a)
#pragma unroll
        for (int b = 0; b < 2; ++b)
#pragma unroll
            for (int m = 0; m < 4; ++m)
#pragma unroll
                for (int n = 0; n < 2; ++n) acc[a][b][m][n] = (f32x4){0.f, 0.f, 0.f, 0.f};
    bf16x8 At[4][2], B0[2][2], B1[2][2];
    const char* cA = (const char*)g.A + (size_t)cur.pm * tstep; const char* cB = (const char*)g.Bt + (size_t)cur.pn * tstep;
    S.a_ready(cur);
    if constexpr (SP2) {
        PG8_STAGE(PG8_SB(0, 0), cB, voffB); PG8_STAGE(PG8_SB(0, 1), cB + hstep, voffB); PG8_STAGE(PG8_SA(0, 0), cA, voffA); PG8_STAGE(PG8_SA(0, 1), cA + hstep, voffA);
        if (wr == 1) PG8_BAR;
        PG8_WAIT_V(2); PG8_BAR;
        PG8_STAGE(PG8_SB(1, 0), cB + kstep, voffB); PG8_STAGE(PG8_SA(1, 0), cA + kstep, voffA); PG8_STAGE(PG8_SB(1, 1), cB + hstep + kstep, voffB);
        PG8_WAIT_V(6); PG8_BAR;
    } else {
        PG8_STAGE(PG8_SB(0, 0), cB, voffB); PG8_STAGE(PG8_SA(0, 0), cA, voffA); PG8_STAGE(PG8_SB(0, 1), cB + hstep, voffB); PG8_STAGE(PG8_SA(0, 1), cA + hstep, voffA);
        if (wr == 1) PG8_BAR;
        PG8_WAIT_V(4); PG8_BAR;
        PG8_STAGE(PG8_SB(1, 0), cB + kstep, voffB); PG8_STAGE(PG8_SA(1, 0), cA + kstep, voffA); PG8_STAGE(PG8_SB(1, 1), cB + hstep + kstep, voffB);
        PG8_WAIT_V(6); PG8_BAR;
    }
    for (;;) {
        const bool has_next = S.next(ui + 1, nxt);
        const char* nA = has_next ? (const char*)g.A + (size_t)nxt.pm * tstep : cA; const char* nB = has_next ? (const char*)g.Bt + (size_t)nxt.pn * tstep : cB;
#pragma unroll
        for (int sgi = 0; sgi < Epi::NSEG; ++sgi) {
        const int t_beg = sgi == 0 ? 0 : Epi::seg_end(sgi - 1), t_end = sgi == Epi::NSEG - 1 ? nt : Epi::seg_end(sgi);
        for (int t = t_beg; t < t_end; t += 2) {
            const bool last = (t == nt - 2);
            const char* a1 = cA + (size_t)(t + 1) * kstep;
            const char* a2 = last ? nA : cA + (size_t)(t + 2) * kstep; const char* b2 = last ? nB : cB + (size_t)(t + 2) * kstep;
            const char* a3 = a2 + kstep; const char* b3 = b2 + kstep;
            if (last && has_next) S.a_ready(nxt);
            if constexpr (SP2) {
            PG8_LDB(B0, 0, 0); PG8_LDB(B1, 0, 1); PG8_SCHED; PG8_LDA(At, 0, 0); PG8_STAGE(PG8_SA(1, 1), a1 + hstep, voffA);
            PG8_WAIT_V(8); PG8_WAIT_L(0); PG8_BAR; PG8_MMA(0, 0, At, B0); PG8_MMA(0, 1, At, B1); PG8_BAR; PG8_SCHED;
            PG8_LDA(At, 0, 1); PG8_STAGE(PG8_SB(0, 0), b2, voffB); PG8_STAGE(PG8_SB(0, 1), b2 + hstep, voffB); PG8_STAGE(PG8_SA(0, 0), a2, voffA);
            PG8_WAIT_V(8); PG8_WAIT_L(0); PG8_BAR; PG8_MMA(1, 0, At, B0); PG8_MMA(1, 1, At, B1); PG8_BAR; PG8_SCHED;
            PG8_LDB(B0, 1, 0); PG8_LDB(B1, 1, 1); PG8_SCHED; PG8_LDA(At, 1, 0); PG8_STAGE(PG8_SA(0, 1), a2 + hstep, voffA);
            PG8_WAIT_V(8); PG8_WAIT_L(0); PG8_BAR; PG8_MMA(0, 0, At, B0); PG8_MMA(0, 1, At, B1); PG8_BAR; PG8_SCHED;
            PG8_LDA(At, 1, 1); PG8_STAGE(PG8_SB(1, 0), b3, voffB); PG8_STAGE(PG8_SB(1, 1), b3 + hstep, voffB); PG8_STAGE(PG8_SA(1, 0), a3, voffA);
            PG8_WAIT_V(8); PG8_WAIT_L(0); PG8_BAR; PG8_MMA(1, 0, At, B0); PG8_MMA(1, 1, At, B1); PG8_BAR; PG8_SCHED;
            } else {
            PG8_LDB(B0, 0, 0); PG8_SCHED; PG8_LDA(At, 0, 0); PG8_STAGE(PG8_SA(1, 1), a1 + hstep, voffA);
            PG8_WAIT_L(8); PG8_BAR; PG8_WAIT_L(0); PG8_MMA(0, 0, At, B0); PG8_BAR; PG8_SCHED;
            PG8_LDB(B1, 0, 1); PG8_STAGE(PG8_SB(0, 0), b2, voffB);
            PG8_BAR; PG8_WAIT_L(0); PG8_MMA(0, 1, At, B1); PG8_BAR;
            PG8_LDA(At, 0, 1); PG8_STAGE(PG8_SA(0, 0), a2, voffA);
            PG8_BAR; PG8_WAIT_L(0); PG8_MMA(1, 0, At, B0); PG8_BAR; PG8_SCHED;
            PG8_STAGE(PG8_SB(0, 1), b2 + hstep, voffB);
            PG8_WAIT_V(6); PG8_BAR; PG8_MMA(1, 1, At, B1); PG8_BAR;
            PG8_LDB(B0, 1, 0); PG8_SCHED; PG8_LDA(At, 1, 0); PG8_STAGE(PG8_SA(0, 1), a2 + hstep, voffA);
            PG8_WAIT_L(8); PG8_BAR; PG8_WAIT_L(0); PG8_MMA(0, 0, At, B0); PG8_BAR; PG8_SCHED;
            PG8_LDB(B1, 1, 1); PG8_STAGE(PG8_SB(1, 0), b3, voffB);
            PG8_BAR; PG8_WAIT_L(0); PG8_MMA(0, 1, At, B1); PG8_BAR;
            PG8_LDA(At, 1, 1); PG8_STAGE(PG8_SA(1, 0), a3, voffA);
            PG8_BAR; PG8_WAIT_L(0); PG8_MMA(1, 0, At, B0); PG8_BAR; PG8_SCHED;
            PG8_STAGE(PG8_SB(1, 1), b3 + hstep, voffB);
            PG8_WAIT_V(6); PG8_BAR; PG8_MMA(1, 1, At, B1); PG8_BAR;
            }
        }
        if constexpr (Epi::NSEG > 1) { if (sgi < Epi::NSEG - 1) E.mid(acc, cur, sgi, wr, wc, fr, fq); }
        }
        if constexpr (ALIGN_EPI) { if (wr == 0) PG8_BAR; }
        E(acc, cur, wr, wc, fr, fq); S.done(cur);
        if (!has_next) break;
#pragma unroll
        for (int a = 0; a < 2; ++a)
#pragma unroll
            for (int b = 0; b < 2; ++b)
#pragma unroll
                for (int m = 0; m < 4; ++m)
#pragma unroll
                    for (int n = 0; n < 2; ++n) acc[a][b][m][n] = (f32x4){0.f, 0.f, 0.f, 0.f};
        cur = nxt; cA = nA; cB = nB; ++ui;
        if constexpr (ALIGN_EPI) { if (wr == 1) PG8_BAR; }
    }
    PG8_WAIT_V(0);
    if constexpr (!ALIGN_EPI) { if (wr == 0) PG8_BAR; }
    PG8_BAR;
#undef PG8_SA
#undef PG8_SB
#undef PG8_STAGE
#undef PG8_LDA
#undef PG8_LDB
#undef PG8_MMA
#undef PG8_WAIT_V
#undef PG8_WAIT_L
#undef PG8_BAR
#undef PG8_SCHED
}

struct EpiStoreBf16 {
    static constexpr bool PERM = true; static constexpr int NSEG = 1; static constexpr int seg_end(int) { return 0; }
    bf16_t* O; int ldc;
    __device__ __forceinline__ void operator()(f32x4 (&acc)[2][2][4][2], const Unit& u, int wr, int wc, int fr, int fq) const {
        bf16_t* base = O + (size_t)(u.pm * BM + wr * 64 + fr) * ldc + u.pn * BM + wc * 32 + 8 * fq;
#pragma unroll
        for (int ai = 0; ai < 2; ++ai)
#pragma unroll
            for (int m = 0; m < 4; ++m) { bf16_t* rowp = base + (size_t)(ai * HALF + m * 16) * ldc;
#pragma unroll
                for (int bj = 0; bj < 2; ++bj) { const f32x4 v0 = acc[ai][bj][m][0], v1 = acc[ai][bj][m][1];
                    u32x4 w; w.x = pk_act(v0[0], v0[1]); w.y = pk_act(v0[2], v0[3]); w.z = pk_act(v1[0], v1[1]); w.w = pk_act(v1[2], v1[3]);
                    *(u32x4*)(rowp + bj * HALF) = w; } }
    }
};
struct EpiDft {
    static constexpr bool PERM = true; static constexpr int NSEG = 1; static constexpr int seg_end(int) { return 0; }
    bf16_t* AM; int tshift, tokbase;
    __device__ __forceinline__ void operator()(f32x4 (&acc)[2][2][4][2], const Unit& u, int wr, int wc, int fr, int fq) const {
        const int k0 = u.pm * BM, part = k0 >> tshift, kk0 = k0 & ((1 << tshift) - 1), b = u.pn >> 2, ch0 = (u.pn & 3) * BM;
        bf16_t* base = AM + (size_t)(tokbase + (b << tshift) + kk0 + wr * 64 + fr) * KMRG + part * 1024 + ch0 + wc * 32 + 8 * fq;
#pragma unroll
        for (int ai = 0; ai < 2; ++ai)
#pragma unroll
            for (int m = 0; m < 4; ++m) { bf16_t* rowp = base + (size_t)(ai * HALF + m * 16) * KMRG;
#pragma unroll
                for (int bj = 0; bj < 2; ++bj) { const f32x4 v0 = acc[ai][bj][m][0], v1 = acc[ai][bj][m][1];
                    u32x4 w; w.x = pk_act(v0[0], v0[1]); w.y = pk_act(v0[2], v0[3]); w.z = pk_act(v1[0], v1[1]); w.w = pk_act(v1[2], v1[3]);
                    *(u32x4*)(rowp + bj * HALF) = w; } }
    }
};
struct EpiMerged {
    static constexpr bool PERM = true; static constexpr int NSEG = 3; static constexpr int seg_end(int s) { return s == 0 ? 32 : 48; }
    bf16_t* O; const bf16_t* Z;
    __device__ __forceinline__ void scale_by(f32x4 (&acc)[2][2][4][2], const Unit& u, int wr, int wc, int fr, int fq, int gnum, int gden) const {
        int lo_ = fr * NZ + 8 * fq; asm volatile("" : "+v"(lo_));
        const bf16_t* zb = Z + (size_t)(u.pm * BM + wr * 64) * NZ + ZGATE + u.pn * BM + wc * 32 + lo_;
#pragma unroll
        for (int ai = 0; ai < 2; ++ai)
#pragma unroll
            for (int m = 0; m < 4; ++m) { const bf16_t* zr = zb + (size_t)(ai * HALF + m * 16) * NZ;
#pragma unroll
                for (int bj = 0; bj < 2; ++bj) {
                    const u32x4 gn = *(const u32x4*)(zr + gnum * DM + bj * HALF);
                    u32x4 gd = (u32x4){0u, 0u, 0u, 0u}; if (gden >= 0) gd = *(const u32x4*)(zr + gden * DM + bj * HALF);
                    float s[8];
#pragma unroll
                    for (int q = 0; q < 4; ++q) {
                        const float n0 = 1.f + __expf(-lo_act(gn[q])), n1 = 1.f + __expf(-hi_act(gn[q]));
                        float d0 = 1.f, d1 = 1.f; if (gden >= 0) { d0 = 1.f + __expf(-lo_act(gd[q])); d1 = 1.f + __expf(-hi_act(gd[q])); }
                        s[2 * q] = d0 * __builtin_amdgcn_rcpf(n0); s[2 * q + 1] = d1 * __builtin_amdgcn_rcpf(n1); }
                    f32x4 v0 = acc[ai][bj][m][0], v1 = acc[ai][bj][m][1];
                    v0[0] *= s[0]; v0[1] *= s[1]; v0[2] *= s[2]; v0[3] *= s[3]; v1[0] *= s[4]; v1[1] *= s[5]; v1[2] *= s[6]; v1[3] *= s[7];
                    acc[ai][bj][m][0] = v0; acc[ai][bj][m][1] = v1; }
                asm volatile("" ::: "memory"); }
    }
    __device__ __forceinline__ void mid(f32x4 (&acc)[2][2][4][2], const Unit& u, int s, int wr, int wc, int fr, int fq) const {
        if (s == 0) scale_by(acc, u, wr, wc, fr, fq, 0, 1); else scale_by(acc, u, wr, wc, fr, fq, 1, 2);
    }
    __device__ __forceinline__ void operator()(f32x4 (&acc)[2][2][4][2], const Unit& u, int wr, int wc, int fr, int fq) const {
        scale_by(acc, u, wr, wc, fr, fq, 2, -1);
        bf16_t* base = O + (size_t)(u.pm * BM + wr * 64 + fr) * DM + u.pn * BM + wc * 32 + 8 * fq;
#pragma unroll
        for (int ai = 0; ai < 2; ++ai)
#pragma unroll
            for (int m = 0; m < 4; ++m) { bf16_t* rowp = base + (size_t)(ai * HALF + m * 16) * DM;
#pragma unroll
                for (int bj = 0; bj < 2; ++bj) { const f32x4 v0 = acc[ai][bj][m][0], v1 = acc[ai][bj][m][1];
                    u32x4 w; w.x = pk_act(v0[0], v0[1]); w.y = pk_act(v0[2], v0[3]); w.z = pk_act(v1[0], v1[1]); w.w = pk_act(v1[2], v1[3]);
                    *(u32x4*)(rowp + bj * HALF) = w; } }
    }
};
struct EpiResid {
    static constexpr bool PERM = false; static constexpr int NSEG = 1; static constexpr int seg_end(int) { return 0; }
    float* X; const float* gate;
    __device__ __forceinline__ void operator()(f32x4 (&acc)[2][2][4][2], const Unit& u, int wr, int wc, int fr, int fq) const {
        const int col0 = u.pn * BM + wc * 32 + 4 * fq, row0 = u.pm * BM + wr * 64 + fr;
        const float* gp = gate + (size_t)mod_row(u.pm * BM) * NMOD + col0;
        f32x4 gv[2][2];
#pragma unroll
        for (int bj = 0; bj < 2; ++bj)
#pragma unroll
            for (int n = 0; n < 2; ++n) gv[bj][n] = *(const f32x4*)(gp + bj * HALF + n * 16);
#pragma unroll
        for (int ai = 0; ai < 2; ++ai)
#pragma unroll
            for (int m = 0; m < 4; ++m) { float* rowp = X + (size_t)(row0 + ai * HALF + m * 16) * DM + col0;
#pragma unroll
                for (int bj = 0; bj < 2; ++bj)
#pragma unroll
                    for (int n = 0; n < 2; ++n) { f32x4 x = *(const f32x4*)(rowp + bj * HALF + n * 16); x = x + gv[bj][n] * acc[ai][bj][m][n]; *(f32x4*)(rowp + bj * HALF + n * 16) = x; }
                asm volatile("" ::: "memory"); }
    }
};
}

namespace att {
constexpr int D = 128, NW = 8, QBLK = 32, KVBLK = 64;
constexpr float SCALE = 0.088388347648318440f;
constexpr float THR = 8.f;
constexpr int LDQ = 1024, LDK = 256, LDO = KMRG;
constexpr int SHM_V = KVBLK * D * 2, SHM_K = KVBLK * D * 2, SHM_ATTN = 2 * SHM_V + 2 * SHM_K + NW * 64 * 4;
typedef __attribute__((ext_vector_type(4))) short s16x4;
typedef __attribute__((ext_vector_type(16))) float f32x16;
#define KSWZ(row, colB) ((row) * 256 + ((colB) ^ (((row) & 7) << 4)))
#define SBAR() __builtin_amdgcn_sched_barrier(0)
__device__ __forceinline__ int crow(int r, int hi) { return (r & 3) + 8 * (r >> 2) + 4 * hi; }

__device__ __forceinline__ void partialSM(f32x16& p0, f32x16& p1, float& m_reg, float& mn, float& alpha) {
  constexpr float C = SCALE * 1.4426950408889634f;
  float pmax = p0[0];
#pragma unroll
  for (int r = 1; r < 16; ++r) pmax = fmaxf(pmax, p0[r]);
#pragma unroll
  for (int r = 0; r < 16; ++r) pmax = fmaxf(pmax, p1[r]);
  { auto rr = __builtin_amdgcn_permlane32_swap(__float_as_uint(pmax), __float_as_uint(pmax), false, false);
    pmax = fmaxf(__uint_as_float(rr[0]), __uint_as_float(rr[1])); }
  if (__builtin_expect(__all(pmax - m_reg <= THR / SCALE), 1)) { mn = m_reg; alpha = 1.f; }
  else { mn = fmaxf(m_reg, pmax); alpha = __builtin_amdgcn_exp2f((m_reg - mn) * C); m_reg = mn; }
  float mnC = -mn * C;
#pragma unroll
  for (int r = 0; r < 16; ++r) p0[r] = fmaf(p0[r], C, mnC);
#pragma unroll
  for (int r = 0; r < 16; ++r) p1[r] = fmaf(p1[r], C, mnC);
#pragma unroll
  for (int r = 0; r < 16; ++r) p0[r] = __builtin_amdgcn_exp2f(p0[r]);
}
__device__ __forceinline__ void finishSM(f32x16& p0, f32x16& p1, float alpha, float& l_reg, bf16x8& pa0, bf16x8& pa1, bf16x8& pa2, bf16x8& pa3) {
#pragma unroll
  for (int r = 0; r < 16; ++r) p1[r] = __builtin_amdgcn_exp2f(p1[r]);
  float ps = 0;
#pragma unroll
  for (int r = 0; r < 16; ++r) ps += p0[r];
#pragma unroll
  for (int r = 0; r < 16; ++r) ps += p1[r];
  { auto rr = __builtin_amdgcn_permlane32_swap(__float_as_uint(ps), __float_as_uint(ps), false, false);
    ps = __uint_as_float(rr[0]) + __uint_as_float(rr[1]); }
  l_reg = l_reg * alpha + ps;
#define PK4(P, BASE, OUT) do { unsigned a0 = pk_act(P[BASE + 0], P[BASE + 1]), a1 = pk_act(P[BASE + 2], P[BASE + 3]);   \
    unsigned b0 = pk_act(P[BASE + 4], P[BASE + 5]), b1 = pk_act(P[BASE + 6], P[BASE + 7]);                              \
    auto r0 = __builtin_amdgcn_permlane32_swap(a0, b0, false, false); auto r1 = __builtin_amdgcn_permlane32_swap(a1, b1, false, false); \
    u32x4 w = {r0[0], r1[0], r0[1], r1[1]}; OUT = *reinterpret_cast<bf16x8*>(&w); } while (0)
  PK4(p0, 0, pa0); PK4(p0, 8, pa1); PK4(p1, 0, pa2); PK4(p1, 8, pa3);
#undef PK4
}
__device__ __forceinline__ void qkt(f32x16& p0, f32x16& p1, const LAS char* Ks, const bf16x8* qr, int r32, int hi) {
  p0 = f32x16{}; p1 = f32x16{};
#pragma unroll
  for (int d0 = 0; d0 < 8; ++d0) { int cb = (d0 * 16 + hi * 8) * 2;
    bf16x8 b0 = *reinterpret_cast<const LAS bf16x8*>(Ks + KSWZ(r32, cb));
    bf16x8 b1 = *reinterpret_cast<const LAS bf16x8*>(Ks + KSWZ(32 + r32, cb));
    p0 = mma32_act(b0, qr[d0], p0);
    p1 = mma32_act(b1, qr[d0], p1); }
}
__device__ __forceinline__ int v_st(int k, int c) { const int kk = (k & ~0xC) | ((k & 4) << 1) | ((k & 8) >> 1); return ((kk >> 3) * 4 + (c >> 5)) * 512 + ((kk & 7) * 32 + (c & 31)) * 2; }
__device__ __forceinline__ int v_rd_base(int lane) { return ((lane & 3) << 3) | (((lane >> 2) & 3) << 6) | (((lane >> 4) & 1) << 5) | (((lane >> 5) & 1) << 8); }
constexpr int v_rd_off(int d0, int ks, int half) { return d0 * 512 + ks * 4096 + half * 2048; }
template <int OFF> __device__ __forceinline__ s16x4 tr_read(int vb) {
  s16x4 r; asm volatile("ds_read_b64_tr_b16 %0, %1 offset:%2" : "=&v"(r) : "v"(vb), "i"(OFF) : "memory"); return r;
}
template <int D0> __device__ __forceinline__ void pv_one(f32x16& od, int vb, bf16x8 pa0, bf16x8 pa1, bf16x8 pa2, bf16x8 pa3) {
  const s16x4 l0 = tr_read<v_rd_off(D0, 0, 0)>(vb), h0 = tr_read<v_rd_off(D0, 0, 1)>(vb), l1 = tr_read<v_rd_off(D0, 1, 0)>(vb), h1 = tr_read<v_rd_off(D0, 1, 1)>(vb);
  const s16x4 l2 = tr_read<v_rd_off(D0, 2, 0)>(vb), h2 = tr_read<v_rd_off(D0, 2, 1)>(vb), l3 = tr_read<v_rd_off(D0, 3, 0)>(vb), h3 = tr_read<v_rd_off(D0, 3, 1)>(vb);
  asm volatile("s_waitcnt lgkmcnt(0)" ::: "memory"); SBAR();
#define PK(L, H) (bf16x8){L[0], L[1], L[2], L[3], H[0], H[1], H[2], H[3]}
  od = mma32_act(pa0, PK(l0, h0), od);
  od = mma32_act(pa1, PK(l1, h1), od);
  od = mma32_act(pa2, PK(l2, h2), od);
  od = mma32_act(pa3, PK(l3, h3), od);
#undef PK
}
__device__ __forceinline__ void pv_d0(f32x16* o, int vb, bf16x8 pa0, bf16x8 pa1, bf16x8 pa2, bf16x8 pa3) {
  pv_one<0>(o[0], vb, pa0, pa1, pa2, pa3); pv_one<1>(o[1], vb, pa0, pa1, pa2, pa3); pv_one<2>(o[2], vb, pa0, pa1, pa2, pa3); pv_one<3>(o[3], vb, pa0, pa1, pa2, pa3);
}

__device__ __forceinline__ void attn_dense_body(const bf16* __restrict__ Qb, const bf16* __restrict__ Kh, const bf16* __restrict__ Vh,
                                                bf16* __restrict__ Ob, int seq, LAS char* lds) {
  const int tid = opaque_tid(), wid = tid >> 6, lane = tid & 63, r32 = lane & 31, hi = lane >> 5;
  LAS char* V_lds = lds; LAS char* K_lds = lds + 2 * SHM_V;
  LAS float* ws = (LAS float*)(lds + 2 * SHM_V + 2 * SHM_K) + wid * 64; LAS float* li_l = ws; LAS float* al_l = ws + 32;
  float m_reg = -1e30f, l_reg = 0; f32x16 o[4] = {}; bf16x8 qr[8];
  { const bf16* Qw = Qb + (long)(wid * QBLK + r32) * LDQ + hi * 8;
#pragma unroll
    for (int d0 = 0; d0 < 8; ++d0) qr[d0] = *reinterpret_cast<const bf16x8*>(Qw + d0 * 16); }
  const int sr = tid >> 4, sc = (tid & 15) * 8, vst0 = v_st(sr, sc), vst1 = v_st(32 + sr, sc);
  const int vb0 = (int)(unsigned)(uintptr_t)V_lds + v_rd_base(lane);
  struct { bf16x8 vs0, vs1, ks0, ks1; } sr_[2];
#define SLOAD(i, k0) do { sr_[i].vs0 = *reinterpret_cast<const bf16x8*>(&Vh[(long)((k0) + sr) * LDK + sc]); sr_[i].vs1 = *reinterpret_cast<const bf16x8*>(&Vh[(long)((k0) + 32 + sr) * LDK + sc]); \
    sr_[i].ks0 = *reinterpret_cast<const bf16x8*>(&Kh[(long)((k0) + sr) * LDK + sc]); sr_[i].ks1 = *reinterpret_cast<const bf16x8*>(&Kh[(long)((k0) + 32 + sr) * LDK + sc]); } while (0)
#define SWRITE(b, i) do { *(LAS bf16x8*)(V_lds + (b) * SHM_V + vst0) = sr_[i].vs0;          \
    *(LAS bf16x8*)(V_lds + (b) * SHM_V + vst1) = sr_[i].vs1; int kc = sc * 2;               \
    *(LAS bf16x8*)(K_lds + (b) * SHM_K + KSWZ(sr, kc)) = sr_[i].ks0;                       \
    *(LAS bf16x8*)(K_lds + (b) * SHM_K + KSWZ(32 + sr, kc)) = sr_[i].ks1; } while (0)
#define SWAIT() asm volatile("s_waitcnt vmcnt(4)" ::: "memory")
#define RESC(a) do { if (__any((a) < 1.f)) { if (hi == 0) al_l[r32] = (a); asm volatile("s_waitcnt lgkmcnt(0)" ::: "memory"); \
    _Pragma("unroll") for (int d = 0; d < 4; ++d) _Pragma("unroll") for (int r = 0; r < 16; ++r) o[d][r] *= al_l[crow(r, hi)]; } } while (0)
  f32x16 pA0, pA1, pB0, pB1; float mnA, mnB, alA, alB; bf16x8 pa0, pa1, pa2, pa3; const int NT = seq / KVBLK;
  constexpr int SE = 0, SO = 1;
  SLOAD(SE, 0); asm volatile("s_waitcnt vmcnt(0)" ::: "memory"); SWRITE(0, SE); __syncthreads();
  qkt(pA0, pA1, K_lds, qr, r32, hi); partialSM(pA0, pA1, m_reg, mnA, alA);
  SLOAD(SO, KVBLK); if (2 < NT) SLOAD(SE, 2 * KVBLK);
  SWAIT(); SWRITE(1, SO); __syncthreads();
  for (int j = 1; j + 1 < NT; j += 2) {
    SBAR(); qkt(pB0, pB1, K_lds + SHM_K, qr, r32, hi);
    finishSM(pA0, pA1, alA, l_reg, pa0, pa1, pa2, pa3); SBAR();
    SLOAD(SO, (j + 2) * KVBLK); SBAR();
    pv_d0(o, vb0, pa0, pa1, pa2, pa3); partialSM(pB0, pB1, m_reg, mnB, alB);
    __syncthreads(); SWAIT(); SWRITE(0, SE);
    RESC(alB); __syncthreads();
    SBAR(); qkt(pA0, pA1, K_lds, qr, r32, hi);
    finishSM(pB0, pB1, alB, l_reg, pa0, pa1, pa2, pa3); SBAR();
    if (j + 3 < NT) SLOAD(SE, (j + 3) * KVBLK); SBAR();
    pv_d0(o, vb0 + (int)SHM_V, pa0, pa1, pa2, pa3); partialSM(pA0, pA1, m_reg, mnA, alA);
    __syncthreads(); SWAIT(); SWRITE(1, SO);
    RESC(alA); __syncthreads();
  }
  SBAR(); qkt(pB0, pB1, K_lds + SHM_K, qr, r32, hi);
  finishSM(pA0, pA1, alA, l_reg, pa0, pa1, pa2, pa3); SBAR();
  pv_d0(o, vb0, pa0, pa1, pa2, pa3); partialSM(pB0, pB1, m_reg, mnB, alB);
  __syncthreads(); RESC(alB);
  finishSM(pB0, pB1, alB, l_reg, pa0, pa1, pa2, pa3); SBAR();
  pv_d0(o, vb0 + (int)SHM_V, pa0, pa1, pa2, pa3);
  if (hi == 0) li_l[r32] = l_reg; asm volatile("s_waitcnt lgkmcnt(0)" ::: "memory");
  float rli[16];
#pragma unroll
  for (int r = 0; r < 16; ++r) rli[r] = __builtin_amdgcn_rcpf(li_l[crow(r, hi)]);
  bf16* Ow = Ob + (long)(wid * QBLK) * LDO;
#pragma unroll
  for (int r = 0; r < 16; ++r) { int orow = crow(r, hi);
#pragma unroll
    for (int d0 = 0; d0 < 4; ++d0) Ow[(long)orow * LDO + d0 * 32 + r32] = f2act(o[d0][r] * rli[r]); }
  __syncthreads();
#undef SLOAD
#undef SWRITE
#undef SWAIT
#undef RESC
}
#undef KSWZ
#undef SBAR
}

namespace gla {
constexpr int L_LA = 0;
constexpr int L_TOT = L_LA + 64 * 132 * 4;
constexpr int L_EB = L_TOT + 2048;
constexpr int L_WG = L_EB + 512;
constexpr int L_BG = L_WG + 8192;
constexpr int L_QE = L_BG + 512;
constexpr int L_KE = L_QE + 64 * 136 * 2;
constexpr int L_SB = L_KE + 64 * 136 * 2;
constexpr int L_KLT = L_SB + 64 * 136 * 2;
constexpr int L_VT = L_KLT + 128 * 72 * 2;
constexpr int L_ATT = L_VT + 64 * 72 * 2;
constexpr int L_END = L_ATT + 64 * 72 * 2;
static_assert(L_END <= MISC_OFF, "GLA LDS map");

__device__ __forceinline__ float log_sigmoid(float x) { return fminf(x, 0.f) - __logf(1.f + __expf(-fabsf(x))); }
__device__ __forceinline__ f32x4 mma16(bf16x8 a, bf16x8 b, f32x4 c) { return __builtin_amdgcn_mfma_f32_16x16x32_bf16(a, b, c, 0, 0, 0); }

__device__ __forceinline__ void gla_item(LAS unsigned char* lds, const bf16* __restrict__ Z, float* __restrict__ OUT, const float* __restrict__ wg, const float* __restrict__ bg,
                                         const float* __restrict__ st_in, float* __restrict__ st_out, int T, int tokbase, int h, int dir, int dvq) {
    const int tid = opaque_tid(), lane = tid & 63, w = __builtin_amdgcn_readfirstlane(tid >> 6), fr = lane & 15, fq = lane >> 4;
    LAS float* LA = (LAS float*)(lds + L_LA); LAS float* TOT = (LAS float*)(lds + L_TOT); LAS float* EB = (LAS float*)(lds + L_EB);
    LAS float* WG = (LAS float*)(lds + L_WG); LAS float* BG = (LAS float*)(lds + L_BG);
    LAS unsigned char* QE = lds + L_QE; LAS unsigned char* KE = lds + L_KE; LAS unsigned char* SB = lds + L_SB;
    LAS unsigned char* KLT = lds + L_KLT; LAS unsigned char* VT = lds + L_VT; LAS unsigned char* ATT = lds + L_ATT;
    const int NC = T >> 6;
    for (int idx = tid; idx < 16 * 128; idx += 512) WG[idx] = wg[(idx >> 7) * 512 + (idx & 127)];
    if (tid < 128) BG[tid] = bg[tid];
    f32x4 S[4];
    const int soff = (16 * w + 4 * fq) * 256 + dvq * 64 + fr;
#pragma unroll
    for (int n = 0; n < 4; ++n) S[n] = (f32x4){0.f, 0.f, 0.f, 0.f};
    if (st_in) {
#pragma unroll
        for (int n = 0; n < 4; ++n)
#pragma unroll
            for (int r = 0; r < 4; ++r) S[n][r] = st_in[soff + r * 256 + n * 16];
    }
    const int i0 = tid >> 4, g8 = tid & 15;
    const int iv = tid >> 3, vg = tid & 7;
    const int gacol = dir ? ZGAB : ZGAF;
    u32x4 rq[2], rk[2], rga[2][2], rv;
#define GLA_ROW(c, i) ((size_t)(tokbase + (dir ? (T - 1 - ((c) * 64 + (i))) : ((c) * 64 + (i)))))
#define GLA_LOAD(c) do { _Pragma("unroll") for (int e = 0; e < 2; ++e) { const bf16* zr = Z + GLA_ROW(c, i0 + 32 * e) * NZ; \
        rq[e] = *(const u32x4*)(zr + ZGQ + h * 128 + g8 * 8); rk[e] = *(const u32x4*)(zr + ZGK + h * 128 + g8 * 8); \
        rga[e][0] = *(const u32x4*)(zr + gacol); rga[e][1] = *(const u32x4*)(zr + gacol + 8); } \
        rv = *(const u32x4*)(Z + GLA_ROW(c, iv) * NZ + ZGV + h * 256 + dvq * 64 + vg * 8); } while (0)
    GLA_LOAD(0);
    __syncthreads();
    for (int c = 0; c < NC; ++c) {
#pragma unroll
        for (int e = 0; e < 2; ++e) {
            float x[8];
            { const f32x4 b0 = *(const LAS f32x4*)(BG + g8 * 8), b1 = *(const LAS f32x4*)(BG + g8 * 8 + 4);
#pragma unroll
              for (int j = 0; j < 4; ++j) { x[j] = b0[j]; x[4 + j] = b1[j]; } }
#pragma unroll
            for (int r = 0; r < 16; ++r) { const unsigned wd = rga[e][r >> 3][(r & 7) >> 1]; const float gar = (r & 1) ? hi_act(wd) : lo_act(wd);
                const f32x4 w0 = *(const LAS f32x4*)(WG + r * 128 + g8 * 8), w1 = *(const LAS f32x4*)(WG + r * 128 + g8 * 8 + 4);
#pragma unroll
                for (int j = 0; j < 4; ++j) { x[j] = fmaf(gar, w0[j], x[j]); x[4 + j] = fmaf(gar, w1[j], x[4 + j]); }
                if (r & 1) asm volatile("" ::: "memory"); }
            f32x4 o0, o1;
#pragma unroll
            for (int j = 0; j < 4; ++j) { o0[j] = log_sigmoid(x[j]) * 0.0625f; o1[j] = log_sigmoid(x[4 + j]) * 0.0625f; }
            *(LAS f32x4*)(LA + (i0 + 32 * e) * 132 + g8 * 8) = o0; *(LAS f32x4*)(LA + (i0 + 32 * e) * 132 + g8 * 8 + 4) = o1;
        }
        __syncthreads();
        { const int d = tid & 127, seg = tid >> 7; float run = 0.f;
#pragma unroll
          for (int ii = 0; ii < 16; ++ii) { run += LA[(seg * 16 + ii) * 132 + d]; LA[(seg * 16 + ii) * 132 + d] = run; }
          TOT[seg * 128 + d] = run; }
        __syncthreads();
        {
            float t0[8], t1[8], t2[8], t3[8];
            { const f32x4 a0 = *(const LAS f32x4*)(TOT + g8 * 8), a1 = *(const LAS f32x4*)(TOT + g8 * 8 + 4), b0 = *(const LAS f32x4*)(TOT + 128 + g8 * 8), b1 = *(const LAS f32x4*)(TOT + 128 + g8 * 8 + 4);
              const f32x4 c0 = *(const LAS f32x4*)(TOT + 256 + g8 * 8), c1 = *(const LAS f32x4*)(TOT + 256 + g8 * 8 + 4), d0 = *(const LAS f32x4*)(TOT + 384 + g8 * 8), d1 = *(const LAS f32x4*)(TOT + 384 + g8 * 8 + 4);
#pragma unroll
              for (int j = 0; j < 4; ++j) { t0[j] = a0[j]; t0[4 + j] = a1[j]; t1[j] = b0[j]; t1[4 + j] = b1[j]; t2[j] = c0[j]; t2[4 + j] = c1[j]; t3[j] = d0[j]; t3[4 + j] = d1[j]; } }
            float blast[8];
#pragma unroll
            for (int j = 0; j < 8; ++j) blast[j] = (t0[j] + t1[j]) + (t2[j] + t3[j]);
            if (tid < 16) {
#pragma unroll
                for (int j = 0; j < 8; ++j) EB[g8 * 8 + j] = __expf(blast[j]); }
#pragma unroll
            for (int e = 0; e < 2; ++e) {
                const int i = i0 + 32 * e, seg = i >> 4;
                const f32x4 l0 = *(const LAS f32x4*)(LA + i * 132 + g8 * 8), l1 = *(const LAS f32x4*)(LA + i * 132 + g8 * 8 + 4);
                float bq[8], kl[8], qe[8], ke[8], qv[8], kv[8];
#pragma unroll
                for (int q = 0; q < 4; ++q) { qv[2 * q] = lo_act(rq[e][q]); qv[2 * q + 1] = hi_act(rq[e][q]); kv[2 * q] = lo_act(rk[e][q]); kv[2 * q + 1] = hi_act(rk[e][q]); }
#pragma unroll
                for (int j = 0; j < 8; ++j) { float off = 0.f; if (seg > 0) off += t0[j]; if (seg > 1) off += t1[j]; if (seg > 2) off += t2[j];
                    bq[j] = (j < 4 ? l0[j] : l1[j - 4]) + off;
                    qe[j] = qv[j] * 0.088388347648318440f * __expf(bq[j]); ke[j] = kv[j] * __expf(-bq[j]); kl[j] = kv[j] * __expf(blast[j] - bq[j]); }
                u32x4 wq = {cvt_pk_bf16(qe[0], qe[1]), cvt_pk_bf16(qe[2], qe[3]), cvt_pk_bf16(qe[4], qe[5]), cvt_pk_bf16(qe[6], qe[7])};
                u32x4 wk = {cvt_pk_bf16(ke[0], ke[1]), cvt_pk_bf16(ke[2], ke[3]), cvt_pk_bf16(ke[4], ke[5]), cvt_pk_bf16(ke[6], ke[7])};
                *(LAS u32x4*)(QE + i * 272 + g8 * 16) = wq; *(LAS u32x4*)(KE + i * 272 + g8 * 16) = wk;
#pragma unroll
                for (int j = 0; j < 8; ++j) *(LAS bf16*)(KLT + (g8 * 8 + j) * 144 + i * 2) = f2bf(kl[j]);
            }
#pragma unroll
            for (int q = 0; q < 4; ++q) { *(LAS bf16*)(VT + (vg * 8 + 2 * q) * 144 + iv * 2) = f2bf(lo_act(rv[q])); *(LAS bf16*)(VT + (vg * 8 + 2 * q + 1) * 144 + iv * 2) = f2bf(hi_act(rv[q])); }
#pragma unroll
            for (int n = 0; n < 4; ++n) { u32x2 ws2 = {cvt_pk_bf16(S[n][0], S[n][1]), cvt_pk_bf16(S[n][2], S[n][3])}; *(LAS u32x2*)(SB + (n * 16 + fr) * 272 + (16 * w + 4 * fq) * 2) = ws2; }
        }
        if (c + 1 < NC) GLA_LOAD(c + 1);
        __syncthreads();
        { const int ti = w >> 1;
#pragma unroll
          for (int jj = 0; jj < 2; ++jj) { const int tj = (w & 1) * 2 + jj; f32x4 a = {0.f, 0.f, 0.f, 0.f};
              if (tj <= ti) {
#pragma unroll
                  for (int ks = 0; ks < 4; ++ks) { const bf16x8 af = *(const LAS bf16x8*)(QE + (ti * 16 + fr) * 272 + (ks * 32 + fq * 8) * 2), bfr = *(const LAS bf16x8*)(KE + (tj * 16 + fr) * 272 + (ks * 32 + fq * 8) * 2);
                      a = mma16(af, bfr, a); } }
#pragma unroll
              for (int r = 0; r < 4; ++r) { const int i = ti * 16 + 4 * fq + r, j = tj * 16 + fr; *(LAS bf16*)(ATT + i * 144 + j * 2) = f2bf(j <= i ? a[r] : 0.f); } } }
        __syncthreads();
        { const int ti = w >> 1;
#pragma unroll
          for (int jj = 0; jj < 2; ++jj) { const int tn = (w & 1) * 2 + jj; f32x4 a = {0.f, 0.f, 0.f, 0.f};
#pragma unroll
              for (int ks = 0; ks < 4; ++ks) { const bf16x8 af = *(const LAS bf16x8*)(QE + (ti * 16 + fr) * 272 + (ks * 32 + fq * 8) * 2), bfr = *(const LAS bf16x8*)(SB + (tn * 16 + fr) * 272 + (ks * 32 + fq * 8) * 2);
                  a = mma16(af, bfr, a); }
#pragma unroll
              for (int ks = 0; ks < 2; ++ks) { const bf16x8 af = *(const LAS bf16x8*)(ATT + (ti * 16 + fr) * 144 + (ks * 32 + fq * 8) * 2), bfr = *(const LAS bf16x8*)(VT + (tn * 16 + fr) * 144 + (ks * 32 + fq * 8) * 2);
                  a = mma16(af, bfr, a); }
#pragma unroll
              for (int r = 0; r < 4; ++r) { const int i = ti * 16 + 4 * fq + r; OUT[GLA_ROW(c, i) * 1024 + h * 256 + dvq * 64 + tn * 16 + fr] = a[r]; } } }
        { const f32x4 eb = *(const LAS f32x4*)(EB + 16 * w + 4 * fq);
#pragma unroll
          for (int n = 0; n < 4; ++n) { S[n] = S[n] * eb;
#pragma unroll
              for (int ks = 0; ks < 2; ++ks) { const bf16x8 af = *(const LAS bf16x8*)(KLT + (16 * w + fr) * 144 + (ks * 32 + fq * 8) * 2), bfr = *(const LAS bf16x8*)(VT + (n * 16 + fr) * 144 + (ks * 32 + fq * 8) * 2);
                  S[n] = mma16(af, bfr, S[n]); } } }
    }
    if (st_out) {
        int fr2 = fr; asm volatile("" : "+v"(fr2));
        const int soff2 = (16 * w + 4 * fq) * 256 + dvq * 64 + fr2;
#pragma unroll
        for (int n = 0; n < 4; ++n)
#pragma unroll
            for (int r = 0; r < 4; ++r) {
#ifdef MK_PROBE_SSCALE
                st_out[soff2 + r * 256 + n * 16] = S[n][r] * MK_PROBE_SSCALE;
#else
                st_out[soff2 + r * 256 + n * 16] = S[n][r];
#endif
            }
    }
    __syncthreads();
#undef GLA_ROW
#undef GLA_LOAD
}
}

#define XB_TMO      128
#define XB_XCNT(j)  (256  + 64 * (j))
#define XB_XSUB(j)  (1280 + 64 * (j))
#define XB_XGEN(j)  (2304 + 64 * (j))
#define XB_TOP      3328
#define XB_TOPGEN   3392
#define XCD_BAR_WORDS 3456
#define XB_SPIN_CAP (1u << 18)
__device__ __forceinline__ unsigned xb_ld(unsigned* p)              { return __hip_atomic_load(p, __ATOMIC_RELAXED, __HIP_MEMORY_SCOPE_AGENT); }
__device__ __forceinline__ unsigned xb_add(unsigned* p, unsigned v) { return __hip_atomic_fetch_add(p, v, __ATOMIC_RELAXED, __HIP_MEMORY_SCOPE_AGENT); }
__device__ __forceinline__ unsigned xb_xcc_id() { return (unsigned)__builtin_amdgcn_s_getreg((3 << 11) | 20) & 0xFu; }
#define XB_SPIN(cond, bar) do { unsigned _sp = 0; while (cond) { __builtin_amdgcn_s_sleep(1); \
    if ((++_sp & 255u) == 0u) { if (xb_ld(&(bar)[XB_TMO])) break; if (_sp > XB_SPIN_CAP) { atomicAdd(&(bar)[XB_TMO], 1u); break; } } } } while (0)
struct XcdBarrier { unsigned* bar; unsigned x; volatile LAS unsigned* st; };
__device__ __forceinline__ XcdBarrier xcd_barrier_post(unsigned* bar, volatile LAS unsigned* st) {
    XcdBarrier b; b.bar = bar; b.x = xb_xcc_id(); b.st = st;
    if (threadIdx.x == 0) (void)xb_add(&bar[XB_XCNT(b.x)], 1u);
    return b;
}
__device__ __forceinline__ void xcd_barrier_complete(unsigned* bar, unsigned x, unsigned& nloc, unsigned& nx) {
    const unsigned G = gridDim.x * gridDim.y * gridDim.z;
    unsigned sum, cnt, mine, sp = 0u;
    for (;;) {
        sum = 0u; cnt = 0u; mine = 0u;
#pragma unroll
        for (unsigned j = 0; j < 16; ++j) { const unsigned c = xb_ld(&bar[XB_XCNT(j)]); sum += c; cnt += (c > 0u) ? 1u : 0u; mine = (j == x) ? c : mine; }
        if (sum == G) break;
        __builtin_amdgcn_s_sleep(1);
        if ((++sp & 255u) == 0u) { if (xb_ld(&bar[XB_TMO])) break; if (sp > XB_SPIN_CAP) { atomicAdd(&bar[XB_TMO], 1u); break; } }
    }
    nloc = mine > 0u ? mine : 1u; nx = cnt > 0u ? cnt : 1u;
}
__device__ __forceinline__ void xcd_barrier(const XcdBarrier& b) {
    asm volatile("s_waitcnt vmcnt(0)" ::: "memory");
    __syncthreads();
    if (threadIdx.x == 0) {
        unsigned* bar = b.bar;
        __builtin_amdgcn_s_waitcnt(0);
        unsigned nloc = b.st[0], nx = b.st[1];
        if (nloc == 0u) { xcd_barrier_complete(bar, b.x, nloc, nx); b.st[0] = nloc; b.st[1] = nx; }
        const unsigned old = xb_add(&bar[XB_XSUB(b.x)], 1u);
        const unsigned gen = old / nloc;
        if (old + 1u == (gen + 1u) * nloc) {
            __builtin_amdgcn_fence(__ATOMIC_RELEASE, "agent");
            asm volatile("s_waitcnt vmcnt(0)" ::: "memory");
            const unsigned og = xb_add(&bar[XB_TOP], 1u);
            const unsigned tg = og / nx;
            if (og + 1u == (tg + 1u) * nx) xb_add(&bar[XB_TOPGEN], 1u);
            else XB_SPIN(xb_ld(&bar[XB_TOPGEN]) == tg, bar);
            __builtin_amdgcn_fence(__ATOMIC_ACQUIRE, "agent");
            xb_add(&bar[XB_XGEN(b.x)], 1u);
            asm volatile("s_waitcnt vmcnt(0)" ::: "memory");
        } else {
            XB_SPIN(xb_ld(&bar[XB_XGEN(b.x)]) == gen, bar);
            __builtin_amdgcn_fence(__ATOMIC_ACQUIRE, "agent");
            asm volatile("s_waitcnt vmcnt(0)" ::: "memory");
        }
    }
    __syncthreads();
}

struct Args {
    const float *x_prompt, *x_sample, *cache_k, *cache_v, *state_f, *state_b, *cvec, *c_ctx, *w_ada, *b_ada, *norm1, *w_in, *q_norm, *k_norm, *w_fourier, *w_attn,
                *w_gate_f, *b_gate_f, *w_gate_b, *b_gate_b, *gla_norm, *w_gla, *w_out, *norm2, *w_up, *conv_w, *conv_b, *w_down, *final_norm;
    float* out; unsigned char* ws;
    int s_lo, s_hi, li, pad;
};
constexpr size_t OUT_YP = 0, OUT_YS = (size_t)NCTX * DM, OUT_CK = (size_t)NTOK * DM, OUT_CV = OUT_CK + (size_t)BCTX * DEPTH * TC * 256,
                 OUT_SF = OUT_CV + (size_t)BCTX * DEPTH * TC * 256, OUT_SB = OUT_SF + (size_t)BCTX * DEPTH * 4 * 128 * 256, OUT_END = OUT_SB + (size_t)BCTX * DEPTH * 4 * 128 * 256;

struct Frame { LAS unsigned char* lds; int tid, lane, wave, G, bid; };
__device__ __forceinline__ Frame frame_now(LAS unsigned char* lds) {
    Frame F; F.lds = lds; F.tid = opaque_tid(); F.lane = F.tid & 63; F.wave = __builtin_amdgcn_readfirstlane(F.tid >> 6); F.G = gridDim.x; F.bid = blockIdx.x; return F; }

__device__ __forceinline__ void transpose_item(const float* __restrict__ W, int N, bf16* __restrict__ WT, int ldd, int koff, int kb, int nb, int row_shift_from, int row_shift, LAS unsigned char* scr, int lane) {
    const int k0 = kb * 128, n0 = nb * 32, c4 = lane & 7, kr = lane >> 3;
#pragma unroll 4
    for (int i = 0; i < 16; ++i) { const int k = 8 * i + kr; const f32x4 v = *(const f32x4*)(W + (size_t)(k0 + k) * N + n0 + 4 * c4);
#pragma unroll
        for (int j = 0; j < 4; ++j) *(LAS bf16*)(scr + (4 * c4 + j) * 272 + k * 2) = f2act(v[j]); }
    LDS_WAIT(); asm volatile("" ::: "memory");
    const int kc = lane & 15;
#pragma unroll
    for (int j = 0; j < 8; ++j) { const int n = (lane >> 4) + 4 * j; const u32x4 o = *(const LAS u32x4*)(scr + n * 272 + kc * 16);
        int row = n0 + n; if (row >= row_shift_from) row += row_shift;
        *(u32x4*)(WT + (size_t)row * ldd + koff + k0 + kc * 8) = o; }
    LDS_WAIT(); asm volatile("" ::: "memory");
}
constexpr int TI_IN = 16 * 369, TI_F = 8 * 64, TI_AT = 8 * 64, TI_GL = 8 * 64, TI_OUT = 16 * 64, TI_UP = 16 * 352, TI_DN = 44 * 64;
constexpr int TI_LAYER = TI_IN + TI_F + TI_AT + TI_GL + TI_OUT + TI_UP + TI_DN;

__device__ __forceinline__ void phase_prologue_a(LAS unsigned char* lds_, const Args& a) {
    const Frame F = frame_now(lds_);
    unsigned char* ws = a.ws;
    {
        LAS unsigned char* scr = F.lds + F.wave * 8704;
        const int gw = F.bid * NWAVES + F.wave, NGW = F.G * NWAVES;
        for (int it = gw; it < DEPTH * TI_LAYER; it += NGW) {
            const int l = it / TI_LAYER; int r = it - l * TI_LAYER;
            if (r < TI_IN) { transpose_item(a.w_in + (size_t)l * DM * N_IN, N_IN, (bf16*)(ws + WS_WIN + l * SZ_WIN), DM, 0, r / 369, r % 369, ZPAD, ZGATE - ZPAD, scr, F.lane); continue; } r -= TI_IN;
            if (r < TI_F) { transpose_item(a.w_fourier + (size_t)l * 1024 * DM, DM, (bf16*)(ws + WS_WFT + l * SZ_WFT), 1024, 0, r / 64, r % 64, 1 << 30, 0, scr, F.lane); continue; } r -= TI_F;
            if (r < TI_AT) { transpose_item(a.w_attn + (size_t)l * 1024 * DM, DM, (bf16*)(ws + WS_WMRG + l * SZ_WMRG), KMRG, 2048, r / 64, r % 64, 1 << 30, 0, scr, F.lane); continue; } r -= TI_AT;
            if (r < TI_GL) { transpose_item(a.w_gla + (size_t)l * 1024 * DM, DM, (bf16*)(ws + WS_WMRG + l * SZ_WMRG), KMRG, 3072, r / 64, r % 64, 1 << 30, 0, scr, F.lane); continue; } r -= TI_GL;
            if (r < TI_OUT) { transpose_item(a.w_out + (size_t)l * DM * DM, DM, (bf16*)(ws + WS_WOUT + l * SZ_WOUT), DM, 0, r / 64, r % 64, 1 << 30, 0, scr, F.lane); continue; } r -= TI_OUT;
            if (r < TI_UP) { transpose_item(a.w_up + (size_t)l * DM * NUP, NUP, (bf16*)(ws + WS_WUP + l * SZ_WUP), DM, 0, r / 352, r % 352, 1 << 30, 0, scr, F.lane); continue; } r -= TI_UP;
            transpose_item(a.w_down + (size_t)l * DFF * DM, DM, (bf16*)(ws + WS_WDN + l * SZ_WDN), DFF, 0, r / 64, r % 64, 1 << 30, 0, scr, F.lane);
        }
    }
    const size_t gt = (size_t)F.bid * 512 + F.tid, NGT = (size_t)F.G * 512;
    for (size_t i = gt; i < (size_t)DEPTH * (ZGATE - ZPAD) * DM / 8; i += NGT) { const size_t l = i / ((ZGATE - ZPAD) * DM / 8), r = i % ((ZGATE - ZPAD) * DM / 8);
        *(u32x4*)(ws + WS_WIN + l * SZ_WIN + (size_t)ZPAD * DM * 2 + r * 16) = (u32x4){0u, 0u, 0u, 0u}; }
    for (size_t i = gt; i < (size_t)2048 * 1024; i += NGT) {
        const int kp = (int)(i >> 10), j = (int)(i & 1023), cs = kp >> 10, g = (kp >> 7) & 7, c = kp & 127, g2 = j >> 7, jj = j & 127; float v = 0.f;
        if (g == g2) { const int m = (c * jj) & 127; const float ang = (float)m * (1.f / 128.f); v = (cs ? -sinpif(2.f * ang) : cospif(2.f * ang)) * 0.088388347648318440f; }
        ((bf16*)(ws + WS_DT))[i] = f2act(v); }
    for (size_t i = gt; i < (size_t)512 * 256; i += NGT) { const int kp = (int)(i >> 8), t = (int)(i & 255), cs = kp >> 8, k = kp & 255, m = (k * t) & 255; const float ang = (float)m * (1.f / 256.f);
        ((bf16*)(ws + WS_ACTX))[i] = f2act((cs ? sinpif(2.f * ang) : cospif(2.f * ang)) * 0.0625f); }
    for (size_t i = gt; i < (size_t)2048 * 1024; i += NGT) { const int kp = (int)(i >> 10), t = (int)(i & 1023), cs = kp >> 10, k = kp & 1023, m = (k * t) & 1023; const float ang = (float)m * (1.f / 1024.f);
        ((bf16*)(ws + WS_ALAT))[i] = f2act((cs ? sinpif(2.f * ang) : cospif(2.f * ang)) * 0.03125f); }
    __syncthreads();
    {
        LAS float* SC = (LAS float*)F.lds;
        for (int i = F.tid; i < NMODV * DM; i += 512) { const int j = i >> 11, k = i & 2047; const float cv = j == 0 ? a.c_ctx[k] : a.cvec[(j - 1) * DM + k]; SC[i] = siluf_(cv); }
        __syncthreads();
        float* MP = (float*)(ws + WS_MODP);
        for (int u = F.bid; u < DEPTH * 16 * 6; u += F.G) {
            const int l = u / 96, kc = (u % 96) / 6, nb = u % 6, n = nb * 2048 + F.tid * 4;
            f32x4 acc[NMODV];
#pragma unroll
            for (int j = 0; j < NMODV; ++j) acc[j] = (f32x4){0.f, 0.f, 0.f, 0.f};
            const float* wp = a.w_ada + ((size_t)l * DM + kc * 128) * NMOD + n;
#pragma unroll 8
            for (int k = 0; k < 128; ++k) { const f32x4 wv = *(const f32x4*)(wp + (size_t)k * NMOD);
#pragma unroll
                for (int j = 0; j < NMODV; ++j) acc[j] = acc[j] + wv * SC[j * DM + kc * 128 + k]; }
#pragma unroll
            for (int j = 0; j < NMODV; ++j) *(f32x4*)(MP + (((size_t)kc * DEPTH + l) * NMODV + j) * NMOD + n) = acc[j];
        }
        __syncthreads();
    }
}
__device__ __forceinline__ void phase_mod_reduce(LAS unsigned char* lds_, const Args& a) {
    const Frame F = frame_now(lds_);
    const float* MP = (const float*)(a.ws + WS_MODP); float* MOD = (float*)(a.ws + WS_MOD);
    for (size_t i = (size_t)F.bid * 512 + F.tid; i < (size_t)DEPTH * NMODV * NMOD / 4; i += (size_t)F.G * 512) {
        const size_t e = i * 4; const int n = (int)(e % NMOD), l = (int)(e / ((size_t)NMODV * NMOD));
        f32x4 s = *(const f32x4*)(a.b_ada + (size_t)l * NMOD + n);
#pragma unroll
        for (int kc = 0; kc < 16; ++kc) s = s + *(const f32x4*)(MP + (size_t)kc * DEPTH * NMODV * NMOD + e);
        *(f32x4*)(MOD + e) = s; }
}

__device__ __forceinline__ void phase_norm(LAS unsigned char* lds_, const Args& a, int l, int which, bool first) {
    const Frame F = frame_now(lds_);
    const float* MOD = (const float*)(a.ws + WS_MOD) + (size_t)l * NMODV * NMOD + (which ? 3 * DM : 0);
    const float* wn = (which ? a.norm2 : a.norm1) + (size_t)l * DM;
    float* X = (float*)(a.ws + WS_X); bf16* H = (bf16*)(a.ws + WS_H);
    const int gw = F.bid * NWAVES + F.wave, NGW = F.G * NWAVES;
    for (int r = gw; r < NTOK; r += NGW) {
        const float* src = first ? (r < NCTX ? a.x_prompt + (size_t)r * DM : a.x_sample + (size_t)(r - NCTX) * DM) : X + (size_t)r * DM;
        f32x4 v[8]; float ss = 0.f;
#pragma unroll
        for (int j = 0; j < 8; ++j) { v[j] = *(const f32x4*)(src + 4 * F.lane + 256 * j); ss += (v[j][0] * v[j][0] + v[j][1] * v[j][1]) + (v[j][2] * v[j][2] + v[j][3] * v[j][3]); }
        if (first) {
#pragma unroll
            for (int j = 0; j < 8; ++j) *(f32x4*)(X + (size_t)r * DM + 4 * F.lane + 256 * j) = v[j]; }
        const float rstd = rsqrtf(wave_sum(ss) * (1.f / DM) + EPS);
        const float* mr = MOD + (size_t)mod_row(r) * NMOD;
#pragma unroll
        for (int j = 0; j < 8; ++j) { const int c = 4 * F.lane + 256 * j; const f32x4 w4 = *(const f32x4*)(wn + c), sh = *(const f32x4*)(mr + c), sc = *(const f32x4*)(mr + DM + c);
            const f32x4 hval = v[j] * rstd * w4 * (sc + 1.f) + sh;
            u32x2 o = {pk_act(hval[0], hval[1]), pk_act(hval[2], hval[3])}; *(u32x2*)(H + (size_t)r * DM + c) = o; }
    }
}
__device__ __forceinline__ void phase_final_norm(LAS unsigned char* lds_, const Args& a) {
    const Frame F = frame_now(lds_);
    const float* X = (const float*)(a.ws + WS_X);
    const int gw = F.bid * NWAVES + F.wave, NGW = F.G * NWAVES;
    for (int r = gw; r < NTOK; r += NGW) {
        f32x4 v[8]; float ss = 0.f;
#pragma unroll
        for (int j = 0; j < 8; ++j) { v[j] = *(const f32x4*)(X + (size_t)r * DM + 4 * F.lane + 256 * j); ss += (v[j][0] * v[j][0] + v[j][1] * v[j][1]) + (v[j][2] * v[j][2] + v[j][3] * v[j][3]); }
        const float rstd = rsqrtf(wave_sum(ss) * (1.f / DM) + EPS);
#pragma unroll
        for (int j = 0; j < 8; ++j) { const int c = 4 * F.lane + 256 * j; f32x4 yv = v[j] * rstd * *(const f32x4*)(a.final_norm + c);
#ifdef MK_PROBE_NOISE
            { const unsigned hsh = ((unsigned)r * 2654435761u) ^ ((unsigned)c * 40503u); const float dn = 0.03f;
              yv[0] += (hsh & 1u) ? dn : -dn; yv[1] += (hsh & 2u) ? dn : -dn; yv[2] += (hsh & 4u) ? dn : -dn; yv[3] += (hsh & 8u) ? dn : -dn; }
#endif
            *(f32x4*)(a.out + OUT_YP + (size_t)r * DM + c) = yv; }
    }
}

__device__ __forceinline__ void phase_prep(LAS unsigned char* lds_, const Args& a, int l) {
    const Frame F = frame_now(lds_);
    const bf16* Z = (const bf16*)(a.ws + WS_Z);
    bf16* KC = (bf16*)(a.ws + WS_KC); bf16* VC = (bf16*)(a.ws + WS_VC); bf16* KL = (bf16*)(a.ws + WS_KL); bf16* VL = (bf16*)(a.ws + WS_VL);
    const int gw = F.bid * NWAVES + F.wave, NGW = F.G * NWAVES, lane = F.lane;
    LAS bf16* tile = (LAS bf16*)(F.lds + F.wave * 8448);
    for (int it = gw; it < NTOK + 1024 + 2048; it += NGW) {
        if (it < NTOK) {
            const int r = it, hh = lane >> 5, i = lane & 31; const bf16* zr = Z + (size_t)r * NZ;
            float kx[4]; float ss = 0.f;
#pragma unroll
            for (int q = 0; q < 4; ++q) { kx[q] = act2f(zr[ZK + hh * 128 + i + 32 * q]); ss += kx[q] * kx[q]; }
            ss = half_sum(ss);
            const float rstd = rsqrtf(ss * (1.f / 128.f) + EPS);
#pragma unroll
            for (int q = 0; q < 4; ++q) kx[q] *= rstd * a.k_norm[l * 128 + i + 32 * q];
            const u32x2 vv = *(const u32x2*)(zr + ZV + 4 * lane);
            {
                bf16* qo = (bf16*)(a.ws + WS_QN) + (size_t)r * 1024;
                const bool lat = r >= NCTX; const int tq = (r - NCTX) & 1023; const float prow = (float)(tq >> 6), pcol = (float)(tq & 63);
                const float inv = exp2f(-(float)i * 0.41524101186092029f);
                float sr = 0.f, cr = 1.f, sc2 = 0.f, cc2 = 1.f;
                if (lat) { sr = __sinf(prow * inv); cr = __cosf(prow * inv); sc2 = __sinf(pcol * inv); cc2 = __cosf(pcol * inv); }
                float qg[4];
#pragma unroll
                for (int q = 0; q < 4; ++q) qg[q] = a.q_norm[l * 128 + i + 32 * q];
#pragma unroll
                for (int hp = 0; hp < 4; ++hp) { const int hd = 2 * hp + hh; float qx[4]; float s2 = 0.f;
#pragma unroll
                    for (int q = 0; q < 4; ++q) { qx[q] = act2f(zr[ZQ + hd * 128 + i + 32 * q]); s2 += qx[q] * qx[q]; }
                    s2 = half_sum(s2);
                    const float rs = rsqrtf(s2 * (1.f / 128.f) + EPS);
#pragma unroll
                    for (int q = 0; q < 4; ++q) qx[q] *= rs * qg[q];
                    const float y0 = qx[0] * cr - qx[1] * sr, y1 = qx[1] * cr + qx[0] * sr, y2 = qx[2] * cc2 - qx[3] * sc2, y3 = qx[3] * cc2 + qx[2] * sc2;
                    qo[hd * 128 + i] = f2act(y0); qo[hd * 128 + i + 32] = f2act(y1); qo[hd * 128 + i + 64] = f2act(y2); qo[hd * 128 + i + 96] = f2act(y3); }
            }
            if (r < NCTX) {
                const int b = r >> 8, t = r & 255; const size_t oo = ((size_t)(b * DEPTH + l) * TC + t) * 256;
#pragma unroll
                for (int q = 0; q < 4; ++q) { KC[(size_t)r * 256 + hh * 128 + i + 32 * q] = f2act(kx[q]); a.out[OUT_CK + oo + hh * 128 + i + 32 * q] = kx[q]; }
                *(u32x2*)(VC + (size_t)r * 256 + 4 * lane) = vv;
                *(f32x4*)(a.out + OUT_CV + oo + 4 * lane) = (f32x4){lo_act(vv[0]), hi_act(vv[0]), lo_act(vv[1]), hi_act(vv[1])};
            } else {
                const int rr = r - NCTX, b = rr >> 10, t = rr & 1023; const float prow = (float)(t >> 6), pcol = (float)(t & 63);
                const float inv = exp2f(-(float)i * 0.41524101186092029f);
                { const float s = __sinf(prow * inv), c = __cosf(prow * inv), x1 = kx[0], x2 = kx[1]; kx[0] = x1 * c - x2 * s; kx[1] = x2 * c + x1 * s; }
                { const float s = __sinf(pcol * inv), c = __cosf(pcol * inv), x1 = kx[2], x2 = kx[3]; kx[2] = x1 * c - x2 * s; kx[3] = x2 * c + x1 * s; }
                const size_t ko = ((size_t)b * 1280 + 256 + t) * 256;
#pragma unroll
                for (int q = 0; q < 4; ++q) KL[ko + hh * 128 + i + 32 * q] = f2act(kx[q]);
                *(u32x2*)(VL + ko + 4 * lane) = vv;
            }
        } else if (it < NTOK + 1024) {
            const int rr = it - NTOK, b = rr >> 8, s = rr & 255; const size_t so = ((size_t)(b * DEPTH + l) * PAST + s) * 256 + 4 * lane, dst_o = ((size_t)b * 1280 + s) * 256 + 4 * lane;
            const f32x4 kk = *(const f32x4*)(a.cache_k + so), vv = *(const f32x4*)(a.cache_v + so);
            u32x2 ko = {pk_act(kk[0], kk[1]), pk_act(kk[2], kk[3])}, vo = {pk_act(vv[0], vv[1]), pk_act(vv[2], vv[3])};
            *(u32x2*)(KL + dst_o) = ko; *(u32x2*)(VL + dst_o) = vo;
        } else {
            const int ti = it - NTOK - 1024, tb = ti >> 4, cb = ti & 15, r0 = tb * 64, c0 = cb * 64;
#pragma unroll
            for (int j = 0; j < 8; ++j) { const int row = (lane >> 3) + 8 * j, cc = (lane & 7) * 8; const u32x4 w = *(const u32x4*)(Z + (size_t)(r0 + row) * NZ + ZF + c0 + cc);
#pragma unroll
                for (int q = 0; q < 4; ++q) *(LAS unsigned*)(tile + row * 66 + cc + 2 * q) = w[q]; }
            LDS_WAIT(); asm volatile("" ::: "memory");
            bf16* XT; int T, b, t0;
            if (r0 < NCTX) { XT = (bf16*)(a.ws + WS_XT); T = TC; b = r0 >> 8; t0 = r0 & 255; } else { XT = (bf16*)(a.ws + WS_XT) + (size_t)16384 * 256; T = TL; b = (r0 - NCTX) >> 10; t0 = (r0 - NCTX) & 1023; }
#pragma unroll
            for (int j = 0; j < 8; ++j) { const int ch = (lane >> 3) + 8 * j, tt = (lane & 7) * 8; unsigned o[4];
#pragma unroll
                for (int q = 0; q < 4; ++q) o[q] = (unsigned)tile[(tt + 2 * q) * 66 + ch] | ((unsigned)tile[(tt + 2 * q + 1) * 66 + ch] << 16);
                *(u32x4*)(XT + ((size_t)b * 1024 + c0 + ch) * T + t0 + tt) = (u32x4){o[0], o[1], o[2], o[3]}; }
            LDS_WAIT(); asm volatile("" ::: "memory");
        }
    }
}

__device__ __forceinline__ void phase_attn(LAS unsigned char* lds_, const Args& a, int l) {
    const Frame F = frame_now(lds_);
    bf16* AM = (bf16*)(a.ws + WS_AM);
    for (int u = F.bid; u < 256; u += F.G) {
        const bool lat = u < 128; const int uu = lat ? u : u - 128;
        const int b = lat ? (uu >> 5) : (uu >> 3), h = lat ? ((uu >> 2) & 7) : (uu & 7), qb = lat ? (uu & 3) : 0;
        const size_t row0 = lat ? (size_t)NCTX + b * 1024 + qb * 256 : (size_t)b * 256;
        const size_t kvo = (lat ? (size_t)b * 1280 * 256 : (size_t)b * 256 * 256) + (h >> 2) * 128;
        const bf16* Kp = (const bf16*)(a.ws + (lat ? WS_KL : WS_KC)) + kvo; const bf16* Vp = (const bf16*)(a.ws + (lat ? WS_VL : WS_VC)) + kvo;
        att::attn_dense_body((const bf16*)(a.ws + WS_QN) + row0 * 1024 + h * 128, Kp, Vp, AM + row0 * KMRG + 2048 + h * 128, lat ? 1280 : 256, (LAS char*)F.lds);
    }
}

__device__ __forceinline__ void phase_gla(LAS unsigned char* lds_, const Args& a, int l) {
    const Frame F = frame_now(lds_);
    const bf16* Z = (const bf16*)(a.ws + WS_Z);
    for (int slot = F.bid; slot < 256; slot += F.G) {
        const int nit = slot < 128 ? 1 : 4;
        for (int k = 0; k < nit; ++k) {
            int path, b, h, dir, dvq;
            if (slot < 128) { path = 1; b = slot >> 5; h = (slot >> 3) & 3; dir = (slot >> 2) & 1; dvq = slot & 3; }
            else { const int it = (slot - 128) * 4 + k; path = 0; b = it >> 5; h = (it >> 3) & 3; dir = (it >> 2) & 1; dvq = it & 3; }
            const float* wg = (dir ? a.w_gate_b : a.w_gate_f) + (size_t)l * 16 * 512 + h * 128;
            const float* bg = (dir ? a.b_gate_b : a.b_gate_f) + (size_t)l * 512 + h * 128;
            float* OUT = (float*)(a.ws + (dir ? WS_OB : WS_OF));
            const size_t so = ((size_t)(b * DEPTH + l) * 4 + h) * 128 * 256;
            const float* st_in = path ? (dir ? a.state_b : a.state_f) + so : nullptr;
            float* st_out = path ? nullptr : a.out + (dir ? OUT_SB : OUT_SF) + so;
            gla::gla_item(F.lds, Z, OUT, wg, bg, st_in, st_out, path ? TL : TC, path ? NCTX + b * 1024 : b * 256, h, dir, dvq);
        }
    }
}
__device__ __forceinline__ void phase_gla_fin(LAS unsigned char* lds_, const Args& a, int l) {
    const Frame F = frame_now(lds_);
    const bf16* Z = (const bf16*)(a.ws + WS_Z); bf16* AM = (bf16*)(a.ws + WS_AM);
    const float* OF = (const float*)(a.ws + WS_OF); const float* OB = (const float*)(a.ws + WS_OB);
    const int gw = F.bid * NWAVES + F.wave, NGW = F.G * NWAVES;
    const f32x4 gn = *(const f32x4*)(a.gla_norm + l * 256 + 4 * F.lane);
    for (int it = gw; it < NTOK * 4; it += NGW) { const int r = it >> 2, h = it & 3; const size_t o = (size_t)r * 1024 + h * 256 + 4 * F.lane;
        const f32x4 v = *(const f32x4*)(OF + o) + *(const f32x4*)(OB + o);
        const float ss = wave_sum((v[0] * v[0] + v[1] * v[1]) + (v[2] * v[2] + v[3] * v[3]));
        const float rstd = rsqrtf(ss * (1.f / 256.f) + EPS);
        const u32x2 g = *(const u32x2*)(Z + (size_t)r * NZ + ZGR + h * 256 + 4 * F.lane);
        const f32x4 y = v * rstd * gn;
        u32x2 w = {pk_act(y[0] * siluf_(lo_act(g[0])), y[1] * siluf_(hi_act(g[0]))), pk_act(y[2] * siluf_(lo_act(g[1])), y[3] * siluf_(hi_act(g[1])))};
        *(u32x2*)(AM + (size_t)r * KMRG + 3072 + h * 256 + 4 * F.lane) = w; }
}
__device__ __forceinline__ void phase_conv(LAS unsigned char* lds_, const Args& a, int l) {
    const Frame F = frame_now(lds_);
    const bf16* U = (const bf16*)(a.ws + WS_Z); bf16* ACT = (bf16*)(a.ws + WS_ACT);
    const float* cw = a.conv_w + (size_t)l * 3 * NUP; const float* cb = a.conv_b + (size_t)l * NUP;
    constexpr int NCG = DFF / 8, STRIP = 32, NS = NTOK / STRIP;
    for (int it = F.bid * 512 + F.tid; it < NCG * NS; it += F.G * 512) {
        const int cg = it % NCG, st = it / NCG, c = cg * 8, r0 = st * STRIP; const int T = r0 < NCTX ? TC : TL;
        float wg[3][8], wv[3][8], bgv[8], bvv[8];
#pragma unroll
        for (int k = 0; k < 3; ++k) { const f32x4 a0 = *(const f32x4*)(cw + k * NUP + c), a1 = *(const f32x4*)(cw + k * NUP + c + 4), b0 = *(const f32x4*)(cw + k * NUP + DFF + c), b1 = *(const f32x4*)(cw + k * NUP + DFF + c + 4);
#pragma unroll
            for (int j = 0; j < 4; ++j) { wg[k][j] = a0[j]; wg[k][4 + j] = a1[j]; wv[k][j] = b0[j]; wv[k][4 + j] = b1[j]; } }
        { const f32x4 a0 = *(const f32x4*)(cb + c), a1 = *(const f32x4*)(cb + c + 4), b0 = *(const f32x4*)(cb + DFF + c), b1 = *(const f32x4*)(cb + DFF + c + 4);
#pragma unroll
          for (int j = 0; j < 4; ++j) { bgv[j] = a0[j]; bgv[4 + j] = a1[j]; bvv[j] = b0[j]; bvv[4 + j] = b1[j]; } }
        const u32x4 zero = {0u, 0u, 0u, 0u};
        u32x4 gp = zero, vp = zero, gc, vc, gn, vn;
        if ((r0 & (T - 1)) != 0) { gp = *(const u32x4*)(U + (size_t)(r0 - 1) * NUP + c); vp = *(const u32x4*)(U + (size_t)(r0 - 1) * NUP + DFF + c); }
        gc = *(const u32x4*)(U + (size_t)r0 * NUP + c); vc = *(const u32x4*)(U + (size_t)r0 * NUP + DFF + c);
        for (int i = 0; i < STRIP; ++i) { const int r = r0 + i;
            if (((r + 1) & (T - 1)) != 0) { gn = *(const u32x4*)(U + (size_t)(r + 1) * NUP + c); vn = *(const u32x4*)(U + (size_t)(r + 1) * NUP + DFF + c); } else { gn = zero; vn = zero; }
            float o[8];
#pragma unroll
            for (int q = 0; q < 4; ++q) {
                const float g0 = wg[0][2 * q] * lo_act(gp[q]) + wg[1][2 * q] * lo_act(gc[q]) + wg[2][2 * q] * lo_act(gn[q]) + bgv[2 * q];
                const float g1 = wg[0][2 * q + 1] * hi_act(gp[q]) + wg[1][2 * q + 1] * hi_act(gc[q]) + wg[2][2 * q + 1] * hi_act(gn[q]) + bgv[2 * q + 1];
                const float v0 = wv[0][2 * q] * lo_act(vp[q]) + wv[1][2 * q] * lo_act(vc[q]) + wv[2][2 * q] * lo_act(vn[q]) + bvv[2 * q];
                const float v1 = wv[0][2 * q + 1] * hi_act(vp[q]) + wv[1][2 * q + 1] * hi_act(vc[q]) + wv[2][2 * q + 1] * hi_act(vn[q]) + bvv[2 * q + 1];
                o[2 * q] = siluf_(g0) * v0; o[2 * q + 1] = siluf_(g1) * v1; }
            *(u32x4*)(ACT + (size_t)r * DFF + c) = (u32x4){pk_act(o[0], o[1]), pk_act(o[2], o[3]), pk_act(o[4], o[5]), pk_act(o[6], o[7])};
            gp = gc; vp = vc; gc = gn; vc = vn; }
    }
}

#ifdef MK_PROBE
constexpr size_t WS_DIAG = WS_END;
__device__ __forceinline__ void diag_max(float* slot, float v) { atomicMax((unsigned*)slot, __builtin_bit_cast(unsigned, fabsf(v))); }
__global__ void k_probe_zero(float* diag) { if (threadIdx.x < 4) diag[threadIdx.x] = 0.f; }
__global__ void k_probe_fill(float* out, const float* diag) {
    for (size_t i = (size_t)blockIdx.x * blockDim.x + threadIdx.x; i < OUT_END; i += (size_t)gridDim.x * blockDim.x) out[i] = 0.f;
    __syncthreads();
    if (blockIdx.x == 0 && threadIdx.x == 0) out[0] = 1e6f * diag[0] / fmaxf(diag[1], 1e-20f);
}
__global__ void k_probe_fill2(float* out, const float* diag) { if (blockIdx.x == 0 && threadIdx.x == 0) out[0] = 1e6f * diag[0] / fmaxf(diag[1], 1e-20f); }
__global__ void k_probe_z(Args a) {
    const bf16* H = (const bf16*)(a.ws + WS_H); const bf16* W = (const bf16*)(a.ws + WS_WIN); const bf16* Z = (const bf16*)(a.ws + WS_Z); float* diag = (float*)(a.ws + WS_DIAG);
    const unsigned id = blockIdx.x * blockDim.x + threadIdx.x; const unsigned hsh = id * 2654435761u + 12345u;
    const int r = (hsh >> 8) % NTOK, c = (hsh * 40503u >> 7) % NZ;
    float s = 0.f; for (int k = 0; k < DM; ++k) s += act2f(H[(size_t)r * DM + k]) * act2f(W[(size_t)c * DM + k]);
    const float z = act2f(Z[(size_t)r * NZ + c]); diag_max(diag, z - s); diag_max(diag + 1, s);
}
__global__ void k_probe_wt(Args a, int l) {
    const bf16* W = (const bf16*)(a.ws + WS_WIN + (size_t)l * SZ_WIN); float* diag = (float*)(a.ws + WS_DIAG);
    for (size_t i = (size_t)blockIdx.x * blockDim.x + threadIdx.x; i < (size_t)N_IN * DM; i += (size_t)gridDim.x * blockDim.x) {
        const int n = (int)(i / DM), k = (int)(i % DM); const int row = n >= ZPAD ? n + (ZGATE - ZPAD) : n;
        const float ref = act2f(f2act(a.w_in[((size_t)l * DM + k) * N_IN + n])); diag_max(diag, act2f(W[(size_t)row * DM + k]) - ref); diag_max(diag + 1, ref); }
}
__global__ void k_probe_gla(Args a) {
    __shared__ float red[4];
    const bf16* Z = (const bf16*)(a.ws + WS_Z); float* diag = (float*)(a.ws + WS_DIAG);
    const int l = 0, blk = blockIdx.x, b = blk & 15, h = (blk >> 4) & 3, dir = (blk >> 6) & 1, dv0 = ((blk >> 7) * 52 + 3) & 252;
    const int d = threadIdx.x & 127, dvi = threadIdx.x >> 7, dv = dv0 + dvi, T = TC, tokbase = b * TC;
    const float* wg = (dir ? a.w_gate_b : a.w_gate_f) + (size_t)l * 16 * 512 + h * 128; const float* bg = (dir ? a.b_gate_b : a.b_gate_f) + (size_t)l * 512 + h * 128;
    const float* OUT = (const float*)(a.ws + (dir ? WS_OB : WS_OF));
    float S = 0.f;
    for (int i = 0; i < T; ++i) { const int t = dir ? T - 1 - i : i; const bf16* zr = Z + (size_t)(tokbase + t) * NZ;
        float x = bg[d]; for (int r = 0; r < 16; ++r) x += act2f(zr[(dir ? ZGAB : ZGAF) + r]) * wg[r * 512 + d];
        const float la = (fminf(x, 0.f) - logf(1.f + expf(-fabsf(x)))) * 0.0625f;
        S = expf(la) * S + act2f(zr[ZGK + h * 128 + d]) * act2f(zr[ZGV + h * 256 + dv]);
        if (threadIdx.x < 4) red[threadIdx.x] = 0.f;
        __syncthreads();
        atomicAdd(&red[dvi], act2f(zr[ZGQ + h * 128 + d]) * 0.088388347648318440f * S);
        __syncthreads();
        if (d == 0) { const float o = OUT[(size_t)(tokbase + t) * 1024 + h * 256 + dv]; diag_max(diag, o - red[dvi]); diag_max(diag + 1, red[dvi]); }
        __syncthreads(); }
    const float sref = S, sgot = a.out[(dir ? OUT_SB : OUT_SF) + (((size_t)(b * DEPTH + l) * 4 + h) * 128 + d) * 256 + dv];
    diag_max(diag + 2, sgot - sref); diag_max(diag + 3, sref);
}

__global__ void k_probe_h(Args a) {
    const bf16* H = (const bf16*)(a.ws + WS_H); float* diag = (float*)(a.ws + WS_DIAG);
    const unsigned id = blockIdx.x * blockDim.x + threadIdx.x; const unsigned hsh = id * 2654435761u + 777u;
    const int r = (hsh >> 8) % NTOK, c = (hsh * 40503u >> 7) % DM, j = mod_row(r);
    const float* xr = r < NCTX ? a.x_prompt + (size_t)r * DM : a.x_sample + (size_t)(r - NCTX) * DM;
    float ss = 0.f, sh = a.b_ada[c], sc = a.b_ada[DM + c];
    for (int k = 0; k < DM; ++k) { ss += xr[k] * xr[k]; const float cv = j == 0 ? a.c_ctx[k] : a.cvec[(j - 1) * DM + k]; const float sl = cv / (1.f + expf(-cv));
        sh += sl * a.w_ada[(size_t)k * NMOD + c]; sc += sl * a.w_ada[(size_t)k * NMOD + DM + c]; }
    const float ref = xr[c] * (1.f / sqrtf(ss / DM + EPS)) * a.norm1[c] * (1.f + sc) + sh;
    diag_max(diag, act2f(H[(size_t)r * DM + c]) - ref); diag_max(diag + 1, ref);
}

__global__ void k_probe_mod(Args a, int l) {
    const float* MOD = (const float*)(a.ws + WS_MOD) + (size_t)l * NMODV * NMOD; float* diag = (float*)(a.ws + WS_DIAG);
    const unsigned id = blockIdx.x * blockDim.x + threadIdx.x; const int j = id % NMODV, n = (int)(((id / NMODV) * 2654435761u >> 8) % NMOD);
    float s = a.b_ada[(size_t)l * NMOD + n];
    for (int k = 0; k < DM; ++k) { const float cv = j == 0 ? a.c_ctx[k] : a.cvec[(j - 1) * DM + k]; s += cv / (1.f + expf(-cv)) * a.w_ada[((size_t)l * DM + k) * NMOD + n]; }
    diag_max(diag, MOD[(size_t)j * NMOD + n] - s); diag_max(diag + 1, s);
}
#endif

constexpr int STEPS_PER_LAYER = 13, STEP_L0 = 2, STEP_FINAL = STEP_L0 + DEPTH * STEPS_PER_LAYER, N_STEPS = STEP_FINAL + 1;
#ifndef MK_PH_MASK
#define MK_PH_MASK 0xFFFFFFFFu
#endif
#define EN(k) (((MK_PH_MASK) >> (k)) & 1u)
#ifndef MK_SP2
#define MK_SP2 true
#endif
#ifndef MK_ALIGN
#define MK_ALIGN true
#endif
__global__ void __launch_bounds__(NWAVES * 64, 2) mk_fwd(Args a) {
    extern __shared__ __attribute__((aligned(16))) unsigned char lds_raw[];
    LAS unsigned char* const lds = (LAS unsigned char*)lds_raw;
    volatile LAS unsigned* MISC = (volatile LAS unsigned*)(lds + MISC_OFF);
    if (threadIdx.x < 64) MISC[threadIdx.x] = 0u;
    __syncthreads();
    unsigned* barw = (unsigned*)(a.ws + WS_CTL) + CW_BAR + a.li * XCD_BAR_WORDS;
    XcdBarrier bar = xcd_barrier_post(barw, MISC + 8);
    const int lo = a.s_lo, hi = a.s_hi;
#define IN(s) (lo <= (s) && (s) < hi)
#define SEAM(s) do { if (IN(s) && IN((s) + 1)) xcd_barrier(bar); else __syncthreads(); } while (0)
    unsigned char* ws = a.ws;
    const int G = gridDim.x, bid = blockIdx.x;

    if (EN(13) && IN(0)) { phase_prologue_a(lds, a); SEAM(0); }
    if (EN(14) && IN(1)) {
        phase_mod_reduce(lds, a);
        pg8::Gemm g{(const bf16*)(ws + WS_WFT), (const bf16*)(ws + WS_DT), DEPTH * DM, 2048, 1024}; pg8::StaticOrder S; S.init(g.M, g.N, G, bid);
        pg8::EpiStoreBf16 E{(bf16*)(ws + WS_WMRG), KMRG};
        pg8::gemm_phase<pg8::EpiStoreBf16, pg8::StaticOrder, MK_ALIGN, MK_SP2>(lds, g, S, E);
        SEAM(1);
    }
    for (int l = 0; l < DEPTH; ++l) {
        const int sb = STEP_L0 + l * STEPS_PER_LAYER;
        if (hi <= sb || lo >= sb + STEPS_PER_LAYER) continue;
        const float* MODL = (const float*)(ws + WS_MOD) + (size_t)l * NMODV * NMOD;
        if (EN(0) && IN(sb + 0)) { phase_norm(lds, a, l, 0, l == 0); SEAM(sb + 0); }
        if (EN(1) && IN(sb + 1)) {
            pg8::Gemm g{(const bf16*)(ws + WS_H), (const bf16*)(ws + WS_WIN + l * SZ_WIN), NTOK, NZ, DM}; pg8::StaticOrder S; S.init(g.M, g.N, G, bid);
            pg8::EpiStoreBf16 E{(bf16*)(ws + WS_Z), NZ};
            pg8::gemm_phase<pg8::EpiStoreBf16, pg8::StaticOrder, MK_ALIGN, MK_SP2>(lds, g, S, E);
            SEAM(sb + 1);
        }
        if (EN(2) && IN(sb + 2)) { phase_prep(lds, a, l); SEAM(sb + 2); }
        if (EN(3) && IN(sb + 3)) { phase_attn(lds, a, l); SEAM(sb + 3); }
        if (EN(4) && IN(sb + 4)) {
            { pg8::Gemm g{(const bf16*)(ws + WS_ALAT), (const bf16*)(ws + WS_XT) + (size_t)16384 * 256, 2048, 4096, 1024}; pg8::StaticOrder S; S.init(g.M, g.N, G, bid);
              pg8::EpiDft E{(bf16*)(ws + WS_AM), 10, NCTX};
              pg8::gemm_phase<pg8::EpiDft, pg8::StaticOrder, MK_ALIGN, MK_SP2>(lds, g, S, E); }
            { pg8::Gemm g{(const bf16*)(ws + WS_ACTX), (const bf16*)(ws + WS_XT), 512, 16384, 256}; pg8::StaticOrder S; S.init(g.M, g.N, G, (bid + G / 2) % G);
              pg8::EpiDft E{(bf16*)(ws + WS_AM), 8, 0};
              pg8::gemm_phase<pg8::EpiDft, pg8::StaticOrder, MK_ALIGN, MK_SP2>(lds, g, S, E); }
            SEAM(sb + 4);
        }
        if (EN(5) && IN(sb + 5)) { phase_gla(lds, a, l); SEAM(sb + 5); }
        if (EN(6) && IN(sb + 6)) { phase_gla_fin(lds, a, l); SEAM(sb + 6); }
        if (EN(7) && IN(sb + 7)) {
            pg8::Gemm g{(const bf16*)(ws + WS_AM), (const bf16*)(ws + WS_WMRG + l * SZ_WMRG), NTOK, DM, KMRG}; pg8::StaticOrder S; S.init(g.M, g.N, G, bid);
            pg8::EpiMerged E{(bf16*)(ws + WS_MG), (const bf16*)(ws + WS_Z)};
            pg8::gemm_phase<pg8::EpiMerged, pg8::StaticOrder, MK_ALIGN, MK_SP2>(lds, g, S, E);
            SEAM(sb + 7);
        }
        if (EN(8) && IN(sb + 8)) {
            pg8::Gemm g{(const bf16*)(ws + WS_MG), (const bf16*)(ws + WS_WOUT + l * SZ_WOUT), NTOK, DM, DM}; pg8::StaticOrder S; S.init(g.M, g.N, G, bid);
            pg8::EpiResid E{(float*)(ws + WS_X), MODL + 2 * DM};
            pg8::gemm_phase<pg8::EpiResid, pg8::StaticOrder, MK_ALIGN, MK_SP2>(lds, g, S, E);
            SEAM(sb + 8);
        }
        if (EN(9) && IN(sb + 9)) { phase_norm(lds, a, l, 1, false); SEAM(sb + 9); }
        if (EN(10) && IN(sb + 10)) {
            pg8::Gemm g{(const bf16*)(ws + WS_H), (const bf16*)(ws + WS_WUP + l * SZ_WUP), NTOK, NUP, DM}; pg8::StaticOrder S; S.init(g.M, g.N, G, bid);
            pg8::EpiStoreBf16 E{(bf16*)(ws + WS_Z), NUP};
            pg8::gemm_phase<pg8::EpiStoreBf16, pg8::StaticOrder, MK_ALIGN, MK_SP2>(lds, g, S, E);
            SEAM(sb + 10);
        }
        if (EN(11) && IN(sb + 11)) { phase_conv(lds, a, l); SEAM(sb + 11); }
        if (EN(12) && IN(sb + 12)) {
            pg8::Gemm g{(const bf16*)(ws + WS_ACT), (const bf16*)(ws + WS_WDN + l * SZ_WDN), NTOK, DM, DFF}; pg8::StaticOrder S; S.init(g.M, g.N, G, bid);
            pg8::EpiResid E{(float*)(ws + WS_X), MODL + 5 * DM};
            pg8::gemm_phase<pg8::EpiResid, pg8::StaticOrder, MK_ALIGN, MK_SP2>(lds, g, S, E);
            SEAM(sb + 12);
        }
    }
    if (EN(15) && IN(STEP_FINAL)) phase_final_norm(lds, a);
#undef IN
#undef SEAM
}

#ifndef MK_LAUNCH_MODE
#define MK_LAUNCH_MODE 0
#endif
extern "C" void kernel_launch(void* const* d_in, const int* in_sizes, int n_in, void* d_out, int out_size, void* d_ws, size_t ws_size, hipStream_t stream) {
    static int grid = 0;
    if (grid == 0) {
        if (n_in != 29 || (size_t)out_size != OUT_END || ws_size < WS_END + 4096) { fprintf(stderr, "kernel_launch: unexpected shapes: n_in %d out %d ws %zu (need %zu)\n", n_in, out_size, ws_size, (size_t)WS_END); grid = -1; return; }
        int dev = 0, cus = 0;
        if (hipGetDevice(&dev) != hipSuccess || hipDeviceGetAttribute(&cus, hipDeviceAttributeMultiprocessorCount, dev) != hipSuccess) { grid = -1; return; }
        if (hipFuncSetAttribute((const void*)mk_fwd, hipFuncAttributeMaxDynamicSharedMemorySize, LDS_BYTES) != hipSuccess) { fprintf(stderr, "kernel_launch: hipFuncSetAttribute failed\n"); grid = -1; return; }
        int per_cu = 0;
        if (hipOccupancyMaxActiveBlocksPerMultiprocessor(&per_cu, (const void*)mk_fwd, NWAVES * 64, LDS_BYTES) != hipSuccess || per_cu < 1) { fprintf(stderr, "kernel_launch: occupancy query says %d\n", per_cu); }
        (void)hipGetLastError();
        grid = cus;
    }
    if (grid < 0) return;
    (void)hipMemsetAsync((char*)d_ws + WS_CTL, 0, CTL_ZERO_BYTES, stream);
    Args a{};
    const float** p = (const float**)&a;
    for (int i = 0; i < 29; ++i) p[i] = (const float*)d_in[i];
    a.out = (float*)d_out; a.ws = (unsigned char*)d_ws; a.pad = 0;
#ifdef MK_PROBE
    {
        constexpr int PROBE_STEPS = (MK_PROBE == 2) ? 1 : (MK_PROBE == 1) ? STEP_L0 + 2 : (MK_PROBE == 4) ? STEP_L0 + 1 : (MK_PROBE == 5) ? 2 : STEP_L0 + 6;
        float* diag = (float*)((char*)d_ws + WS_DIAG);
        for (int s = 0; s < PROBE_STEPS; ++s) { a.s_lo = s; a.s_hi = s + 1; a.li = s; hipLaunchKernelGGL(mk_fwd, dim3(grid), dim3(NWAVES * 64), LDS_BYTES, stream, a); }
        hipLaunchKernelGGL(k_probe_zero, dim3(1), dim3(64), 0, stream, diag);
        if (MK_PROBE == 1) hipLaunchKernelGGL(k_probe_z, dim3(128), dim3(512), 0, stream, a);
        if (MK_PROBE == 2) hipLaunchKernelGGL(k_probe_wt, dim3(1024), dim3(256), 0, stream, a, MK_PROBE_L);
        if (MK_PROBE == 4) hipLaunchKernelGGL(k_probe_h, dim3(32), dim3(512), 0, stream, a);
        if (MK_PROBE == 5) hipLaunchKernelGGL(k_probe_mod, dim3(40), dim3(512), 0, stream, a, MK_PROBE_L);
        if (MK_PROBE == 3) hipLaunchKernelGGL(k_probe_gla, dim3(512), dim3(512), 0, stream, a);
        hipLaunchKernelGGL(k_probe_fill, dim3(1024), dim3(256), 0, stream, (float*)d_out, (const float*)(diag + 2 * MK_PROBE_SEL));
        hipLaunchKernelGGL(k_probe_fill2, dim3(1), dim3(64), 0, stream, (float*)d_out, (const float*)(diag + 2 * MK_PROBE_SEL));
        return;
    }
#endif
#if MK_LAUNCH_MODE == 1
    a.s_lo = 0; a.s_hi = N_STEPS; a.li = 0;
    hipLaunchKernelGGL(mk_fwd, dim3(grid), dim3(NWAVES * 64), LDS_BYTES, stream, a);
#else
    for (int s = 0; s < N_STEPS; ++s) { a.s_lo = s; a.s_hi = s + 1; a.li = s;
        hipLaunchKernelGGL(mk_fwd, dim3(grid), dim3(NWAVES * 64), LDS_BYTES, stream, a); }
#endif
}
```

```cpp
#define MK_LAUNCH_MODE 1
#include <hip/hip_runtime.h>
#include <cstdio>
#include <cstdint>

#define GAS __attribute__((address_space(1)))
#define LAS __attribute__((address_space(3)))
typedef unsigned short bf16;
typedef short bf16x8 __attribute__((ext_vector_type(8)));
typedef float f32x4 __attribute__((ext_vector_type(4)));
typedef float f32x2 __attribute__((ext_vector_type(2)));
typedef unsigned u32x4 __attribute__((ext_vector_type(4)));
typedef unsigned u32x2 __attribute__((ext_vector_type(2)));
typedef GAS unsigned gu32;

constexpr int DM = 2048, NTOK = 8192, NCTX = 4096, TC = 256, TL = 1024, BCTX = 16, BLAT = 4, PAST = 256, DEPTH = 4;
constexpr int N_IN = 11808, NZ = 12032;
constexpr int ZF = 0, ZQ = 1024, ZK = 2048, ZV = 2304, ZGQ = 2560, ZGK = 3072, ZGV = 3584, ZGR = 4608, ZGAF = 5632, ZGAB = 5648, ZPAD = 5664, ZGATE = 5888;
constexpr int NUP = 11264, DFF = 5632, NMOD = 12288, KMRG = 4096;
constexpr int NMODV = 5;
constexpr float EPS = 1e-6f;

constexpr size_t MiB = 1u << 20;
constexpr size_t WS_CTL = 0, CTL_ZERO_BYTES = 1 * MiB;
constexpr size_t WS_MOD = 1 * MiB;
constexpr size_t WS_MODP = 2 * MiB;
constexpr size_t WS_DT = 17 * MiB;
constexpr size_t WS_ACTX = 21 * MiB;
constexpr size_t WS_ALAT = 22 * MiB;
constexpr size_t WS_WIN = 26 * MiB;
constexpr size_t WS_WMRG = 214 * MiB;
constexpr size_t WS_WFT = 278 * MiB;
constexpr size_t WS_WOUT = 294 * MiB;
constexpr size_t WS_WUP = 326 * MiB;
constexpr size_t WS_WDN = 502 * MiB;
constexpr size_t WS_X = 590 * MiB;
constexpr size_t WS_H = 654 * MiB;
constexpr size_t WS_Z = 686 * MiB;
constexpr size_t WS_XT = 874 * MiB;
constexpr size_t WS_KC = 890 * MiB, WS_VC = 892 * MiB;
constexpr size_t WS_KL = 894 * MiB, WS_VL = 897 * MiB;
constexpr size_t WS_AM = 900 * MiB;
constexpr size_t WS_OF = 964 * MiB, WS_OB = 996 * MiB;
constexpr size_t WS_MG = 1028 * MiB;
constexpr size_t WS_ACT = 1060 * MiB;
constexpr size_t WS_QN = 1148 * MiB;
constexpr size_t WS_END = 1164 * MiB;
constexpr size_t SZ_WIN = (size_t)NZ * DM * 2, SZ_WMRG = (size_t)DM * KMRG * 2, SZ_WFT = (size_t)DM * 1024 * 2, SZ_WOUT = (size_t)DM * DM * 2, SZ_WUP = (size_t)NUP * DM * 2, SZ_WDN = (size_t)DM * DFF * 2;
static_assert(WS_WIN + 4 * SZ_WIN <= WS_WMRG && WS_WMRG + 4 * SZ_WMRG <= WS_WFT && WS_WFT + 4 * SZ_WFT <= WS_WOUT && WS_WOUT + 4 * SZ_WOUT <= WS_WUP && WS_WUP + 4 * SZ_WUP <= WS_WDN && WS_WDN + 4 * SZ_WDN <= WS_X, "ws map (weights)");
static_assert(WS_Z + (size_t)NTOK * NZ * 2 <= WS_XT && WS_MODP + (size_t)16 * 4 * 5 * NMOD * 4 <= WS_DT && WS_AM + (size_t)NTOK * KMRG * 2 <= WS_OF && WS_ACT + (size_t)NTOK * DFF * 2 <= WS_END, "ws map (activations)");
constexpr int CW_BAR = 4096;

constexpr int LDS_BYTES = 163840;
constexpr int MISC_OFF = LDS_BYTES - 256;
constexpr int NWAVES = 8;

#define RLX_AGENT __ATOMIC_RELAXED, __HIP_MEMORY_SCOPE_AGENT
#define LDS_WAIT() asm volatile("s_waitcnt lgkmcnt(0)" ::: "memory")
#define VM_WAIT() asm volatile("s_waitcnt vmcnt(0)" ::: "memory")
__device__ __forceinline__ unsigned cvt_pk_bf16(float lo, float hi) { unsigned r; asm volatile("v_cvt_pk_bf16_f32 %0, %1, %2" : "=v"(r) : "v"(lo), "v"(hi)); return r; }
__device__ __forceinline__ float bf_lo(unsigned w) { return __builtin_bit_cast(float, w << 16); }
__device__ __forceinline__ float bf_hi(unsigned w) { return __builtin_bit_cast(float, w & 0xffff0000u); }
__device__ __forceinline__ float bf2f(bf16 h) { return __builtin_bit_cast(float, (unsigned)h << 16); }
__device__ __forceinline__ bf16 f2bf(float f) { return (bf16)(cvt_pk_bf16(f, 0.f) & 0xffffu); }
#ifndef MK_F16
#define MK_F16 1
#endif
typedef _Float16 h16x2 __attribute__((ext_vector_type(2)));
typedef _Float16 h16x8 __attribute__((ext_vector_type(8)));
typedef float f32x16_t __attribute__((ext_vector_type(16)));
#if MK_F16
__device__ __forceinline__ unsigned pk_act(float lo, float hi) { h16x2 v; v[0] = (_Float16)lo; v[1] = (_Float16)hi; return __builtin_bit_cast(unsigned, v); }
__device__ __forceinline__ float lo_act(unsigned w) { return (float)__builtin_bit_cast(h16x2, w)[0]; }
__device__ __forceinline__ float hi_act(unsigned w) { return (float)__builtin_bit_cast(h16x2, w)[1]; }
__device__ __forceinline__ float act2f(bf16 h) { return (float)__builtin_bit_cast(_Float16, h); }
__device__ __forceinline__ bf16 f2act(float f) { return __builtin_bit_cast(bf16, (_Float16)f); }
__device__ __forceinline__ f32x4 mma16_act(bf16x8 a, bf16x8 b, f32x4 c) { return __builtin_amdgcn_mfma_f32_16x16x32_f16(__builtin_bit_cast(h16x8, a), __builtin_bit_cast(h16x8, b), c, 0, 0, 0); }
__device__ __forceinline__ f32x16_t mma32_act(bf16x8 a, bf16x8 b, f32x16_t c) { return __builtin_amdgcn_mfma_f32_32x32x16_f16(__builtin_bit_cast(h16x8, a), __builtin_bit_cast(h16x8, b), c, 0, 0, 0); }
#else
__device__ __forceinline__ unsigned pk_act(float lo, float hi) { return cvt_pk_bf16(lo, hi); }
__device__ __forceinline__ float lo_act(unsigned w) { return bf_lo(w); }
__device__ __forceinline__ float hi_act(unsigned w) { return bf_hi(w); }
__device__ __forceinline__ float act2f(bf16 h) { return bf2f(h); }
__device__ __forceinline__ bf16 f2act(float f) { return f2bf(f); }
__device__ __forceinline__ f32x4 mma16_act(bf16x8 a, bf16x8 b, f32x4 c) { return __builtin_amdgcn_mfma_f32_16x16x32_bf16(a, b, c, 0, 0, 0); }
__device__ __forceinline__ f32x16_t mma32_act(bf16x8 a, bf16x8 b, f32x16_t c) { return __builtin_amdgcn_mfma_f32_32x32x16_bf16(a, b, c, 0, 0, 0); }
#endif
template <int M> __device__ __forceinline__ float swz_xor(float v) { return __builtin_bit_cast(float, __builtin_amdgcn_ds_swizzle(__builtin_bit_cast(int, v), (M << 10) | 0x1f)); }
__device__ __forceinline__ float half_sum(float v) { v += swz_xor<1>(v); v += swz_xor<2>(v); v += swz_xor<4>(v); v += swz_xor<8>(v); v += swz_xor<16>(v); return v; }
__device__ __forceinline__ float wave_sum(float v) { v = half_sum(v);
    auto rr = __builtin_amdgcn_permlane32_swap(__float_as_uint(v), __float_as_uint(v), false, false); return __uint_as_float(rr[0]) + __uint_as_float(rr[1]); }
__device__ __forceinline__ float sigmoidf_(float x) { return __builtin_amdgcn_rcpf(1.f + __expf(-x)); }
__device__ __forceinline__ float siluf_(float x) { return x * sigmoidf_(x); }
__device__ __forceinline__ int opaque_tid() { int t = threadIdx.x; asm volatile("" : "+v"(t)); return t; }
__device__ __forceinline__ int mod_row(int r) { return r < NCTX ? 0 : 1 + ((r - NCTX) >> 10); }

namespace pg8 {
#define PG8_LAS __attribute__((address_space(3)))
typedef unsigned short bf16_t;
constexpr int BM = 256, BK = 64, HALF = 128, HTB = HALF * BK * 2  , STAGE_BYTES = 8 * HTB, NXCD = 8, WGM = 8;

__host__ __device__ __forceinline__ int lds_byte(int r, int c) { const int st = (r >> 4) * 2 + (c >> 5), rr = r & 15, cc = c & 31, ob = rr * 64 + cc * 2; return st * 1024 + (ob ^ (((ob >> 9) & 1) << 5)); }
__host__ __device__ __forceinline__ void stage_rc(int b, int& R, int& C) { const int st = b / 1024, sb = b % 1024, swz = sb ^ (((sb >> 9) & 1) << 5); R = (st >> 1) * 16 + swz / 64; C = (st & 1) * 32 + (swz % 64) / 2; }
__host__ __device__ __forceinline__ int perm32(int rho) { const int n = rho >> 4, i = rho & 15; return 8 * (i >> 2) + 4 * n + (i & 3); }

struct Unit { int pm, pn; };
struct Gemm { const bf16_t* A; const bf16_t* Bt; int M, N, K; };

struct StaticOrder {
    int nM, nN, nwg, G, c;
    __host__ __device__ void init(int M, int N, int G_, int c_) { nM = M / BM; nN = N / BM; nwg = nM * nN; G = G_; c = c_; }
    __host__ __device__ bool next(int i, Unit& u) const {
        const long L = (long)i * G + c; if (L >= nwg) return false;
        int wgid = (int)L; { const int q = nwg / NXCD, r = nwg % NXCD, xcd = wgid % NXCD, off = wgid / NXCD; wgid = (xcd < r ? xcd * (q + 1) : r * (q + 1) + (xcd - r) * q) + off; }
        const int nig = WGM * nN, gid = wgid / nig, fm = gid * WGM, gsz = (nM - fm) < WGM ? (nM - fm) : WGM;
        u.pm = fm + ((wgid % nig) % gsz); u.pn = (wgid % nig) / gsz; return true;
    }
    __device__ __forceinline__ void a_ready(const Unit&) const {}
    __device__ __forceinline__ void done(const Unit&) const {}
};

template <class Epi, class Sched, bool ALIGN_EPI = false, bool SP2 = false>
__device__ __forceinline__ void gemm_phase(PG8_LAS unsigned char* lds, const Gemm g, const Sched& S, const Epi& E) {
    const int tid = opaque_tid(), wid = __builtin_amdgcn_readfirstlane(tid >> 6), lane = tid & 63, wr = wid >> 2, wc = wid & 3, fr = lane & 15, fq = lane >> 4;
    const int K = g.K, nt = K / BK;
    unsigned voffA[2], voffB[2];
#pragma unroll
    for (int i = 0; i < 2; ++i) { int R, C; stage_rc(tid * 16 + i * 8192, R, C); const int Rb = Epi::PERM ? ((R & ~31) + perm32(R & 31)) : R;
        voffA[i] = (unsigned)(R * K + C) * 2u; voffB[i] = (unsigned)(Rb * K + C) * 2u; }
    const size_t kstep = (size_t)(BK * 2);
    const size_t hstep = (size_t)HALF * K * 2;
    const size_t tstep = 2 * hstep;
    const unsigned ldsw = (unsigned)wid * 1024u;
    const int aoff = lds_byte(wr * 64 + fr, fq * 8), boff = lds_byte(wc * 32 + fr, fq * 8);
#define PG8_SA(b, h) (((b) * 2 + (h)) * HTB)
#define PG8_SB(b, h) ((4 + (b) * 2 + (h)) * HTB)
#define PG8_STAGE(bufoff, gbase, voff) do { _Pragma("unroll") for (int _i = 0; _i < 2; ++_i) \
        __builtin_amdgcn_global_load_lds((const unsigned*)((const char*)(gbase) + (voff)[_i]), (PG8_LAS unsigned*)(lds + (bufoff) + ldsw + _i * 8192), 16, 0, 0); } while (0)
#define PG8_LDA(dst, b, h) do { _Pragma("unroll") for (int m = 0; m < 4; ++m) _Pragma("unroll") for (int k = 0; k < 2; ++k) dst[m][k] = *(const PG8_LAS bf16x8*)(lds + PG8_SA(b, h) + aoff + m * 2048 + k * 1024); } while (0)
#define PG8_LDB(dst, b, h) do { _Pragma("unroll") for (int n = 0; n < 2; ++n) _Pragma("unroll") for (int k = 0; k < 2; ++k) dst[n][k] = *(const PG8_LAS bf16x8*)(lds + PG8_SB(b, h) + boff + n * 2048 + k * 1024); } while (0)
#define PG8_MMA(ai, bj, At, Bt) do { __builtin_amdgcn_s_setprio(1); _Pragma("unroll") for (int m = 0; m < 4; ++m) _Pragma("unroll") for (int n = 0; n < 2; ++n) _Pragma("unroll") for (int k = 0; k < 2; ++k) \
        acc[ai][bj][m][n] = mma16_act(Bt[n][k], At[m][k], acc[ai][bj][m][n]); __builtin_amdgcn_s_setprio(0); } while (0)
#define PG8_WAIT_V(n) asm volatile("s_waitcnt vmcnt(" #n ")" ::: "memory")
#define PG8_WAIT_L(n) asm volatile("s_waitcnt lgkmcnt(" #n ")" ::: "memory")
#define PG8_BAR __builtin_amdgcn_s_barrier()
#define PG8_SCHED __builtin_amdgcn_sched_barrier(0)
    Unit cur, nxt; int ui = 0;
    if (!S.next(0, cur)) return;
    f32x4 acc[2][2][4][2];
#pragma unroll
    for (int a = 0; a < 2; ++a)
#pragma unroll
        for (int b = 0; b < 2; ++b)
#pragma unroll
            for (int m = 0; m < 4; ++m)
#pragma unroll
                for (int n = 0; n < 2; ++n) acc[a][b][m][n] = (f32x4){0.f, 0.f, 0.f, 0.f};
    bf16x8 At[4][2], B0[2][2], B1[2][2];
    const char* cA = (const char*)g.A + (size_t)cur.pm * tstep; const char* cB = (const char*)g.Bt + (size_t)cur.pn * tstep;
    S.a_ready(cur);
    if constexpr (SP2) {
        PG8_STAGE(PG8_SB(0, 0), cB, voffB); PG8_STAGE(PG8_SB(0, 1), cB + hstep, voffB); PG8_STAGE(PG8_SA(0, 0), cA, voffA); PG8_STAGE(PG8_SA(0, 1), cA + hstep, voffA);
        if (wr == 1) PG8_BAR;
        PG8_WAIT_V(2); PG8_BAR;
        PG8_STAGE(PG8_SB(1, 0), cB + kstep, voffB); PG8_STAGE(PG8_SA(1, 0), cA + kstep, voffA); PG8_STAGE(PG8_SB(1, 1), cB + hstep + kstep, voffB);
        PG8_WAIT_V(6); PG8_BAR;
    } else {
        PG8_STAGE(PG8_SB(0, 0), cB, voffB); PG8_STAGE(PG8_SA(0, 0), cA, voffA); PG8_STAGE(PG8_SB(0, 1), cB + hstep, voffB); PG8_STAGE(PG8_SA(0, 1), cA + hstep, voffA);
        if (wr == 1) PG8_BAR;
        PG8_WAIT_V(4); PG8_BAR;
        PG8_STAGE(PG8_SB(1, 0), cB + kstep, voffB); PG8_STAGE(PG8_SA(1, 0), cA + kstep, voffA); PG8_STAGE(PG8_SB(1, 1), cB + hstep + kstep, voffB);
        PG8_WAIT_V(6); PG8_BAR;
    }
    for (;;) {
        const bool has_next = S.next(ui + 1, nxt);
        const char* nA = has_next ? (const char*)g.A + (size_t)nxt.pm * tstep : cA; const char* nB = has_next ? (const char*)g.Bt + (size_t)nxt.pn * tstep : cB;
#pragma unroll
        for (int sgi = 0; sgi < Epi::NSEG; ++sgi) {
        const int t_beg = sgi == 0 ? 0 : Epi::seg_end(sgi - 1), t_end = sgi == Epi::NSEG - 1 ? nt : Epi::seg_end(sgi);
        for (int t = t_beg; t < t_end; t += 2) {
            const bool last = (t == nt - 2);
            const char* a1 = cA + (size_t)(t + 1) * kstep;
            const char* a2 = last ? nA : cA + (size_t)(t + 2) * kstep; const char* b2 = last ? nB : cB + (size_t)(t + 2) * kstep;
            const char* a3 = a2 + kstep; const char* b3 = b2 + kstep;
            if (last && has_next) S.a_ready(nxt);
            if constexpr (SP2) {
            PG8_LDB(B0, 0, 0); PG8_LDB(B1, 0, 1); PG8_SCHED; PG8_LDA(At, 0, 0); PG8_STAGE(PG8_SA(1, 1), a1 + hstep, voffA);
            PG8_WAIT_V(8); PG8_WAIT_L(0); PG8_BAR; PG8_MMA(0, 0, At, B0); PG8_MMA(0, 1, At, B1); PG8_BAR; PG8_SCHED;
            PG8_LDA(At, 0, 1); PG8_STAGE(PG8_SB(0, 0), b2, voffB); PG8_STAGE(PG8_SB(0, 1), b2 + hstep, voffB); PG8_STAGE(PG8_SA(0, 0), a2, voffA);
            PG8_WAIT_V(8); PG8_WAIT_L(0); PG8_BAR; PG8_MMA(1, 0, At, B0); PG8_MMA(1, 1, At, B1); PG8_BAR; PG8_SCHED;
            PG8_LDB(B0, 1, 0); PG8_LDB(B1, 1, 1); PG8_SCHED; PG8_LDA(At, 1, 0); PG8_STAGE(PG8_SA(0, 1), a2 + hstep, voffA);
            PG8_WAIT_V(8); PG8_WAIT_L(0); PG8_BAR; PG8_MMA(0, 0, At, B0); PG8_MMA(0, 1, At, B1); PG8_BAR; PG8_SCHED;
            PG8_LDA(At, 1, 1); PG8_STAGE(PG8_SB(1, 0), b3, voffB); PG8_STAGE(PG8_SB(1, 1), b3 + hstep, voffB); PG8_STAGE(PG8_SA(1, 0), a3, voffA);
            PG8_WAIT_V(8); PG8_WAIT_L(0); PG8_BAR; PG8_MMA(1, 0, At, B0); PG8_MMA(1, 1, At, B1); PG8_BAR; PG8_SCHED;
            } else {
            PG8_LDB(B0, 0, 0); PG8_SCHED; PG8_LDA(At, 0, 0); PG8_STAGE(PG8_SA(1, 1), a1 + hstep, voffA);
            PG8_WAIT_L(8); PG8_BAR; PG8_WAIT_L(0); PG8_MMA(0, 0, At, B0); PG8_BAR; PG8_SCHED;
            PG8_LDB(B1, 0, 1); PG8_STAGE(PG8_SB(0, 0), b2, voffB);
            PG8_BAR; PG8_WAIT_L(0); PG8_MMA(0, 1, At, B1); PG8_BAR;
            PG8_LDA(At, 0, 1); PG8_STAGE(PG8_SA(0, 0), a2, voffA);
            PG8_BAR; PG8_WAIT_L(0); PG8_MMA(1, 0, At, B0); PG8_BAR; PG8_SCHED;
            PG8_STAGE(PG8_SB(0, 1), b2 + hstep, voffB);
            PG8_WAIT_V(6); PG8_BAR; PG8_MMA(1, 1, At, B1); PG8_BAR;
            PG8_LDB(B0, 1, 0); PG8_SCHED; PG8_LDA(At, 1, 0); PG8_STAGE(PG8_SA(0, 1), a2 + hstep, voffA);
            PG8_WAIT_L(8); PG8_BAR; PG8_WAIT_L(0); PG8_MMA(0, 0, At, B0); PG8_BAR; PG8_SCHED;
            PG8_LDB(B1, 1, 1); PG8_STAGE(PG8_SB(1, 0), b3, voffB);
            PG8_BAR; PG8_WAIT_L(0); PG8_MMA(0, 1, At, B1); PG8_BAR;
            PG8_LDA(At, 1, 1); PG8_STAGE(PG8_SA(1, 0), a3, voffA);
            PG8_BAR; PG8_WAIT_L(0); PG8_MMA(1, 0, At, B0); PG8_BAR; PG8_SCHED;
            PG8_STAGE(PG8_SB(1, 1), b3 + hstep, voffB);
            PG8_WAIT_V(6); PG8_BAR; PG8_MMA(1, 1, At, B1); PG8_BAR;
            }
        }
        if constexpr (Epi::NSEG > 1) { if (sgi < Epi::NSEG - 1) E.mid(acc, cur, sgi, wr, wc, fr, fq); }
        }
        if constexpr (ALIGN_EPI) { if (wr == 0) PG8_BAR; }
        E(acc, cur, wr, wc, fr, fq); S.done(cur);
        if (!has_next) break;
#pragma unroll
        for (int a = 0; a < 2; ++a)
#pragma unroll
            for (int b = 0; b < 2; ++b)
#pragma unroll
                for (int m = 0; m < 4; ++m)
#pragma unroll
                    for (int n = 0; n < 2; ++n) acc[a][b][m][n] = (f32x4){0.f, 0.f, 0.f, 0.f};
        cur = nxt; cA = nA; cB = nB; ++ui;
        if constexpr (ALIGN_EPI) { if (wr == 1) PG8_BAR; }
    }
    PG8_WAIT_V(0);
    if constexpr (!ALIGN_EPI) { if (wr == 0) PG8_BAR; }
    PG8_BAR;
#undef PG8_SA
#undef PG8_SB
#undef PG8_STAGE
#undef PG8_LDA
#undef PG8_LDB
#undef PG8_MMA
#undef PG8_WAIT_V
#undef PG8_WAIT_L
#undef PG8_BAR
#undef PG8_SCHED
}

struct EpiStoreBf16 {
    static constexpr bool PERM = true; static constexpr int NSEG = 1; static constexpr int seg_end(int) { return 0; }
    bf16_t* O; int ldc;
    __device__ __forceinline__ void operator()(f32x4 (&acc)[2][2][4][2], const Unit& u, int wr, int wc, int fr, int fq) const {
        bf16_t* base = O + (size_t)(u.pm * BM + wr * 64 + fr) * ldc + u.pn * BM + wc * 32 + 8 * fq;
#pragma unroll
        for (int ai = 0; ai < 2; ++ai)
#pragma unroll
            for (int m = 0; m < 4; ++m) { bf16_t* rowp = base + (size_t)(ai * HALF + m * 16) * ldc;
#pragma unroll
                for (int bj = 0; bj < 2; ++bj) { const f32x4 v0 = acc[ai][bj][m][0], v1 = acc[ai][bj][m][1];
                    u32x4 w; w.x = pk_act(v0[0], v0[1]); w.y = pk_act(v0[2], v0[3]); w.z = pk_act(v1[0], v1[1]); w.w = pk_act(v1[2], v1[3]);
                    *(u32x4*)(rowp + bj * HALF) = w; } }
    }
};
struct EpiDft {
    static constexpr bool PERM = true; static constexpr int NSEG = 1; static constexpr int seg_end(int) { return 0; }
    bf16_t* AM; int tshift, tokbase;
    __device__ __forceinline__ void operator()(f32x4 (&acc)[2][2][4][2], const Unit& u, int wr, int wc, int fr, int fq) const {
        const int k0 = u.pm * BM, part = k0 >> tshift, kk0 = k0 & ((1 << tshift) - 1), b = u.pn >> 2, ch0 = (u.pn & 3) * BM;
        bf16_t* base = AM + (size_t)(tokbase + (b << tshift) + kk0 + wr * 64 + fr) * KMRG + part * 1024 + ch0 + wc * 32 + 8 * fq;
#pragma unroll
        for (int ai = 0; ai < 2; ++ai)
#pragma unroll
            for (int m = 0; m < 4; ++m) { bf16_t* rowp = base + (size_t)(ai * HALF + m * 16) * KMRG;
#pragma unroll
                for (int bj = 0; bj < 2; ++bj) { const f32x4 v0 = acc[ai][bj][m][0], v1 = acc[ai][bj][m][1];
                    u32x4 w; w.x = pk_act(v0[0], v0[1]); w.y = pk_act(v0[2], v0[3]); w.z = pk_act(v1[0], v1[1]); w.w = pk_act(v1[2], v1[3]);
                    *(u32x4*)(rowp + bj * HALF) = w; } }
    }
};
struct EpiMerged {
    static constexpr bool PERM = true; static constexpr int NSEG = 3; static constexpr int seg_end(int s) { return s == 0 ? 32 : 48; }
    bf16_t* O; const bf16_t* Z;
    __device__ __forceinline__ void scale_by(f32x4 (&acc)[2][2][4][2], const Unit& u, int wr, int wc, int fr, int fq, int gnum, int gden) const {
        int lo_ = fr * NZ + 8 * fq; asm volatile("" : "+v"(lo_));
        const bf16_t* zb = Z + (size_t)(u.pm * BM + wr * 64) * NZ + ZGATE + u.pn * BM + wc * 32 + lo_;
#pragma unroll
        for (int ai = 0; ai < 2; ++ai)
#pragma unroll
            for (int m = 0; m < 4; ++m) { const bf16_t* zr = zb + (size_t)(ai * HALF + m * 16) * NZ;
#pragma unroll
                for (int bj = 0; bj < 2; ++bj) {
                    const u32x4 gn = *(const u32x4*)(zr + gnum * DM + bj * HALF);
                    u32x4 gd = (u32x4){0u, 0u, 0u, 0u}; if (gden >= 0) gd = *(const u32x4*)(zr + gden * DM + bj * HALF);
                    float s[8];
#pragma unroll
                    for (int q = 0; q < 4; ++q) {
                        const float n0 = 1.f + __expf(-lo_act(gn[q])), n1 = 1.f + __expf(-hi_act(gn[q]));
                        float d0 = 1.f, d1 = 1.f; if (gden >= 0) { d0 = 1.f + __expf(-lo_act(gd[q])); d1 = 1.f + __expf(-hi_act(gd[q])); }
                        s[2 * q] = d0 * __builtin_amdgcn_rcpf(n0); s[2 * q + 1] = d1 * __builtin_amdgcn_rcpf(n1); }
                    f32x4 v0 = acc[ai][bj][m][0], v1 = acc[ai][bj][m][1];
                    v0[0] *= s[0]; v0[1] *= s[1]; v0[2] *= s[2]; v0[3] *= s[3]; v1[0] *= s[4]; v1[1] *= s[5]; v1[2] *= s[6]; v1[3] *= s[7];
                    acc[ai][bj][m][0] = v0; acc[ai][bj][m][1] = v1; }
                asm volatile("" ::: "memory"); }
    }
    __device__ __forceinline__ void mid(f32x4 (&acc)[2][2][4][2], const Unit& u, int s, int wr, int wc, int fr, int fq) const {
        if (s == 0) scale_by(acc, u, wr, wc, fr, fq, 0, 1); else scale_by(acc, u, wr, wc, fr, fq, 1, 2);
    }
    __device__ __forceinline__ void operator()(f32x4 (&acc)[2][2][4][2], const Unit& u, int wr, int wc, int fr, int fq) const {
        scale_by(acc, u, wr, wc, fr, fq, 2, -1);
        bf16_t* base = O + (size_t)(u.pm * BM + wr * 64 + fr) * DM + u.pn * BM + wc * 32 + 8 * fq;
#pragma unroll
        for (int ai = 0; ai < 2; ++ai)
#pragma unroll
            for (int m = 0; m < 4; ++m) { bf16_t* rowp = base + (size_t)(ai * HALF + m * 16) * DM;
#pragma unroll
                for (int bj = 0; bj < 2; ++bj) { const f32x4 v0 = acc[ai][bj][m][0], v1 = acc[ai][bj][m][1];
                    u32x4 w; w.x = pk_act(v0[0], v0[1]); w.y = pk_act(v0[2], v0[3]); w.z = pk_act(v1[0], v1[1]); w.w = pk_act(v1[2], v1[3]);
                    *(u32x4*)(rowp + bj * HALF) = w; } }
    }
};
struct EpiResid {
    static constexpr bool PERM = false; static constexpr int NSEG = 1; static constexpr int seg_end(int) { return 0; }
    float* X; const float* gate;
    __device__ __forceinline__ void operator()(f32x4 (&acc)[2][2][4][2], const Unit& u, int wr, int wc, int fr, int fq) const {
        const int col0 = u.pn * BM + wc * 32 + 4 * fq, row0 = u.pm * BM + wr * 64 + fr;
        const float* gp = gate + (size_t)mod_row(u.pm * BM) * NMOD + col0;
        f32x4 gv[2][2];
#pragma unroll
        for (int bj = 0; bj < 2; ++bj)
#pragma unroll
            for (int n = 0; n < 2; ++n) gv[bj][n] = *(const f32x4*)(gp + bj * HALF + n * 16);
#pragma unroll
        for (int ai = 0; ai < 2; ++ai)
#pragma unroll
            for (int m = 0; m < 4; ++m) { float* rowp = X + (size_t)(row0 + ai * HALF + m * 16) * DM + col0;
#pragma unroll
                for (int bj = 0; bj < 2; ++bj)
#pragma unroll
                    for (int n = 0; n < 2; ++n) { f32x4 x = *(const f32x4*)(rowp + bj * HALF + n * 16); x = x + gv[bj][n] * acc[ai][bj][m][n]; *(f32x4*)(rowp + bj * HALF + n * 16) = x; }
                asm volatile("" ::: "memory"); }
    }
};
}

namespace att {
constexpr int D = 128, NW = 8, QBLK = 32, KVBLK = 64;
constexpr float SCALE = 0.088388347648318440f;
constexpr float THR = 8.f;
constexpr int LDQ = 1024, LDK = 256, LDO = KMRG;
constexpr int SHM_V = KVBLK * D * 2, SHM_K = KVBLK * D * 2, SHM_ATTN = 2 * SHM_V + 2 * SHM_K + NW * 64 * 4;
typedef __attribute__((ext_vector_type(4))) short s16x4;
typedef __attribute__((ext_vector_type(16))) float f32x16;
#define KSWZ(row, colB) ((row) * 256 + ((colB) ^ (((row) & 7) << 4)))
#define SBAR() __builtin_amdgcn_sched_barrier(0)
__device__ __forceinline__ int crow(int r, int hi) { return (r & 3) + 8 * (r >> 2) + 4 * hi; }

__device__ __forceinline__ void partialSM(f32x16& p0, f32x16& p1, float& m_reg, float& mn, float& alpha) {
  constexpr float C = SCALE * 1.4426950408889634f;
  float pmax = p0[0];
#pragma unroll
  for (int r = 1; r < 16; ++r) pmax = fmaxf(pmax, p0[r]);
#pragma unroll
  for (int r = 0; r < 16; ++r) pmax = fmaxf(pmax, p1[r]);
  { auto rr = __builtin_amdgcn_permlane32_swap(__float_as_uint(pmax), __float_as_uint(pmax), false, false);
    pmax = fmaxf(__uint_as_float(rr[0]), __uint_as_float(rr[1])); }
  if (__builtin_expect(__all(pmax - m_reg <= THR / SCALE), 1)) { mn = m_reg; alpha = 1.f; }
  else { mn = fmaxf(m_reg, pmax); alpha = __builtin_amdgcn_exp2f((m_reg - mn) * C); m_reg = mn; }
  float mnC = -mn * C;
#pragma unroll
  for (int r = 0; r < 16; ++r) p0[r] = fmaf(p0[r], C, mnC);
#pragma unroll
  for (int r = 0; r < 16; ++r) p1[r] = fmaf(p1[r], C, mnC);
#pragma unroll
  for (int r = 0; r < 16; ++r) p0[r] = __builtin_amdgcn_exp2f(p0[r]);
}
__device__ __forceinline__ void finishSM(f32x16& p0, f32x16& p1, float alpha, float& l_reg, bf16x8& pa0, bf16x8& pa1, bf16x8& pa2, bf16x8& pa3) {
#pragma unroll
  for (int r = 0; r < 16; ++r) p1[r] = __builtin_amdgcn_exp2f(p1[r]);
  float ps = 0;
#pragma unroll
  for (int r = 0; r < 16; ++r) ps += p0[r];
#pragma unroll
  for (int r = 0; r < 16; ++r) ps += p1[r];
  { auto rr = __builtin_amdgcn_permlane32_swap(__float_as_uint(ps), __float_as_uint(ps), false, false);
    ps = __uint_as_float(rr[0]) + __uint_as_float(rr[1]); }
  l_reg = l_reg * alpha + ps;
#define PK4(P, BASE, OUT) do { unsigned a0 = pk_act(P[BASE + 0], P[BASE + 1]), a1 = pk_act(P[BASE + 2], P[BASE + 3]);   \
    unsigned b0 = pk_act(P[BASE + 4], P[BASE + 5]), b1 = pk_act(P[BASE + 6], P[BASE + 7]);                              \
    auto r0 = __builtin_amdgcn_permlane32_swap(a0, b0, false, false); auto r1 = __builtin_amdgcn_permlane32_swap(a1, b1, false, false); \
    u32x4 w = {r0[0], r1[0], r0[1], r1[1]}; OUT = *reinterpret_cast<bf16x8*>(&w); } while (0)
  PK4(p0, 0, pa0); PK4(p0, 8, pa1); PK4(p1, 0, pa2); PK4(p1, 8, pa3);
#undef PK4
}
__device__ __forceinline__ void qkt(f32x16& p0, f32x16& p1, const LAS char* Ks, const bf16x8* qr, int r32, int hi) {
  p0 = f32x16{}; p1 = f32x16{};
#pragma unroll
  for (int d0 = 0; d0 < 8; ++d0) { int cb = (d0 * 16 + hi * 8) * 2;
    bf16x8 b0 = *reinterpret_cast<const LAS bf16x8*>(Ks + KSWZ(r32, cb));
    bf16x8 b1 = *reinterpret_cast<const LAS bf16x8*>(Ks + KSWZ(32 + r32, cb));
    p0 = mma32_act(b0, qr[d0], p0);
    p1 = mma32_act(b1, qr[d0], p1); }
}
__device__ __forceinline__ int v_st(int k, int c) { const int kk = (k & ~0xC) | ((k & 4) << 1) | ((k & 8) >> 1); return ((kk >> 3) * 4 + (c >> 5)) * 512 + ((kk & 7) * 32 + (c & 31)) * 2; }
__device__ __forceinline__ int v_rd_base(int lane) { return ((lane & 3) << 3) | (((lane >> 2) & 3) << 6) | (((lane >> 4) & 1) << 5) | (((lane >> 5) & 1) << 8); }
constexpr int v_rd_off(int d0, int ks, int half) { return d0 * 512 + ks * 4096 + half * 2048; }
template <int OFF> __device__ __forceinline__ s16x4 tr_read(int vb) {
  s16x4 r; asm volatile("ds_read_b64_tr_b16 %0, %1 offset:%2" : "=&v"(r) : "v"(vb), "i"(OFF) : "memory"); return r;
}
template <int D0> __device__ __forceinline__ void pv_one(f32x16& od, int vb, bf16x8 pa0, bf16x8 pa1, bf16x8 pa2, bf16x8 pa3) {
  const s16x4 l0 = tr_read<v_rd_off(D0, 0, 0)>(vb), h0 = tr_read<v_rd_off(D0, 0, 1)>(vb), l1 = tr_read<v_rd_off(D0, 1, 0)>(vb), h1 = tr_read<v_rd_off(D0, 1, 1)>(vb);
  const s16x4 l2 = tr_read<v_rd_off(D0, 2, 0)>(vb), h2 = tr_read<v_rd_off(D0, 2, 1)>(vb), l3 = tr_read<v_rd_off(D0, 3, 0)>(vb), h3 = tr_read<v_rd_off(D0, 3, 1)>(vb);
  asm volatile("s_waitcnt lgkmcnt(0)" ::: "memory"); SBAR();
#define PK(L, H) (bf16x8){L[0], L[1], L[2], L[3], H[0], H[1], H[2], H[3]}
  od = mma32_act(pa0, PK(l0, h0), od);
  od = mma32_act(pa1, PK(l1, h1), od);
  od = mma32_act(pa2, PK(l2, h2), od);
  od = mma32_act(pa3, PK(l3, h3), od);
#undef PK
}
__device__ __forceinline__ void pv_d0(f32x16* o, int vb, bf16x8 pa0, bf16x8 pa1, bf16x8 pa2, bf16x8 pa3) {
  pv_one<0>(o[0], vb, pa0, pa1, pa2, pa3); pv_one<1>(o[1], vb, pa0, pa1, pa2, pa3); pv_one<2>(o[2], vb, pa0, pa1, pa2, pa3); pv_one<3>(o[3], vb, pa0, pa1, pa2, pa3);
}

__device__ __forceinline__ void attn_dense_body(const bf16* __restrict__ Qb, const bf16* __restrict__ Kh, const bf16* __restrict__ Vh,
                                                bf16* __restrict__ Ob, int seq, LAS char* lds) {
  const int tid = opaque_tid(), wid = tid >> 6, lane = tid & 63, r32 = lane & 31, hi = lane >> 5;
  LAS char* V_lds = lds; LAS char* K_lds = lds + 2 * SHM_V;
  LAS float* ws = (LAS float*)(lds + 2 * SHM_V + 2 * SHM_K) + wid * 64; LAS float* li_l = ws; LAS float* al_l = ws + 32;
  float m_reg = -1e30f, l_reg = 0; f32x16 o[4] = {}; bf16x8 qr[8];
  { const bf16* Qw = Qb + (long)(wid * QBLK + r32) * LDQ + hi * 8;
#pragma unroll
    for (int d0 = 0; d0 < 8; ++d0) qr[d0] = *reinterpret_cast<const bf16x8*>(Qw + d0 * 16); }
  const int sr = tid >> 4, sc = (tid & 15) * 8, vst0 = v_st(sr, sc), vst1 = v_st(32 + sr, sc);
  const int vb0 = (int)(unsigned)(uintptr_t)V_lds + v_rd_base(lane);
  struct { bf16x8 vs0, vs1, ks0, ks1; } sr_[2];
#define SLOAD(i, k0) do { sr_[i].vs0 = *reinterpret_cast<const bf16x8*>(&Vh[(long)((k0) + sr) * LDK + sc]); sr_[i].vs1 = *reinterpret_cast<const bf16x8*>(&Vh[(long)((k0) + 32 + sr) * LDK + sc]); \
    sr_[i].ks0 = *reinterpret_cast<const bf16x8*>(&Kh[(long)((k0) + sr) * LDK + sc]); sr_[i].ks1 = *reinterpret_cast<const bf16x8*>(&Kh[(long)((k0) + 32 + sr) * LDK + sc]); } while (0)
#define SWRITE(b, i) do { *(LAS bf16x8*)(V_lds + (b) * SHM_V + vst0) = sr_[i].vs0;          \
    *(LAS bf16x8*)(V_lds + (b) * SHM_V + vst1) = sr_[i].vs1; int kc = sc * 2;               \
    *(LAS bf16x8*)(K_lds + (b) * SHM_K + KSWZ(sr, kc)) = sr_[i].ks0;                       \
    *(LAS bf16x8*)(K_lds + (b) * SHM_K + KSWZ(32 + sr, kc)) = sr_[i].ks1; } while (0)
#define SWAIT() asm volatile("s_waitcnt vmcnt(4)" ::: "memory")
#define RESC(a) do { if (__any((a) < 1.f)) { if (hi == 0) al_l[r32] = (a); asm volatile("s_waitcnt lgkmcnt(0)" ::: "memory"); \
    _Pragma("unroll") for (int d = 0; d < 4; ++d) _Pragma("unroll") for (int r = 0; r < 16; ++r) o[d][r] *= al_l[crow(r, hi)]; } } while (0)
  f32x16 pA0, pA1, pB0, pB1; float mnA, mnB, alA, alB; bf16x8 pa0, pa1, pa2, pa3; const int NT = seq / KVBLK;
  constexpr int SE = 0, SO = 1;
  SLOAD(SE, 0); asm volatile("s_waitcnt vmcnt(0)" ::: "memory"); SWRITE(0, SE); __syncthreads();
  qkt(pA0, pA1, K_lds, qr, r32, hi); partialSM(pA0, pA1, m_reg, mnA, alA);
  SLOAD(SO, KVBLK); if (2 < NT) SLOAD(SE, 2 * KVBLK);
  SWAIT(); SWRITE(1, SO); __syncthreads();
  for (int j = 1; j + 1 < NT; j += 2) {
    SBAR(); qkt(pB0, pB1, K_lds + SHM_K, qr, r32, hi);
    finishSM(pA0, pA1, alA, l_reg, pa0, pa1, pa2, pa3); SBAR();
    SLOAD(SO, (j + 2) * KVBLK); SBAR();
    pv_d0(o, vb0, pa0, pa1, pa2, pa3); partialSM(pB0, pB1, m_reg, mnB, alB);
    __syncthreads(); SWAIT(); SWRITE(0, SE);
    RESC(alB); __syncthreads();
    SBAR(); qkt(pA0, pA1, K_lds, qr, r32, hi);
    finishSM(pB0, pB1, alB, l_reg, pa0, pa1, pa2, pa3); SBAR();
    if (j + 3 < NT) SLOAD(SE, (j + 3) * KVBLK); SBAR();
    pv_d0(o, vb0 + (int)SHM_V, pa0, pa1, pa2, pa3); partialSM(pA0, pA1, m_reg, mnA, alA);
    __syncthreads(); SWAIT(); SWRITE(1, SO);
    RESC(alA); __syncthreads();
  }
  SBAR(); qkt(pB0, pB1, K_lds + SHM_K, qr, r32, hi);
  finishSM(pA0, pA1, alA, l_reg, pa0, pa1, pa2, pa3); SBAR();
  pv_d0(o, vb0, pa0, pa1, pa2, pa3); partialSM(pB0, pB1, m_reg, mnB, alB);
  __syncthreads(); RESC(alB);
  finishSM(pB0, pB1, alB, l_reg, pa0, pa1, pa2, pa3); SBAR();
  pv_d0(o, vb0 + (int)SHM_V, pa0, pa1, pa2, pa3);
  if (hi == 0) li_l[r32] = l_reg; asm volatile("s_waitcnt lgkmcnt(0)" ::: "memory");
  float rli[16];
#pragma unroll
  for (int r = 0; r < 16; ++r) rli[r] = __builtin_amdgcn_rcpf(li_l[crow(r, hi)]);
  bf16* Ow = Ob + (long)(wid * QBLK) * LDO;
#pragma unroll
  for (int r = 0; r < 16; ++r) { int orow = crow(r, hi);
#pragma unroll
    for (int d0 = 0; d0 < 4; ++d0) Ow[(long)orow * LDO + d0 * 32 + r32] = f2act(o[d0][r] * rli[r]); }
  __syncthreads();
#undef SLOAD
#undef SWRITE
#undef SWAIT
#undef RESC
}
#undef KSWZ
#undef SBAR
}

namespace gla {
constexpr int L_LA = 0;
constexpr int L_TOT = L_LA + 64 * 132 * 4;
constexpr int L_EB = L_TOT + 2048;
constexpr int L_WG = L_EB + 512;
constexpr int L_BG = L_WG + 8192;
constexpr int L_QE = L_BG + 512;
constexpr int L_KE = L_QE + 64 * 136 * 2;
constexpr int L_SB = L_KE + 64 * 136 * 2;
constexpr int L_KLT = L_SB + 64 * 136 * 2;
constexpr int L_VT = L_KLT + 128 * 72 * 2;
constexpr int L_ATT = L_VT + 64 * 72 * 2;
constexpr int L_END = L_ATT + 64 * 72 * 2;
static_assert(L_END <= MISC_OFF, "GLA LDS map");

__device__ __forceinline__ float log_sigmoid(float x) { return fminf(x, 0.f) - __logf(1.f + __expf(-fabsf(x))); }
__device__ __forceinline__ f32x4 mma16(bf16x8 a, bf16x8 b, f32x4 c) { return __builtin_amdgcn_mfma_f32_16x16x32_bf16(a, b, c, 0, 0, 0); }

__device__ __forceinline__ void gla_item(LAS unsigned char* lds, const bf16* __restrict__ Z, float* __restrict__ OUT, const float* __restrict__ wg, const float* __restrict__ bg,
                                         const float* __restrict__ st_in, float* __restrict__ st_out, int T, int tokbase, int h, int dir, int dvq) {
    const int tid = opaque_tid(), lane = tid & 63, w = __builtin_amdgcn_readfirstlane(tid >> 6), fr = lane & 15, fq = lane >> 4;
    LAS float* LA = (LAS float*)(lds + L_LA); LAS float* TOT = (LAS float*)(lds + L_TOT); LAS float* EB = (LAS float*)(lds + L_EB);
    LAS float* WG = (LAS float*)(lds + L_WG); LAS float* BG = (LAS float*)(lds + L_BG);
    LAS unsigned char* QE = lds + L_QE; LAS unsigned char* KE = lds + L_KE; LAS unsigned char* SB = lds + L_SB;
    LAS unsigned char* KLT = lds + L_KLT; LAS unsigned char* VT = lds + L_VT; LAS unsigned char* ATT = lds + L_ATT;
    const int NC = T >> 6;
    for (int idx = tid; idx < 16 * 128; idx += 512) WG[idx] = wg[(idx >> 7) * 512 + (idx & 127)];
    if (tid < 128) BG[tid] = bg[tid];
    f32x4 S[4];
    const int soff = (16 * w + 4 * fq) * 256 + dvq * 64 + fr;
#pragma unroll
    for (int n = 0; n < 4; ++n) S[n] = (f32x4){0.f, 0.f, 0.f, 0.f};
    if (st_in) {
#pragma unroll
        for (int n = 0; n < 4; ++n)
#pragma unroll
            for (int r = 0; r < 4; ++r) S[n][r] = st_in[soff + r * 256 + n * 16];
    }
    const int i0 = tid >> 4, g8 = tid & 15;
    const int iv = tid >> 3, vg = tid & 7;
    const int gacol = dir ? ZGAB : ZGAF;
    u32x4 rq[2], rk[2], rga[2][2], rv;
#define GLA_ROW(c, i) ((size_t)(tokbase + (dir ? (T - 1 - ((c) * 64 + (i))) : ((c) * 64 + (i)))))
#define GLA_LOAD(c) do { _Pragma("unroll") for (int e = 0; e < 2; ++e) { const bf16* zr = Z + GLA_ROW(c, i0 + 32 * e) * NZ; \
        rq[e] = *(const u32x4*)(zr + ZGQ + h * 128 + g8 * 8); rk[e] = *(const u32x4*)(zr + ZGK + h * 128 + g8 * 8); \
        rga[e][0] = *(const u32x4*)(zr + gacol); rga[e][1] = *(const u32x4*)(zr + gacol + 8); } \
        rv = *(const u32x4*)(Z + GLA_ROW(c, iv) * NZ + ZGV + h * 256 + dvq * 64 + vg * 8); } while (0)
    GLA_LOAD(0);
    __syncthreads();
    for (int c = 0; c < NC; ++c) {
#pragma unroll
        for (int e = 0; e < 2; ++e) {
            float x[8];
            { const f32x4 b0 = *(const LAS f32x4*)(BG + g8 * 8), b1 = *(const LAS f32x4*)(BG + g8 * 8 + 4);
#pragma unroll
              for (int j = 0; j < 4; ++j) { x[j] = b0[j]; x[4 + j] = b1[j]; } }
#pragma unroll
            for (int r = 0; r < 16; ++r) { const unsigned wd = rga[e][r >> 3][(r & 7) >> 1]; const float gar = (r & 1) ? hi_act(wd) : lo_act(wd);
                const f32x4 w0 = *(const LAS f32x4*)(WG + r * 128 + g8 * 8), w1 = *(const LAS f32x4*)(WG + r * 128 + g8 * 8 + 4);
#pragma unroll
                for (int j = 0; j < 4; ++j) { x[j] = fmaf(gar, w0[j], x[j]); x[4 + j] = fmaf(gar, w1[j], x[4 + j]); }
                if (r & 1) asm volatile("" ::: "memory"); }
            f32x4 o0, o1;
#pragma unroll
            for (int j = 0; j < 4; ++j) { o0[j] = log_sigmoid(x[j]) * 0.0625f; o1[j] = log_sigmoid(x[4 + j]) * 0.0625f; }
            *(LAS f32x4*)(LA + (i0 + 32 * e) * 132 + g8 * 8) = o0; *(LAS f32x4*)(LA + (i0 + 32 * e) * 132 + g8 * 8 + 4) = o1;
        }
        __syncthreads();
        { const int d = tid & 127, seg = tid >> 7; float run = 0.f;
#pragma unroll
          for (int ii = 0; ii < 16; ++ii) { run += LA[(seg * 16 + ii) * 132 + d]; LA[(seg * 16 + ii) * 132 + d] = run; }
          TOT[seg * 128 + d] = run; }
        __syncthreads();
        {
            float t0[8], t1[8], t2[8], t3[8];
            { const f32x4 a0 = *(const LAS f32x4*)(TOT + g8 * 8), a1 = *(const LAS f32x4*)(TOT + g8 * 8 + 4), b0 = *(const LAS f32x4*)(TOT + 128 + g8 * 8), b1 = *(const LAS f32x4*)(TOT + 128 + g8 * 8 + 4);
              const f32x4 c0 = *(const LAS f32x4*)(TOT + 256 + g8 * 8), c1 = *(const LAS f32x4*)(TOT + 256 + g8 * 8 + 4), d0 = *(const LAS f32x4*)(TOT + 384 + g8 * 8), d1 = *(const LAS f32x4*)(TOT + 384 + g8 * 8 + 4);
#pragma unroll
              for (int j = 0; j < 4; ++j) { t0[j] = a0[j]; t0[4 + j] = a1[j]; t1[j] = b0[j]; t1[4 + j] = b1[j]; t2[j] = c0[j]; t2[4 + j] = c1[j]; t3[j] = d0[j]; t3[4 + j] = d1[j]; } }
            float blast[8];
#pragma unroll
            for (int j = 0; j < 8; ++j) blast[j] = (t0[j] + t1[j]) + (t2[j] + t3[j]);
            if (tid < 16) {
#pragma unroll
                for (int j = 0; j < 8; ++j) EB[g8 * 8 + j] = __expf(blast[j]); }
#pragma unroll
            for (int e = 0; e < 2; ++e) {
                const int i = i0 + 32 * e, seg = i >> 4;
                const f32x4 l0 = *(const LAS f32x4*)(LA + i * 132 + g8 * 8), l1 = *(const LAS f32x4*)(LA + i * 132 + g8 * 8 + 4);
                float bq[8], kl[8], qe[8], ke[8], qv[8], kv[8];
#pragma unroll
                for (int q = 0; q < 4; ++q) { qv[2 * q] = lo_act(rq[e][q]); qv[2 * q + 1] = hi_act(rq[e][q]); kv[2 * q] = lo_act(rk[e][q]); kv[2 * q + 1] = hi_act(rk[e][q]); }
#pragma unroll
                for (int j = 0; j < 8; ++j) { float off = 0.f; if (seg > 0) off += t0[j]; if (seg > 1) off += t1[j]; if (seg > 2) off += t2[j];
                    bq[j] = (j < 4 ? l0[j] : l1[j - 4]) + off;
                    qe[j] = qv[j] * 0.088388347648318440f * __expf(bq[j]); ke[j] = kv[j] * __expf(-bq[j]); kl[j] = kv[j] * __expf(blast[j] - bq[j]); }
                u32x4 wq = {cvt_pk_bf16(qe[0], qe[1]), cvt_pk_bf16(qe[2], qe[3]), cvt_pk_bf16(qe[4], qe[5]), cvt_pk_bf16(qe[6], qe[7])};
                u32x4 wk = {cvt_pk_bf16(ke[0], ke[1]), cvt_pk_bf16(ke[2], ke[3]), cvt_pk_bf16(ke[4], ke[5]), cvt_pk_bf16(ke[6], ke[7])};
                *(LAS u32x4*)(QE + i * 272 + g8 * 16) = wq; *(LAS u32x4*)(KE + i * 272 + g8 * 16) = wk;
#pragma unroll
                for (int j = 0; j < 8; ++j) *(LAS bf16*)(KLT + (g8 * 8 + j) * 144 + i * 2) = f2bf(kl[j]);
            }
#pragma unroll
            for (int q = 0; q < 4; ++q) { *(LAS bf16*)(VT + (vg * 8 + 2 * q) * 144 + iv * 2) = f2bf(lo_act(rv[q])); *(LAS bf16*)(VT + (vg * 8 + 2 * q + 1) * 144 + iv * 2) = f2bf(hi_act(rv[q])); }
#pragma unroll
            for (int n = 0; n < 4; ++n) { u32x2 ws2 = {cvt_pk_bf16(S[n][0], S[n][1]), cvt_pk_bf16(S[n][2], S[n][3])}; *(LAS u32x2*)(SB + (n * 16 + fr) * 272 + (16 * w + 4 * fq) * 2) = ws2; }
        }
        if (c + 1 < NC) GLA_LOAD(c + 1);
        __syncthreads();
        { const int ti = w >> 1;
#pragma unroll
          for (int jj = 0; jj < 2; ++jj) { const int tj = (w & 1) * 2 + jj; f32x4 a = {0.f, 0.f, 0.f, 0.f};
              if (tj <= ti) {
#pragma unroll
                  for (int ks = 0; ks < 4; ++ks) { const bf16x8 af = *(const LAS bf16x8*)(QE + (ti * 16 + fr) * 272 + (ks * 32 + fq * 8) * 2), bfr = *(const LAS bf16x8*)(KE + (tj * 16 + fr) * 272 + (ks * 32 + fq * 8) * 2);
                      a = mma16(af, bfr, a); } }
#pragma unroll
              for (int r = 0; r < 4; ++r) { const int i = ti * 16 + 4 * fq + r, j = tj * 16 + fr; *(LAS bf16*)(ATT + i * 144 + j * 2) = f2bf(j <= i ? a[r] : 0.f); } } }
        __syncthreads();
        { const int ti = w >> 1;
#pragma unroll
          for (int jj = 0; jj < 2; ++jj) { const int tn = (w & 1) * 2 + jj; f32x4 a = {0.f, 0.f, 0.f, 0.f};
#pragma unroll
              for (int ks = 0; ks < 4; ++ks) { const bf16x8 af = *(const LAS bf16x8*)(QE + (ti * 16 + fr) * 272 + (ks * 32 + fq * 8) * 2), bfr = *(const LAS bf16x8*)(SB + (tn * 16 + fr) * 272 + (ks * 32 + fq * 8) * 2);
                  a = mma16(af, bfr, a); }
#pragma unroll
              for (int ks = 0; ks < 2; ++ks) { const bf16x8 af = *(const LAS bf16x8*)(ATT + (ti * 16 + fr) * 144 + (ks * 32 + fq * 8) * 2), bfr = *(const LAS bf16x8*)(VT + (tn * 16 + fr) * 144 + (ks * 32 + fq * 8) * 2);
                  a = mma16(af, bfr, a); }
#pragma unroll
              for (int r = 0; r < 4; ++r) { const int i = ti * 16 + 4 * fq + r; OUT[GLA_ROW(c, i) * 1024 + h * 256 + dvq * 64 + tn * 16 + fr] = a[r]; } } }
        { const f32x4 eb = *(const LAS f32x4*)(EB + 16 * w + 4 * fq);
#pragma unroll
          for (int n = 0; n < 4; ++n) { S[n] = S[n] * eb;
#pragma unroll
              for (int ks = 0; ks < 2; ++ks) { const bf16x8 af = *(const LAS bf16x8*)(KLT + (16 * w + fr) * 144 + (ks * 32 + fq * 8) * 2), bfr = *(const LAS bf16x8*)(VT + (n * 16 + fr) * 144 + (ks * 32 + fq * 8) * 2);
                  S[n] = mma16(af, bfr, S[n]); } } }
    }
    if (st_out) {
        int fr2 = fr; asm volatile("" : "+v"(fr2));
        const int soff2 = (16 * w + 4 * fq) * 256 + dvq * 64 + fr2;
#pragma unroll
        for (int n = 0; n < 4; ++n)
#pragma unroll
            for (int r = 0; r < 4; ++r) {
#ifdef MK_PROBE_SSCALE
                st_out[soff2 + r * 256 + n * 16] = S[n][r] * MK_PROBE_SSCALE;
#else
                st_out[soff2 + r * 256 + n * 16] = S[n][r];
#endif
            }
    }
    __syncthreads();
#undef GLA_ROW
#undef GLA_LOAD
}
}

#define XB_TMO      128
#define XB_XCNT(j)  (256  + 64 * (j))
#define XB_XSUB(j)  (1280 + 64 * (j))
#define XB_XGEN(j)  (2304 + 64 * (j))
#define XB_TOP      3328
#define XB_TOPGEN   3392
#define XCD_BAR_WORDS 3456
#define XB_SPIN_CAP (1u << 18)
__device__ __forceinline__ unsigned xb_ld(unsigned* p)              { return __hip_atomic_load(p, __ATOMIC_RELAXED, __HIP_MEMORY_SCOPE_AGENT); }
__device__ __forceinline__ unsigned xb_add(unsigned* p, unsigned v) { return __hip_atomic_fetch_add(p, v, __ATOMIC_RELAXED, __HIP_MEMORY_SCOPE_AGENT); }
__device__ __forceinline__ unsigned xb_xcc_id() { return (unsigned)__builtin_amdgcn_s_getreg((3 << 11) | 20) & 0xFu; }
#define XB_SPIN(cond, bar) do { unsigned _sp = 0; while (cond) { __builtin_amdgcn_s_sleep(1); \
    if ((++_sp & 255u) == 0u) { if (xb_ld(&(bar)[XB_TMO])) break; if (_sp > XB_SPIN_CAP) { atomicAdd(&(bar)[XB_TMO], 1u); break; } } } } while (0)
struct XcdBarrier { unsigned* bar; unsigned x; volatile LAS unsigned* st; };
__device__ __forceinline__ XcdBarrier xcd_barrier_post(unsigned* bar, volatile LAS unsigned* st) {
    XcdBarrier b; b.bar = bar; b.x = xb_xcc_id(); b.st = st;
    if (threadIdx.x == 0) (void)xb_add(&bar[XB_XCNT(b.x)], 1u);
    return b;
}
__device__ __forceinline__ void xcd_barrier_complete(unsigned* bar, unsigned x, unsigned& nloc, unsigned& nx) {
    const unsigned G = gridDim.x * gridDim.y * gridDim.z;
    unsigned sum, cnt, mine, sp = 0u;
    for (;;) {
        sum = 0u; cnt = 0u; mine = 0u;
#pragma unroll
        for (unsigned j = 0; j < 16; ++j) { const unsigned c = xb_ld(&bar[XB_XCNT(j)]); sum += c; cnt += (c > 0u) ? 1u : 0u; mine = (j == x) ? c : mine; }
        if (sum == G) break;
        __builtin_amdgcn_s_sleep(1);
        if ((++sp & 255u) == 0u) { if (xb_ld(&bar[XB_TMO])) break; if (sp > XB_SPIN_CAP) { atomicAdd(&bar[XB_TMO], 1u); break; } }
    }
    nloc = mine > 0u ? mine : 1u; nx = cnt > 0u ? cnt : 1u;
}
__device__ __forceinline__ void xcd_barrier(const XcdBarrier& b) {
    asm volatile("s_waitcnt vmcnt(0)" ::: "memory");
    __syncthreads();
    if (threadIdx.x == 0) {
        unsigned* bar = b.bar;
        __builtin_amdgcn_s_waitcnt(0);
        unsigned nloc = b.st[0], nx = b.st[1];
        if (nloc == 0u) { xcd_barrier_complete(bar, b.x, nloc, nx); b.st[0] = nloc; b.st[1] = nx; }
        const unsigned old = xb_add(&bar[XB_XSUB(b.x)], 1u);
        const unsigned gen = old / nloc;
        if (old + 1u == (gen + 1u) * nloc) {
            __builtin_amdgcn_fence(__ATOMIC_RELEASE, "agent");
            asm volatile("s_waitcnt vmcnt(0)" ::: "memory");
            const unsigned og = xb_add(&bar[XB_TOP], 1u);
            const unsigned tg = og / nx;
            if (og + 1u == (tg + 1u) * nx) xb_add(&bar[XB_TOPGEN], 1u);
            else XB_SPIN(xb_ld(&bar[XB_TOPGEN]) == tg, bar);
            __builtin_amdgcn_fence(__ATOMIC_ACQUIRE, "agent");
            xb_add(&bar[XB_XGEN(b.x)], 1u);
            asm volatile("s_waitcnt vmcnt(0)" ::: "memory");
        } else {
            XB_SPIN(xb_ld(&bar[XB_XGEN(b.x)]) == gen, bar);
            __builtin_amdgcn_fence(__ATOMIC_ACQUIRE, "agent");
            asm volatile("s_waitcnt vmcnt(0)" ::: "memory");
        }
    }
    __syncthreads();
}

struct Args {
    const float *x_prompt, *x_sample, *cache_k, *cache_v, *state_f, *state_b, *cvec, *c_ctx, *w_ada, *b_ada, *norm1, *w_in, *q_norm, *k_norm, *w_fourier, *w_attn,
                *w_gate_f, *b_gate_f, *w_gate_b, *b_gate_b, *gla_norm, *w_gla, *w_out, *norm2, *w_up, *conv_w, *conv_b, *w_down, *final_norm;
    float* out; unsigned char* ws;
    int s_lo, s_hi, li, pad;
};
constexpr size_t OUT_YP = 0, OUT_YS = (size_t)NCTX * DM, OUT_CK = (size_t)NTOK * DM, OUT_CV = OUT_CK + (size_t)BCTX * DEPTH * TC * 256,
                 OUT_SF = OUT_CV + (size_t)BCTX * DEPTH * TC * 256, OUT_SB = OUT_SF + (size_t)BCTX * DEPTH * 4 * 128 * 256, OUT_END = OUT_SB + (size_t)BCTX * DEPTH * 4 * 128 * 256;

struct Frame { LAS unsigned char* lds; int tid, lane, wave, G, bid; };
__device__ __forceinline__ Frame frame_now(LAS unsigned char* lds) {
    Frame F; F.lds = lds; F.tid = opaque_tid(); F.lane = F.tid & 63; F.wave = __builtin_amdgcn_readfirstlane(F.tid >> 6); F.G = gridDim.x; F.bid = blockIdx.x; return F; }

__device__ __forceinline__ void transpose_item(const float* __restrict__ W, int N, bf16* __restrict__ WT, int ldd, int koff, int kb, int nb, int row_shift_from, int row_shift, LAS unsigned char* scr, int lane) {
    const int k0 = kb * 128, n0 = nb * 32, c4 = lane & 7, kr = lane >> 3;
#pragma unroll 4
    for (int i = 0; i < 16; ++i) { const int k = 8 * i + kr; const f32x4 v = *(const f32x4*)(W + (size_t)(k0 + k) * N + n0 + 4 * c4);
#pragma unroll
        for (int j = 0; j < 4; ++j) *(LAS bf16*)(scr + (4 * c4 + j) * 272 + k * 2) = f2act(v[j]); }
    LDS_WAIT(); asm volatile("" ::: "memory");
    const int kc = lane & 15;
#pragma unroll
    for (int j = 0; j < 8; ++j) { const int n = (lane >> 4) + 4 * j; const u32x4 o = *(const LAS u32x4*)(scr + n * 272 + kc * 16);
        int row = n0 + n; if (row >= row_shift_from) row += row_shift;
        *(u32x4*)(WT + (size_t)row * ldd + koff + k0 + kc * 8) = o; }
    LDS_WAIT(); asm volatile("" ::: "memory");
}
constexpr int TI_IN = 16 * 369, TI_F = 8 * 64, TI_AT = 8 * 64, TI_GL = 8 * 64, TI_OUT = 16 * 64, TI_UP = 16 * 352, TI_DN = 44 * 64;
constexpr int TI_LAYER = TI_IN + TI_F + TI_AT + TI_GL + TI_OUT + TI_UP + TI_DN;

__device__ __forceinline__ void phase_prologue_a(LAS unsigned char* lds_, const Args& a) {
    const Frame F = frame_now(lds_);
    unsigned char* ws = a.ws;
    {
        LAS unsigned char* scr = F.lds + F.wave * 8704;
        const int gw = F.bid * NWAVES + F.wave, NGW = F.G * NWAVES;
        for (int it = gw; it < DEPTH * TI_LAYER; it += NGW) {
            const int l = it / TI_LAYER; int r = it - l * TI_LAYER;
            if (r < TI_IN) { transpose_item(a.w_in + (size_t)l * DM * N_IN, N_IN, (bf16*)(ws + WS_WIN + l * SZ_WIN), DM, 0, r / 369, r % 369, ZPAD, ZGATE - ZPAD, scr, F.lane); continue; } r -= TI_IN;
            if (r < TI_F) { transpose_item(a.w_fourier + (size_t)l * 1024 * DM, DM, (bf16*)(ws + WS_WFT + l * SZ_WFT), 1024, 0, r / 64, r % 64, 1 << 30, 0, scr, F.lane); continue; } r -= TI_F;
            if (r < TI_AT) { transpose_item(a.w_attn + (size_t)l * 1024 * DM, DM, (bf16*)(ws + WS_WMRG + l * SZ_WMRG), KMRG, 2048, r / 64, r % 64, 1 << 30, 0, scr, F.lane); continue; } r -= TI_AT;
            if (r < TI_GL) { transpose_item(a.w_gla + (size_t)l * 1024 * DM, DM, (bf16*)(ws + WS_WMRG + l * SZ_WMRG), KMRG, 3072, r / 64, r % 64, 1 << 30, 0, scr, F.lane); continue; } r -= TI_GL;
            if (r < TI_OUT) { transpose_item(a.w_out + (size_t)l * DM * DM, DM, (bf16*)(ws + WS_WOUT + l * SZ_WOUT), DM, 0, r / 64, r % 64, 1 << 30, 0, scr, F.lane); continue; } r -= TI_OUT;
            if (r < TI_UP) { transpose_item(a.w_up + (size_t)l * DM * NUP, NUP, (bf16*)(ws + WS_WUP + l * SZ_WUP), DM, 0, r / 352, r % 352, 1 << 30, 0, scr, F.lane); continue; } r -= TI_UP;
            transpose_item(a.w_down + (size_t)l * DFF * DM, DM, (bf16*)(ws + WS_WDN + l * SZ_WDN), DFF, 0, r / 64, r % 64, 1 << 30, 0, scr, F.lane);
        }
    }
    const size_t gt = (size_t)F.bid * 512 + F.tid, NGT = (size_t)F.G * 512;
    for (size_t i = gt; i < (size_t)DEPTH * (ZGATE - ZPAD) * DM / 8; i += NGT) { const size_t l = i / ((ZGATE - ZPAD) * DM / 8), r = i % ((ZGATE - ZPAD) * DM / 8);
        *(u32x4*)(ws + WS_WIN + l * SZ_WIN + (size_t)ZPAD * DM * 2 + r * 16) = (u32x4){0u, 0u, 0u, 0u}; }
    for (size_t i = gt; i < (size_t)2048 * 1024; i += NGT) {
        const int kp = (int)(i >> 10), j = (int)(i & 1023), cs = kp >> 10, g = (kp >> 7) & 7, c = kp & 127, g2 = j >> 7, jj = j & 127; float v = 0.f;
        if (g == g2) { const int m = (c * jj) & 127; const float ang = (float)m * (1.f / 128.f); v = (cs ? -sinpif(2.f * ang) : cospif(2.f * ang)) * 0.088388347648318440f; }
        ((bf16*)(ws + WS_DT))[i] = f2act(v); }
    for (size_t i = gt; i < (size_t)512 * 256; i += NGT) { const int kp = (int)(i >> 8), t = (int)(i & 255), cs = kp >> 8, k = kp & 255, m = (k * t) & 255; const float ang = (float)m * (1.f / 256.f);
        ((bf16*)(ws + WS_ACTX))[i] = f2act((cs ? sinpif(2.f * ang) : cospif(2.f * ang)) * 0.0625f); }
    for (size_t i = gt; i < (size_t)2048 * 1024; i += NGT) { const int kp = (int)(i >> 10), t = (int)(i & 1023), cs = kp >> 10, k = kp & 1023, m = (k * t) & 1023; const float ang = (float)m * (1.f / 1024.f);
        ((bf16*)(ws + WS_ALAT))[i] = f2act((cs ? sinpif(2.f * ang) : cospif(2.f * ang)) * 0.03125f); }
    __syncthreads();
    {
        LAS float* SC = (LAS float*)F.lds;
        for (int i = F.tid; i < NMODV * DM; i += 512) { const int j = i >> 11, k = i & 2047; const float cv = j == 0 ? a.c_ctx[k] : a.cvec[(j - 1) * DM + k]; SC[i] = siluf_(cv); }
        __syncthreads();
        float* MP = (float*)(ws + WS_MODP);
        for (int u = F.bid; u < DEPTH * 16 * 6; u += F.G) {
            const int l = u / 96, kc = (u % 96) / 6, nb = u % 6, n = nb * 2048 + F.tid * 4;
            f32x4 acc[NMODV];
#pragma unroll
            for (int j = 0; j < NMODV; ++j) acc[j] = (f32x4){0.f, 0.f, 0.f, 0.f};
            const float* wp = a.w_ada + ((size_t)l * DM + kc * 128) * NMOD + n;
#pragma unroll 8
            for (int k = 0; k < 128; ++k) { const f32x4 wv = *(const f32x4*)(wp + (size_t)k * NMOD);
#pragma unroll
                for (int j = 0; j < NMODV; ++j) acc[j] = acc[j] + wv * SC[j * DM + kc * 128 + k]; }
#pragma unroll
            for (int j = 0; j < NMODV; ++j) *(f32x4*)(MP + (((size_t)kc * DEPTH + l) * NMODV + j) * NMOD + n) = acc[j];
        }
        __syncthreads();
    }
}
__device__ __forceinline__ void phase_mod_reduce(LAS unsigned char* lds_, const Args& a) {
    const Frame F = frame_now(lds_);
    const float* MP = (const float*)(a.ws + WS_MODP); float* MOD = (float*)(a.ws + WS_MOD);
    for (size_t i = (size_t)F.bid * 512 + F.tid; i < (size_t)DEPTH * NMODV * NMOD / 4; i += (size_t)F.G * 512) {
        const size_t e = i * 4; const int n = (int)(e % NMOD), l = (int)(e / ((size_t)NMODV * NMOD));
        f32x4 s = *(const f32x4*)(a.b_ada + (size_t)l * NMOD + n);
#pragma unroll
        for (int kc = 0; kc < 16; ++kc) s = s + *(const f32x4*)(MP + (size_t)kc * DEPTH * NMODV * NMOD + e);
        *(f32x4*)(MOD + e) = s; }
}

__device__ __forceinline__ void phase_norm(LAS unsigned char* lds_, const Args& a, int l, int which, bool first) {
    const Frame F = frame_now(lds_);
    const float* MOD = (const float*)(a.ws + WS_MOD) + (size_t)l * NMODV * NMOD + (which ? 3 * DM : 0);
    const float* wn = (which ? a.norm2 : a.norm1) + (size_t)l * DM;
    float* X = (float*)(a.ws + WS_X); bf16* H = (bf16*)(a.ws + WS_H);
    const int gw = F.bid * NWAVES + F.wave, NGW = F.G * NWAVES;
    for (int r = gw; r < NTOK; r += NGW) {
        const float* src = first ? (r < NCTX ? a.x_prompt + (size_t)r * DM : a.x_sample + (size_t)(r - NCTX) * DM) : X + (size_t)r * DM;
        f32x4 v[8]; float ss = 0.f;
#pragma unroll
        for (int j = 0; j < 8; ++j) { v[j] = *(const f32x4*)(src + 4 * F.lane + 256 * j); ss += (v[j][0] * v[j][0] + v[j][1] * v[j][1]) + (v[j][2] * v[j][2] + v[j][3] * v[j][3]); }
        if (first) {
#pragma unroll
            for (int j = 0; j < 8; ++j) *(f32x4*)(X + (size_t)r * DM + 4 * F.lane + 256 * j) = v[j]; }
        const float rstd = rsqrtf(wave_sum(ss) * (1.f / DM) + EPS);
        const float* mr = MOD + (size_t)mod_row(r) * NMOD;
#pragma unroll
        for (int j = 0; j < 8; ++j) { const int c = 4 * F.lane + 256 * j; const f32x4 w4 = *(const f32x4*)(wn + c), sh = *(const f32x4*)(mr + c), sc = *(const f32x4*)(mr + DM + c);
            const f32x4 hval = v[j] * rstd * w4 * (sc + 1.f) + sh;
            u32x2 o = {pk_act(hval[0], hval[1]), pk_act(hval[2], hval[3])}; *(u32x2*)(H + (size_t)r * DM + c) = o; }
    }
}
__device__ __forceinline__ void phase_final_norm(LAS unsigned char* lds_, const Args& a) {
    const Frame F = frame_now(lds_);
    const float* X = (const float*)(a.ws + WS_X);
    const int gw = F.bid * NWAVES + F.wave, NGW = F.G * NWAVES;
    for (int r = gw; r < NTOK; r += NGW) {
        f32x4 v[8]; float ss = 0.f;
#pragma unroll
        for (int j = 0; j < 8; ++j) { v[j] = *(const f32x4*)(X + (size_t)r * DM + 4 * F.lane + 256 * j); ss += (v[j][0] * v[j][0] + v[j][1] * v[j][1]) + (v[j][2] * v[j][2] + v[j][3] * v[j][3]); }
        const float rstd = rsqrtf(wave_sum(ss) * (1.f / DM) + EPS);
#pragma unroll
        for (int j = 0; j < 8; ++j) { const int c = 4 * F.lane + 256 * j; f32x4 yv = v[j] * rstd * *(const f32x4*)(a.final_norm + c);
#ifdef MK_PROBE_NOISE
            { const unsigned hsh = ((unsigned)r * 2654435761u) ^ ((unsigned)c * 40503u); const float dn = 0.03f;
              yv[0] += (hsh & 1u) ? dn : -dn; yv[1] += (hsh & 2u) ? dn : -dn; yv[2] += (hsh & 4u) ? dn : -dn; yv[3] += (hsh & 8u) ? dn : -dn; }
#endif
            *(f32x4*)(a.out + OUT_YP + (size_t)r * DM + c) = yv; }
    }
}

__device__ __forceinline__ void phase_prep(LAS unsigned char* lds_, const Args& a, int l) {
    const Frame F = frame_now(lds_);
    const bf16* Z = (const bf16*)(a.ws + WS_Z);
    bf16* KC = (bf16*)(a.ws + WS_KC); bf16* VC = (bf16*)(a.ws + WS_VC); bf16* KL = (bf16*)(a.ws + WS_KL); bf16* VL = (bf16*)(a.ws + WS_VL);
    const int gw = F.bid * NWAVES + F.wave, NGW = F.G * NWAVES, lane = F.lane;
    LAS bf16* tile = (LAS bf16*)(F.lds + F.wave * 8448);
    for (int it = gw; it < NTOK + 1024 + 2048; it += NGW) {
        if (it < NTOK) {
            const int r = it, hh = lane >> 5, i = lane & 31; const bf16* zr = Z + (size_t)r * NZ;
            float kx[4]; float ss = 0.f;
#pragma unroll
            for (int q = 0; q < 4; ++q) { kx[q] = act2f(zr[ZK + hh * 128 + i + 32 * q]); ss += kx[q] * kx[q]; }
            ss = half_sum(ss);
            const float rstd = rsqrtf(ss * (1.f / 128.f) + EPS);
#pragma unroll
            for (int q = 0; q < 4; ++q) kx[q] *= rstd * a.k_norm[l * 128 + i + 32 * q];
            const u32x2 vv = *(const u32x2*)(zr + ZV + 4 * lane);
            {
                bf16* qo = (bf16*)(a.ws + WS_QN) + (size_t)r * 1024;
                const bool lat = r >= NCTX; const int tq = (r - NCTX) & 1023; const float prow = (float)(tq >> 6), pcol = (float)(tq & 63);
                const float inv = exp2f(-(float)i * 0.41524101186092029f);
                float sr = 0.f, cr = 1.f, sc2 = 0.f, cc2 = 1.f;
                if (lat) { sr = __sinf(prow * inv); cr = __cosf(prow * inv); sc2 = __sinf(pcol * inv); cc2 = __cosf(pcol * inv); }
                float qg[4];
#pragma unroll
                for (int q = 0; q < 4; ++q) qg[q] = a.q_norm[l * 128 + i + 32 * q];
#pragma unroll
                for (int hp = 0; hp < 4; ++hp) { const int hd = 2 * hp + hh; float qx[4]; float s2 = 0.f;
#pragma unroll
                    for (int q = 0; q < 4; ++q) { qx[q] = act2f(zr[ZQ + hd * 128 + i + 32 * q]); s2 += qx[q] * qx[q]; }
                    s2 = half_sum(s2);
                    const float rs = rsqrtf(s2 * (1.f / 128.f) + EPS);
#pragma unroll
                    for (int q = 0; q < 4; ++q) qx[q] *= rs * qg[q];
                    const float y0 = qx[0] * cr - qx[1] * sr, y1 = qx[1] * cr + qx[0] * sr, y2 = qx[2] * cc2 - qx[3] * sc2, y3 = qx[3] * cc2 + qx[2] * sc2;
                    qo[hd * 128 + i] = f2act(y0); qo[hd * 128 + i + 32] = f2act(y1); qo[hd * 128 + i + 64] = f2act(y2); qo[hd * 128 + i + 96] = f2act(y3); }
            }
            if (r < NCTX) {
                const int b = r >> 8, t = r & 255; const size_t oo = ((size_t)(b * DEPTH + l) * TC + t) * 256;
#pragma unroll
                for (int q = 0; q < 4; ++q) { KC[(size_t)r * 256 + hh * 128 + i + 32 * q] = f2act(kx[q]); a.out[OUT_CK + oo + hh * 128 + i + 32 * q] = kx[q]; }
                *(u32x2*)(VC + (size_t)r * 256 + 4 * lane) = vv;
                *(f32x4*)(a.out + OUT_CV + oo + 4 * lane) = (f32x4){lo_act(vv[0]), hi_act(vv[0]), lo_act(vv[1]), hi_act(vv[1])};
            } else {
                const int rr = r - NCTX, b = rr >> 10, t = rr & 1023; const float prow = (float)(t >> 6), pcol = (float)(t & 63);
                const float inv = exp2f(-(float)i * 0.41524101186092029f);
                { const float s = __sinf(prow * inv), c = __cosf(prow * inv), x1 = kx[0], x2 = kx[1]; kx[0] = x1 * c - x2 * s; kx[1] = x2 * c + x1 * s; }
                { const float s = __sinf(pcol * inv), c = __cosf(pcol * inv), x1 = kx[2], x2 = kx[3]; kx[2] = x1 * c - x2 * s; kx[3] = x2 * c + x1 * s; }
                const size_t ko = ((size_t)b * 1280 + 256 + t) * 256;
#pragma unroll
                for (int q = 0; q < 4; ++q) KL[ko + hh * 128 + i + 32 * q] = f2act(kx[q]);
                *(u32x2*)(VL + ko + 4 * lane) = vv;
            }
        } else if (it < NTOK + 1024) {
            const int rr = it - NTOK, b = rr >> 8, s = rr & 255; const size_t so = ((size_t)(b * DEPTH + l) * PAST + s) * 256 + 4 * lane, dst_o = ((size_t)b * 1280 + s) * 256 + 4 * lane;
            const f32x4 kk = *(const f32x4*)(a.cache_k + so), vv = *(const f32x4*)(a.cache_v + so);
            u32x2 ko = {pk_act(kk[0], kk[1]), pk_act(kk[2], kk[3])}, vo = {pk_act(vv[0], vv[1]), pk_act(vv[2], vv[3])};
            *(u32x2*)(KL + dst_o) = ko; *(u32x2*)(VL + dst_o) = vo;
        } else {
            const int ti = it - NTOK - 1024, tb = ti >> 4, cb = ti & 15, r0 = tb * 64, c0 = cb * 64;
#pragma unroll
            for (int j = 0; j < 8; ++j) { const int row = (lane >> 3) + 8 * j, cc = (lane & 7) * 8; const u32x4 w = *(const u32x4*)(Z + (size_t)(r0 + row) * NZ + ZF + c0 + cc);
#pragma unroll
                for (int q = 0; q < 4; ++q) *(LAS unsigned*)(tile + row * 66 + cc + 2 * q) = w[q]; }
            LDS_WAIT(); asm volatile("" ::: "memory");
            bf16* XT; int T, b, t0;
            if (r0 < NCTX) { XT = (bf16*)(a.ws + WS_XT); T = TC; b = r0 >> 8; t0 = r0 & 255; } else { XT = (bf16*)(a.ws + WS_XT) + (size_t)16384 * 256; T = TL; b = (r0 - NCTX) >> 10; t0 = (r0 - NCTX) & 1023; }
#pragma unroll
            for (int j = 0; j < 8; ++j) { const int ch = (lane >> 3) + 8 * j, tt = (lane & 7) * 8; unsigned o[4];
#pragma unroll
                for (int q = 0; q < 4; ++q) o[q] = (unsigned)tile[(tt + 2 * q) * 66 + ch] | ((unsigned)tile[(tt + 2 * q + 1) * 66 + ch] << 16);
                *(u32x4*)(XT + ((size_t)b * 1024 + c0 + ch) * T + t0 + tt) = (u32x4){o[0], o[1], o[2], o[3]}; }
            LDS_WAIT(); asm volatile("" ::: "memory");
        }
    }
}

__device__ __forceinline__ void phase_attn(LAS unsigned char* lds_, const Args& a, int l) {
    const Frame F = frame_now(lds_);
    bf16* AM = (bf16*)(a.ws + WS_AM);
    for (int u = F.bid; u < 256; u += F.G) {
        const bool lat = u < 128; const int uu = lat ? u : u - 128;
        const int b = lat ? (uu >> 5) : (uu >> 3), h = lat ? ((uu >> 2) & 7) : (uu & 7), qb = lat ? (uu & 3) : 0;
        const size_t row0 = lat ? (size_t)NCTX + b * 1024 + qb * 256 : (size_t)b * 256;
        const size_t kvo = (lat ? (size_t)b * 1280 * 256 : (size_t)b * 256 * 256) + (h >> 2) * 128;
        const bf16* Kp = (const bf16*)(a.ws + (lat ? WS_KL : WS_KC)) + kvo; const bf16* Vp = (const bf16*)(a.ws + (lat ? WS_VL : WS_VC)) + kvo;
        att::attn_dense_body((const bf16*)(a.ws + WS_QN) + row0 * 1024 + h * 128, Kp, Vp, AM + row0 * KMRG + 2048 + h * 128, lat ? 1280 : 256, (LAS char*)F.lds);
    }
}

__device__ __forceinline__ void phase_gla(LAS unsigned char* lds_, const Args& a, int l) {
    const Frame F = frame_now(lds_);
    const bf16* Z = (const bf16*)(a.ws + WS_Z);
    for (int slot = F.bid; slot < 256; slot += F.G) {
        const int nit = slot < 128 ? 1 : 4;
        for (int k = 0; k < nit; ++k) {
            int path, b, h, dir, dvq;
            if (slot < 128) { path = 1; b = slot >> 5; h = (slot >> 3) & 3; dir = (slot >> 2) & 1; dvq = slot & 3; }
            else { const int it = (slot - 128) * 4 + k; path = 0; b = it >> 5; h = (it >> 3) & 3; dir = (it >> 2) & 1; dvq = it & 3; }
            const float* wg = (dir ? a.w_gate_b : a.w_gate_f) + (size_t)l * 16 * 512 + h * 128;
            const float* bg = (dir ? a.b_gate_b : a.b_gate_f) + (size_t)l * 512 + h * 128;
            float* OUT = (float*)(a.ws + (dir ? WS_OB : WS_OF));
            const size_t so = ((size_t)(b * DEPTH + l) * 4 + h) * 128 * 256;
            const float* st_in = path ? (dir ? a.state_b : a.state_f) + so : nullptr;
            float* st_out = path ? nullptr : a.out + (dir ? OUT_SB : OUT_SF) + so;
            gla::gla_item(F.lds, Z, OUT, wg, bg, st_in, st_out, path ? TL : TC, path ? NCTX + b * 1024 : b * 256, h, dir, dvq);
        }
    }
}
__device__ __forceinline__ void phase_gla_fin(LAS unsigned char* lds_, const Args& a, int l) {
    const Frame F = frame_now(lds_);
    const bf16* Z = (const bf16*)(a.ws + WS_Z); bf16* AM = (bf16*)(a.ws + WS_AM);
    const float* OF = (const float*)(a.ws + WS_OF); const float* OB = (const float*)(a.ws + WS_OB);
    const int gw = F.bid * NWAVES + F.wave, NGW = F.G * NWAVES;
    const f32x4 gn = *(const f32x4*)(a.gla_norm + l * 256 + 4 * F.lane);
    for (int it = gw; it < NTOK * 4; it += NGW) { const int r = it >> 2, h = it & 3; const size_t o = (size_t)r * 1024 + h * 256 + 4 * F.lane;
        const f32x4 v = *(const f32x4*)(OF + o) + *(const f32x4*)(OB + o);
        const float ss = wave_sum((v[0] * v[0] + v[1] * v[1]) + (v[2] * v[2] + v[3] * v[3]));
        const float rstd = rsqrtf(ss * (1.f / 256.f) + EPS);
        const u32x2 g = *(const u32x2*)(Z + (size_t)r * NZ + ZGR + h * 256 + 4 * F.lane);
        const f32x4 y = v * rstd * gn;
        u32x2 w = {pk_act(y[0] * siluf_(lo_act(g[0])), y[1] * siluf_(hi_act(g[0]))), pk_act(y[2] * siluf_(lo_act(g[1])), y[3] * siluf_(hi_act(g[1])))};
        *(u32x2*)(AM + (size_t)r * KMRG + 3072 + h * 256 + 4 * F.lane) = w; }
}
__device__ __forceinline__ void phase_conv(LAS unsigned char* lds_, const Args& a, int l) {
    const Frame F = frame_now(lds_);
    const bf16* U = (const bf16*)(a.ws + WS_Z); bf16* ACT = (bf16*)(a.ws + WS_ACT);
    const float* cw = a.conv_w + (size_t)l * 3 * NUP; const float* cb = a.conv_b + (size_t)l * NUP;
    constexpr int NCG = DFF / 8, STRIP = 32, NS = NTOK / STRIP;
    for (int it = F.bid * 512 + F.tid; it < NCG * NS; it += F.G * 512) {
        const int cg = it % NCG, st = it / NCG, c = cg * 8, r0 = st * STRIP; const int T = r0 < NCTX ? TC : TL;
        float wg[3][8], wv[3][8], bgv[8], bvv[8];
#pragma unroll
        for (int k = 0; k < 3; ++k) { const f32x4 a0 = *(const f32x4*)(cw + k * NUP + c), a1 = *(const f32x4*)(cw + k * NUP + c + 4), b0 = *(const f32x4*)(cw + k * NUP + DFF + c), b1 = *(const f32x4*)(cw + k * NUP + DFF + c + 4);
#pragma unroll
            for (int j = 0; j < 4; ++j) { wg[k][j] = a0[j]; wg[k][4 + j] = a1[j]; wv[k][j] = b0[j]; wv[k][4 + j] = b1[j]; } }
        { const f32x4 a0 = *(const f32x4*)(cb + c), a1 = *(const f32x4*)(cb + c + 4), b0 = *(const f32x4*)(cb + DFF + c), b1 = *(const f32x4*)(cb + DFF + c + 4);
#pragma unroll
          for (int j = 0; j < 4; ++j) { bgv[j] = a0[j]; bgv[4 + j] = a1[j]; bvv[j] = b0[j]; bvv[4 + j] = b1[j]; } }
        const u32x4 zero = {0u, 0u, 0u, 0u};
        u32x4 gp = zero, vp = zero, gc, vc, gn, vn;
        if ((r0 & (T - 1)) != 0) { gp = *(const u32x4*)(U + (size_t)(r0 - 1) * NUP + c); vp = *(const u32x4*)(U + (size_t)(r0 - 1) * NUP + DFF + c); }
        gc = *(const u32x4*)(U + (size_t)r0 * NUP + c); vc = *(const u32x4*)(U + (size_t)r0 * NUP + DFF + c);
        for (int i = 0; i < STRIP; ++i) { const int r = r0 + i;
            if (((r + 1) & (T - 1)) != 0) { gn = *(const u32x4*)(U + (size_t)(r + 1) * NUP + c); vn = *(const u32x4*)(U + (size_t)(r + 1) * NUP + DFF + c); } else { gn = zero; vn = zero; }
            float o[8];
#pragma unroll
            for (int q = 0; q < 4; ++q) {
                const float g0 = wg[0][2 * q] * lo_act(gp[q]) + wg[1][2 * q] * lo_act(gc[q]) + wg[2][2 * q] * lo_act(gn[q]) + bgv[2 * q];
                const float g1 = wg[0][2 * q + 1] * hi_act(gp[q]) + wg[1][2 * q + 1] * hi_act(gc[q]) + wg[2][2 * q + 1] * hi_act(gn[q]) + bgv[2 * q + 1];
                const float v0 = wv[0][2 * q] * lo_act(vp[q]) + wv[1][2 * q] * lo_act(vc[q]) + wv[2][2 * q] * lo_act(vn[q]) + bvv[2 * q];
                const float v1 = wv[0][2 * q + 1] * hi_act(vp[q]) + wv[1][2 * q + 1] * hi_act(vc[q]) + wv[2][2 * q + 1] * hi_act(vn[q]) + bvv[2 * q + 1];
                o[2 * q] = siluf_(g0) * v0; o[2 * q + 1] = siluf_(g1) * v1; }
            *(u32x4*)(ACT + (size_t)r * DFF + c) = (u32x4){pk_act(o[0], o[1]), pk_act(o[2], o[3]), pk_act(o[4], o[5]), pk_act(o[6], o[7])};
            gp = gc; vp = vc; gc = gn; vc = vn; }
    }
}

#ifdef MK_PROBE
constexpr size_t WS_DIAG = WS_END;
__device__ __forceinline__ void diag_max(float* slot, float v) { atomicMax((unsigned*)slot, __builtin_bit_cast(unsigned, fabsf(v))); }
__global__ void k_probe_zero(float* diag) { if (threadIdx.x < 4) diag[threadIdx.x] = 0.f; }
__global__ void k_probe_fill(float* out, const float* diag) {
    for (size_t i = (size_t)blockIdx.x * blockDim.x + threadIdx.x; i < OUT_END; i += (size_t)gridDim.x * blockDim.x) out[i] = 0.f;
    __syncthreads();
    if (blockIdx.x == 0 && threadIdx.x == 0) out[0] = 1e6f * diag[0] / fmaxf(diag[1], 1e-20f);
}
__global__ void k_probe_fill2(float* out, const float* diag) { if (blockIdx.x == 0 && threadIdx.x == 0) out[0] = 1e6f * diag[0] / fmaxf(diag[1], 1e-20f); }
__global__ void k_probe_z(Args a) {
    const bf16* H = (const bf16*)(a.ws + WS_H); const bf16* W = (const bf16*)(a.ws + WS_WIN); const bf16* Z = (const bf16*)(a.ws + WS_Z); float* diag = (float*)(a.ws + WS_DIAG);
    const unsigned id = blockIdx.x * blockDim.x + threadIdx.x; const unsigned hsh = id * 2654435761u + 12345u;
    const int r = (hsh >> 8) % NTOK, c = (hsh * 40503u >> 7) % NZ;
    float s = 0.f; for (int k = 0; k < DM; ++k) s += act2f(H[(size_t)r * DM + k]) * act2f(W[(size_t)c * DM + k]);
    const float z = act2f(Z[(size_t)r * NZ + c]); diag_max(diag, z - s); diag_max(diag + 1, s);
}
__global__ void k_probe_wt(Args a, int l) {
    const bf16* W = (const bf16*)(a.ws + WS_WIN + (size_t)l * SZ_WIN); float* diag = (float*)(a.ws + WS_DIAG);
    for (size_t i = (size_t)blockIdx.x * blockDim.x + threadIdx.x; i < (size_t)N_IN * DM; i += (size_t)gridDim.x * blockDim.x) {
        const int n = (int)(i / DM), k = (int)(i % DM); const int row = n >= ZPAD ? n + (ZGATE - ZPAD) : n;
        const float ref = act2f(f2act(a.w_in[((size_t)l * DM + k) * N_IN + n])); diag_max(diag, act2f(W[(size_t)row * DM + k]) - ref); diag_max(diag + 1, ref); }
}
__global__ void k_probe_gla(Args a) {
    __shared__ float red[4];
    const bf16* Z = (const bf16*)(a.ws + WS_Z); float* diag = (float*)(a.ws + WS_DIAG);
    const int l = 0, blk = blockIdx.x, b = blk & 15, h = (blk >> 4) & 3, dir = (blk >> 6) & 1, dv0 = ((blk >> 7) * 52 + 3) & 252;
    const int d = threadIdx.x & 127, dvi = threadIdx.x >> 7, dv = dv0 + dvi, T = TC, tokbase = b * TC;
    const float* wg = (dir ? a.w_gate_b : a.w_gate_f) + (size_t)l * 16 * 512 + h * 128; const float* bg = (dir ? a.b_gate_b : a.b_gate_f) + (size_t)l * 512 + h * 128;
    const float* OUT = (const float*)(a.ws + (dir ? WS_OB : WS_OF));
    float S = 0.f;
    for (int i = 0; i < T; ++i) { const int t = dir ? T - 1 - i : i; const bf16* zr = Z + (size_t)(tokbase + t) * NZ;
        float x = bg[d]; for (int r = 0; r < 16; ++r) x += act2f(zr[(dir ? ZGAB : ZGAF) + r]) * wg[r * 512 + d];
        const float la = (fminf(x, 0.f) - logf(1.f + expf(-fabsf(x)))) * 0.0625f;
        S = expf(la) * S + act2f(zr[ZGK + h * 128 + d]) * act2f(zr[ZGV + h * 256 + dv]);
        if (threadIdx.x < 4) red[threadIdx.x] = 0.f;
        __syncthreads();
        atomicAdd(&red[dvi], act2f(zr[ZGQ + h * 128 + d]) * 0.088388347648318440f * S);
        __syncthreads();
        if (d == 0) { const float o = OUT[(size_t)(tokbase + t) * 1024 + h * 256 + dv]; diag_max(diag, o - red[dvi]); diag_max(diag + 1, red[dvi]); }
        __syncthreads(); }
    const float sref = S, sgot = a.out[(dir ? OUT_SB : OUT_SF) + (((size_t)(b * DEPTH + l) * 4 + h) * 128 + d) * 256 + dv];
    diag_max(diag + 2, sgot - sref); diag_max(diag + 3, sref);
}

__global__ void k_probe_h(Args a) {
    const bf16* H = (const bf16*)(a.ws + WS_H); float* diag = (float*)(a.ws + WS_DIAG);
    const unsigned id = blockIdx.x * blockDim.x + threadIdx.x; const unsigned hsh = id * 2654435761u + 777u;
    const int r = (hsh >> 8) % NTOK, c = (hsh * 40503u >> 7) % DM, j = mod_row(r);
    const float* xr = r < NCTX ? a.x_prompt + (size_t)r * DM : a.x_sample + (size_t)(r - NCTX) * DM;
    float ss = 0.f, sh = a.b_ada[c], sc = a.b_ada[DM + c];
    for (int k = 0; k < DM; ++k) { ss += xr[k] * xr[k]; const float cv = j == 0 ? a.c_ctx[k] : a.cvec[(j - 1) * DM + k]; const float sl = cv / (1.f + expf(-cv));
        sh += sl * a.w_ada[(size_t)k * NMOD + c]; sc += sl * a.w_ada[(size_t)k * NMOD + DM + c]; }
    const float ref = xr[c] * (1.f / sqrtf(ss / DM + EPS)) * a.norm1[c] * (1.f + sc) + sh;
    diag_max(diag, act2f(H[(size_t)r * DM + c]) - ref); diag_max(diag + 1, ref);
}

__global__ void k_probe_mod(Args a, int l) {
    const float* MOD = (const float*)(a.ws + WS_MOD) + (size_t)l * NMODV * NMOD; float* diag = (float*)(a.ws + WS_DIAG);
    const unsigned id = blockIdx.x * blockDim.x + threadIdx.x; const int j = id % NMODV, n = (int)(((id / NMODV) * 2654435761u >> 8) % NMOD);
    float s = a.b_ada[(size_t)l * NMOD + n];
    for (int k = 0; k < DM; ++k) { const float cv = j == 0 ? a.c_ctx[k] : a.cvec[(j - 1) * DM + k]; s += cv / (1.f + expf(-cv)) * a.w_ada[((size_t)l * DM + k) * NMOD + n]; }
    diag_max(diag, MOD[(size_t)j * NMOD + n] - s); diag_max(diag + 1, s);
}
#endif

constexpr int STEPS_PER_LAYER = 13, STEP_L0 = 2, STEP_FINAL = STEP_L0 + DEPTH * STEPS_PER_LAYER, N_STEPS = STEP_FINAL + 1;
#ifndef MK_PH_MASK
#define MK_PH_MASK 0xFFFFFFFFu
#endif
#define EN(k) (((MK_PH_MASK) >> (k)) & 1u)
#ifndef MK_SP2
#define MK_SP2 true
#endif
#ifndef MK_ALIGN
#define MK_ALIGN true
#endif
__global__ void __launch_bounds__(NWAVES * 64, 2) mk_fwd(Args a) {
    extern __shared__ __attribute__((aligned(16))) unsigned char lds_raw[];
    LAS unsigned char* const lds = (LAS unsigned char*)lds_raw;
    volatile LAS unsigned* MISC = (volatile LAS unsigned*)(lds + MISC_OFF);
    if (threadIdx.x < 64) MISC[threadIdx.x] = 0u;
    __syncthreads();
    unsigned* barw = (unsigned*)(a.ws + WS_CTL) + CW_BAR + a.li * XCD_BAR_WORDS;
    XcdBarrier bar = xcd_barrier_post(barw, MISC + 8);
    const int lo = a.s_lo, hi = a.s_hi;
#define IN(s) (lo <= (s) && (s) < hi)
#define SEAM(s) do { if (IN(s) && IN((s) + 1)) xcd_barrier(bar); else __syncthreads(); } while (0)
    unsigned char* ws = a.ws;
    const int G = gridDim.x, bid = blockIdx.x;

    if (EN(13) && IN(0)) { phase_prologue_a(lds, a); SEAM(0); }
    if (EN(14) && IN(1)) {
        phase_mod_reduce(lds, a);
        pg8::Gemm g{(const bf16*)(ws + WS_WFT), (const bf16*)(ws + WS_DT), DEPTH * DM, 2048, 1024}; pg8::StaticOrder S; S.init(g.M, g.N, G, bid);
        pg8::EpiStoreBf16 E{(bf16*)(ws + WS_WMRG), KMRG};
        pg8::gemm_phase<pg8::EpiStoreBf16, pg8::StaticOrder, MK_ALIGN, MK_SP2>(lds, g, S, E);
        SEAM(1);
    }
    for (int l = 0; l < DEPTH; ++l) {
        const int sb = STEP_L0 + l * STEPS_PER_LAYER;
        if (hi <= sb || lo >= sb + STEPS_PER_LAYER) continue;
        const float* MODL = (const float*)(ws + WS_MOD) + (size_t)l * NMODV * NMOD;
        if (EN(0) && IN(sb + 0)) { phase_norm(lds, a, l, 0, l == 0); SEAM(sb + 0); }
        if (EN(1) && IN(sb + 1)) {
            pg8::Gemm g{(const bf16*)(ws + WS_H), (const bf16*)(ws + WS_WIN + l * SZ_WIN), NTOK, NZ, DM}; pg8::StaticOrder S; S.init(g.M, g.N, G, bid);
            pg8::EpiStoreBf16 E{(bf16*)(ws + WS_Z), NZ};
            pg8::gemm_phase<pg8::EpiStoreBf16, pg8::StaticOrder, MK_ALIGN, MK_SP2>(lds, g, S, E);
            SEAM(sb + 1);
        }
        if (EN(2) && IN(sb + 2)) { phase_prep(lds, a, l); SEAM(sb + 2); }
        if (EN(3) && IN(sb + 3)) { phase_attn(lds, a, l); SEAM(sb + 3); }
        if (EN(4) && IN(sb + 4)) {
            { pg8::Gemm g{(const bf16*)(ws + WS_ALAT), (const bf16*)(ws + WS_XT) + (size_t)16384 * 256, 2048, 4096, 1024}; pg8::StaticOrder S; S.init(g.M, g.N, G, bid);
              pg8::EpiDft E{(bf16*)(ws + WS_AM), 10, NCTX};
              pg8::gemm_phase<pg8::EpiDft, pg8::StaticOrder, MK_ALIGN, MK_SP2>(lds, g, S, E); }
            { pg8::Gemm g{(const bf16*)(ws + WS_ACTX), (const bf16*)(ws + WS_XT), 512, 16384, 256}; pg8::StaticOrder S; S.init(g.M, g.N, G, (bid + G / 2) % G);
              pg8::EpiDft E{(bf16*)(ws + WS_AM), 8, 0};
              pg8::gemm_phase<pg8::EpiDft, pg8::StaticOrder, MK_ALIGN, MK_SP2>(lds, g, S, E); }
            SEAM(sb + 4);
        }
        if (EN(5) && IN(sb + 5)) { phase_gla(lds, a, l); SEAM(sb + 5); }
        if (EN(6) && IN(sb + 6)) { phase_gla_fin(lds, a, l); SEAM(sb + 6); }
        if (EN(7) && IN(sb + 7)) {
            pg8::Gemm g{(const bf16*)(ws + WS_AM), (const bf16*)(ws + WS_WMRG + l * SZ_WMRG), NTOK, DM, KMRG}; pg8::StaticOrder S; S.init(g.M, g.N, G, bid);
            pg8::EpiMerged E{(bf16*)(ws + WS_MG), (const bf16*)(ws + WS_Z)};
            pg8::gemm_phase<pg8::EpiMerged, pg8::StaticOrder, MK_ALIGN, MK_SP2>(lds, g, S, E);
            SEAM(sb + 7);
        }
        if (EN(8) && IN(sb + 8)) {
            pg8::Gemm g{(const bf16*)(ws + WS_MG), (const bf16*)(ws + WS_WOUT + l * SZ_WOUT), NTOK, DM, DM}; pg8::StaticOrder S; S.init(g.M, g.N, G, bid);
            pg8::EpiResid E{(float*)(ws + WS_X), MODL + 2 * DM};
            pg8::gemm_phase<pg8::EpiResid, pg8::StaticOrder, MK_ALIGN, MK_SP2>(lds, g, S, E);
            SEAM(sb + 8);
        }
        if (EN(9) && IN(sb + 9)) { phase_norm(lds, a, l, 1, false); SEAM(sb + 9); }
        if (EN(10) && IN(sb + 10)) {
            pg8::Gemm g{(const bf16*)(ws + WS_H), (const bf16*)(ws + WS_WUP + l * SZ_WUP), NTOK, NUP, DM}; pg8::StaticOrder S; S.init(g.M, g.N, G, bid);
            pg8::EpiStoreBf16 E{(bf16*)(ws + WS_Z), NUP};
            pg8::gemm_phase<pg8::EpiStoreBf16, pg8::StaticOrder, MK_ALIGN, MK_SP2>(lds, g, S, E);
            SEAM(sb + 10);
        }
        if (EN(11) && IN(sb + 11)) { phase_conv(lds, a, l); SEAM(sb + 11); }
        if (EN(12) && IN(sb + 12)) {
            pg8::Gemm g{(const bf16*)(ws + WS_ACT), (const bf16*)(ws + WS_WDN + l * SZ_WDN), NTOK, DM, DFF}; pg8::StaticOrder S; S.init(g.M, g.N, G, bid);
            pg8::EpiResid E{(float*)(ws + WS_X), MODL + 5 * DM};
            pg8::gemm_phase<pg8::EpiResid, pg8::StaticOrder, MK_ALIGN, MK_SP2>(lds, g, S, E);
            SEAM(sb + 12);
        }
    }
    if (EN(15) && IN(STEP_FINAL)) phase_final_norm(lds, a);
#undef IN
#undef SEAM
}

#ifndef MK_LAUNCH_MODE
#define MK_LAUNCH_MODE 0
#endif
extern "C" void kernel_launch(void* const* d_in, const int* in_sizes, int n_in, void* d_out, int out_size, void* d_ws, size_t ws_size, hipStream_t stream) {
    static int grid = 0;
    if (grid == 0) {
        if (n_in != 29 || (size_t)out_size != OUT_END || ws_size < WS_END + 4096) { fprintf(stderr, "kernel_launch: unexpected shapes: n_in %d out %d ws %zu (need %zu)\n", n_in, out_size, ws_size, (size_t)WS_END); grid = -1; return; }
        int dev = 0, cus = 0;
        if (hipGetDevice(&dev) != hipSuccess || hipDeviceGetAttribute(&cus, hipDeviceAttributeMultiprocessorCount, dev) != hipSuccess) { grid = -1; return; }
        if (hipFuncSetAttribute((const void*)mk_fwd, hipFuncAttributeMaxDynamicSharedMemorySize, LDS_BYTES) != hipSuccess) { fprintf(stderr, "kernel_launch: hipFuncSetAttribute failed\n"); grid = -1; return; }
        int per_cu = 0;
        if (hipOccupancyMaxActiveBlocksPerMultiprocessor(&per_cu, (const void*)mk_fwd, NWAVES * 64, LDS_BYTES) != hipSuccess || per_cu < 1) { fprintf(stderr, "kernel_launch: occupancy query says %d\n", per_cu); }
        (void)hipGetLastError();
        grid = cus;
    }
    if (grid < 0) return;
    (void)hipMemsetAsync((char*)d_ws + WS_CTL, 0, CTL_ZERO_BYTES, stream);
    Args a{};
    const float** p = (const float**)&a;
    for (int i = 0; i < 29; ++i) p[i] = (const float*)d_in[i];
    a.out = (float*)d_out; a.ws = (unsigned char*)d_ws; a.pad = 0;
#ifdef MK_PROBE
    {
        constexpr int PROBE_STEPS = (MK_PROBE == 2) ? 1 : (MK_PROBE == 1) ? STEP_L0 + 2 : (MK_PROBE == 4) ? STEP_L0 + 1 : (MK_PROBE == 5) ? 2 : STEP_L0 + 6;
        float* diag = (float*)((char*)d_ws + WS_DIAG);
        for (int s = 0; s < PROBE_STEPS; ++s) { a.s_lo = s; a.s_hi = s + 1; a.li = s; hipLaunchKernelGGL(mk_fwd, dim3(grid), dim3(NWAVES * 64), LDS_BYTES, stream, a); }
        hipLaunchKernelGGL(k_probe_zero, dim3(1), dim3(64), 0, stream, diag);
        if (MK_PROBE == 1) hipLaunchKernelGGL(k_probe_z, dim3(128), dim3(512), 0, stream, a);
        if (MK_PROBE == 2) hipLaunchKernelGGL(k_probe_wt, dim3(1024), dim3(256), 0, stream, a, MK_PROBE_L);
        if (MK_PROBE == 4) hipLaunchKernelGGL(k_probe_h, dim3(32), dim3(512), 0, stream, a);
        if (MK_PROBE == 5) hipLaunchKernelGGL(k_probe_mod, dim3(40), dim3(512), 0, stream, a, MK_PROBE_L);
        if (MK_PROBE == 3) hipLaunchKernelGGL(k_probe_gla, dim3(512), dim3(512), 0, stream, a);
        hipLaunchKernelGGL(k_probe_fill, dim3(1024), dim3(256), 0, stream, (float*)d_out, (const float*)(diag + 2 * MK_PROBE_SEL));
        hipLaunchKernelGGL(k_probe_fill2, dim3(1), dim3(64), 0, stream, (float*)d_out, (const float*)(diag + 2 * MK_PROBE_SEL));
        return;
    }
#endif
#if MK_LAUNCH_MODE == 1
    a.s_lo = 0; a.s_hi = N_STEPS; a.li = 0;
    hipLaunchKernelGGL(mk_fwd, dim3(grid), dim3(NWAVES * 64), LDS_BYTES, stream, a);
#else
    for (int s = 0; s < N_STEPS; ++s) { a.s_lo = s; a.s_hi = s + 1; a.li = s;
        hipLaunchKernelGGL(mk_fwd, dim3(grid), dim3(NWAVES * 64), LDS_BYTES, stream, a); }
#endif
}
```

```cpp
#define MK_LAUNCH_MODE 1
#include <hip/hip_runtime.h>
#include <cstdio>
#include <cstdint>

#define GAS __attribute__((address_space(1)))
#define LAS __attribute__((address_space(3)))
typedef unsigned short bf16;
typedef short bf16x8 __attribute__((ext_vector_type(8)));
typedef float f32x4 __attribute__((ext_vector_type(4)));
typedef float f32x2 __attribute__((ext_vector_type(2)));
typedef unsigned u32x4 __attribute__((ext_vector_type(4)));
typedef unsigned u32x2 __attribute__((ext_vector_type(2)));
typedef GAS unsigned gu32;

constexpr int DM = 2048, NTOK = 8192, NCTX = 4096, TC = 256, TL = 1024, BCTX = 16, BLAT = 4, PAST = 256, DEPTH = 4;
constexpr int N_IN = 11808, NZ = 12032;
constexpr int ZF = 0, ZQ = 1024, ZK = 2048, ZV = 2304, ZGQ = 2560, ZGK = 3072, ZGV = 3584, ZGR = 4608, ZGAF = 5632, ZGAB = 5648, ZPAD = 5664, ZGATE = 5888;
constexpr int NUP = 11264, DFF = 5632, NMOD = 12288, KMRG = 4096;
constexpr int NMODV = 5;
constexpr float EPS = 1e-6f;

constexpr size_t MiB = 1u << 20;
constexpr size_t WS_CTL = 0, CTL_ZERO_BYTES = 1 * MiB;
constexpr size_t WS_MOD = 1 * MiB;
constexpr size_t WS_MODP = 2 * MiB;
constexpr size_t WS_DT = 17 * MiB;
constexpr size_t WS_ACTX = 21 * MiB;
constexpr size_t WS_ALAT = 22 * MiB;
constexpr size_t WS_WIN = 26 * MiB;
constexpr size_t WS_WMRG = 214 * MiB;
constexpr size_t WS_WFT = 278 * MiB;
constexpr size_t WS_WOUT = 294 * MiB;
constexpr size_t WS_WUP = 326 * MiB;
constexpr size_t WS_WDN = 502 * MiB;
constexpr size_t WS_X = 590 * MiB;
constexpr size_t WS_H = 654 * MiB;
constexpr size_t WS_Z = 686 * MiB;
constexpr size_t WS_XT = 874 * MiB;
constexpr size_t WS_KC = 890 * MiB, WS_VC = 892 * MiB;
constexpr size_t WS_KL = 894 * MiB, WS_VL = 897 * MiB;
constexpr size_t WS_AM = 900 * MiB;
constexpr size_t WS_OF = 964 * MiB, WS_OB = 996 * MiB;
constexpr size_t WS_MG = 1028 * MiB;
constexpr size_t WS_ACT = 1060 * MiB;
constexpr size_t WS_QN = 1148 * MiB;
constexpr size_t WS_END = 1164 * MiB;
constexpr size_t SZ_WIN = (size_t)NZ * DM * 2, SZ_WMRG = (size_t)DM * KMRG * 2, SZ_WFT = (size_t)DM * 1024 * 2, SZ_WOUT = (size_t)DM * DM * 2, SZ_WUP = (size_t)NUP * DM * 2, SZ_WDN = (size_t)DM * DFF * 2;
static_assert(WS_WIN + 4 * SZ_WIN <= WS_WMRG && WS_WMRG + 4 * SZ_WMRG <= WS_WFT && WS_WFT + 4 * SZ_WFT <= WS_WOUT && WS_WOUT + 4 * SZ_WOUT <= WS_WUP && WS_WUP + 4 * SZ_WUP <= WS_WDN && WS_WDN + 4 * SZ_WDN <= WS_X, "ws map (weights)");
static_assert(WS_Z + (size_t)NTOK * NZ * 2 <= WS_XT && WS_MODP + (size_t)16 * 4 * 5 * NMOD * 4 <= WS_DT && WS_AM + (size_t)NTOK * KMRG * 2 <= WS_OF && WS_ACT + (size_t)NTOK * DFF * 2 <= WS_END, "ws map (activations)");
constexpr int CW_BAR = 4096;

constexpr int LDS_BYTES = 163840;
constexpr int MISC_OFF = LDS_BYTES - 256;
constexpr int NWAVES = 8;

#define RLX_AGENT __ATOMIC_RELAXED, __HIP_MEMORY_SCOPE_AGENT
#define LDS_WAIT() asm volatile("s_waitcnt lgkmcnt(0)" ::: "memory")
#define VM_WAIT() asm volatile("s_waitcnt vmcnt(0)" ::: "memory")
__device__ __forceinline__ unsigned cvt_pk_bf16(float lo, float hi) { unsigned r; asm volatile("v_cvt_pk_bf16_f32 %0, %1, %2" : "=v"(r) : "v"(lo), "v"(hi)); return r; }
__device__ __forceinline__ float bf_lo(unsigned w) { return __builtin_bit_cast(float, w << 16); }
__device__ __forceinline__ float bf_hi(unsigned w) { return __builtin_bit_cast(float, w & 0xffff0000u); }
__device__ __forceinline__ float bf2f(bf16 h) { return __builtin_bit_cast(float, (unsigned)h << 16); }
__device__ __forceinline__ bf16 f2bf(float f) { return (bf16)(cvt_pk_bf16(f, 0.f) & 0xffffu); }
#ifndef MK_F16
#define MK_F16 1
#endif
typedef _Float16 h16x2 __attribute__((ext_vector_type(2)));
typedef _Float16 h16x8 __attribute__((ext_vector_type(8)));
typedef float f32x16_t __attribute__((ext_vector_type(16)));
#if MK_F16
__device__ __forceinline__ unsigned pk_act(float lo, float hi) { h16x2 v; v[0] = (_Float16)lo; v[1] = (_Float16)hi; return __builtin_bit_cast(unsigned, v); }
__device__ __forceinline__ float lo_act(unsigned w) { return (float)__builtin_bit_cast(h16x2, w)[0]; }
__device__ __forceinline__ float hi_act(unsigned w) { return (float)__builtin_bit_cast(h16x2, w)[1]; }
__device__ __forceinline__ float act2f(bf16 h) { return (float)__builtin_bit_cast(_Float16, h); }
__device__ __forceinline__ bf16 f2act(float f) { return __builtin_bit_cast(bf16, (_Float16)f); }
__device__ __forceinline__ f32x4 mma16_act(bf16x8 a, bf16x8 b, f32x4 c) { return __builtin_amdgcn_mfma_f32_16x16x32_f16(__builtin_bit_cast(h16x8, a), __builtin_bit_cast(h16x8, b), c, 0, 0, 0); }
__device__ __forceinline__ f32x16_t mma32_act(bf16x8 a, bf16x8 b, f32x16_t c) { return __builtin_amdgcn_mfma_f32_32x32x16_f16(__builtin_bit_cast(h16x8, a), __builtin_bit_cast(h16x8, b), c, 0, 0, 0); }
#else
__device__ __forceinline__ unsigned pk_act(float lo, float hi) { return cvt_pk_bf16(lo, hi); }
__device__ __forceinline__ float lo_act(unsigned w) { return bf_lo(w); }
__device__ __forceinline__ float hi_act(unsigned w) { return bf_hi(w); }
__device__ __forceinline__ float act2f(bf16 h) { return bf2f(h); }
__device__ __forceinline__ bf16 f2act(float f) { return f2bf(f); }
__device__ __forceinline__ f32x4 mma16_act(bf16x8 a, bf16x8 b, f32x4 c) { return __builtin_amdgcn_mfma_f32_16x16x32_bf16(a, b, c, 0, 0, 0); }
__device__ __forceinline__ f32x16_t mma32_act(bf16x8 a, bf16x8 b, f32x16_t c) { return __builtin_amdgcn_mfma_f32_32x32x16_bf16(a, b, c, 0, 0, 0); }
#endif
template <int M> __device__ __forceinline__ float swz_xor(float v) { return __builtin_bit_cast(float, __builtin_amdgcn_ds_swizzle(__builtin_bit_cast(int, v), (M << 10) | 0x1f)); }
__device__ __forceinline__ float half_sum(float v) { v += swz_xor<1>(v); v += swz_xor<2>(v); v += swz_xor<4>(v); v += swz_xor<8>(v); v += swz_xor<16>(v); return v; }
__device__ __forceinline__ float wave_sum(float v) { v = half_sum(v);
    auto rr = __builtin_amdgcn_permlane32_swap(__float_as_uint(v), __float_as_uint(v), false, false); return __uint_as_float(rr[0]) + __uint_as_float(rr[1]); }
__device__ __forceinline__ float sigmoidf_(float x) { return __builtin_amdgcn_rcpf(1.f + __expf(-x)); }
__device__ __forceinline__ float siluf_(float x) { return x * sigmoidf_(x); }
__device__ __forceinline__ int opaque_tid() { int t = threadIdx.x; asm volatile("" : "+v"(t)); return t; }
__device__ __forceinline__ int mod_row(int r) { return r < NCTX ? 0 : 1 + ((r - NCTX) >> 10); }

namespace pg8 {
#define PG8_LAS __attribute__((address_space(3)))
typedef unsigned short bf16_t;
constexpr int BM = 256, BK = 64, HALF = 128, HTB = HALF * BK * 2  , STAGE_BYTES = 8 * HTB, NXCD = 8, WGM = 8;

__host__ __device__ __forceinline__ int lds_byte(int r, int c) { const int st = (r >> 4) * 2 + (c >> 5), rr = r & 15, cc = c & 31, ob = rr * 64 + cc * 2; return st * 1024 + (ob ^ (((ob >> 9) & 1) << 5)); }
__host__ __device__ __forceinline__ void stage_rc(int b, int& R, int& C) { const int st = b / 1024, sb = b % 1024, swz = sb ^ (((sb >> 9) & 1) << 5); R = (st >> 1) * 16 + swz / 64; C = (st & 1) * 32 + (swz % 64) / 2; }
__host__ __device__ __forceinline__ int perm32(int rho) { const int n = rho >> 4, i = rho & 15; return 8 * (i >> 2) + 4 * n + (i & 3); }

struct Unit { int pm, pn; };
struct Gemm { const bf16_t* A; const bf16_t* Bt; int M, N, K; };

struct StaticOrder {
    int nM, nN, nwg, G, c;
    __host__ __device__ void init(int M, int N, int G_, int c_) { nM = M / BM; nN = N / BM; nwg = nM * nN; G = G_; c = c_; }
    __host__ __device__ bool next(int i, Unit& u) const {
        const long L = (long)i * G + c; if (L >= nwg) return false;
        int wgid = (int)L; { const int q = nwg / NXCD, r = nwg % NXCD, xcd = wgid % NXCD, off = wgid / NXCD; wgid = (xcd < r ? xcd * (q + 1) : r * (q + 1) + (xcd - r) * q) + off; }
        const int nig = WGM * nN, gid = wgid / nig, fm = gid * WGM, gsz = (nM - fm) < WGM ? (nM - fm) : WGM;
        u.pm = fm + ((wgid % nig) % gsz); u.pn = (wgid % nig) / gsz; return true;
    }
    __device__ __forceinline__ void a_ready(const Unit&) const {}
    __device__ __forceinline__ void done(const Unit&) const {}
};

template <class Epi, class Sched, bool ALIGN_EPI = false, bool SP2 = false>
__device__ __forceinline__ void gemm_phase(PG8_LAS unsigned char* lds, const Gemm g, const Sched& S, const Epi& E) {
    const int tid = opaque_tid(), wid = __builtin_amdgcn_readfirstlane(tid >> 6), lane = tid & 63, wr = wid >> 2, wc = wid & 3, fr = lane & 15, fq = lane >> 4;
    const int K = g.K, nt = K / BK;
    unsigned voffA[2], voffB[2];
#pragma unroll
    for (int i = 0; i < 2; ++i) { int R, C; stage_rc(tid * 16 + i * 8192, R, C); const int Rb = Epi::PERM ? ((R & ~31) + perm32(R & 31)) : R;
        voffA[i] = (unsigned)(R * K + C) * 2u; voffB[i] = (unsigned)(Rb * K + C) * 2u; }
    const size_t kstep = (size_t)(BK * 2);
    const size_t hstep = (size_t)HALF * K * 2;
    const size_t tstep = 2 * hstep;
    const unsigned ldsw = (unsigned)wid * 1024u;
    const int aoff = lds_byte(wr * 64 + fr, fq * 8), boff = lds_byte(wc * 32 + fr, fq * 8);
#define PG8_SA(b, h) (((b) * 2 + (h)) * HTB)
#define PG8_SB(b, h) ((4 + (b) * 2 + (h)) * HTB)
#define PG8_STAGE(bufoff, gbase, voff) do { _Pragma("unroll") for (int _i = 0; _i < 2; ++_i) \
        __builtin_amdgcn_global_load_lds((const unsigned*)((const char*)(gbase) + (voff)[_i]), (PG8_LAS unsigned*)(lds + (bufoff) + ldsw + _i * 8192), 16, 0, 0); } while (0)
#define PG8_LDA(dst, b, h) do { _Pragma("unroll") for (int m = 0; m < 4; ++m) _Pragma("unroll") for (int k = 0; k < 2; ++k) dst[m][k] = *(const PG8_LAS bf16x8*)(lds + PG8_SA(b, h) + aoff + m * 2048 + k * 1024); } while (0)
#define PG8_LDB(dst, b, h) do { _Pragma("unroll") for (int n = 0; n < 2; ++n) _Pragma("unroll") for (int k = 0; k < 2; ++k) dst[n][k] = *(const PG8_LAS bf16x8*)(lds + PG8_SB(b, h) + boff + n * 2048 + k * 1024); } while (0)
#define PG8_MMA(ai, bj, At, Bt) do { __builtin_amdgcn_s_setprio(1); _Pragma("unroll") for (int m = 0; m < 4; ++m) _Pragma("unroll") for (int n = 0; n < 2; ++n) _Pragma("unroll") for (int k = 0; k < 2; ++k) \
        acc[ai][bj][m][n] = mma16_act(Bt[n][k], At[m][k], acc[ai][bj][m][n]); __builtin_amdgcn_s_setprio(0); } while (0)
#define PG8_WAIT_V(n) asm volatile("s_waitcnt vmcnt(" #n ")" ::: "memory")
#define PG8_WAIT_L(n) asm volatile("s_waitcnt lgkmcnt(" #n ")" ::: "memory")
#define PG8_BAR __builtin_amdgcn_s_barrier()
#define PG8_SCHED __builtin_amdgcn_sched_barrier(0)
    Unit cur, nxt; int ui = 0;
    if (!S.next(0, cur)) return;
    f32x4 acc[2][2][4][2];
#pragma unroll
    for (int a = 0; a < 2; ++a)
#pragma unroll
        for (int b = 0; b < 2; ++b)
#pragma unroll
            for (int m = 0; m < 4; ++m)
#pragma unroll
                for (int n = 0; n < 2; ++n) acc[a][b][m][n] = (f32x4){0.f, 0.f, 0.f, 0.f};
    bf16x8 At[4][2], B0[2][2], B1[2][2];
    const char* cA = (const char*)g.A + (size_t)cur.pm * tstep; const char* cB = (const char*)g.Bt + (size_t)cur.pn * tstep;
    S.a_ready(cur);
    if constexpr (SP2) {
        PG8_STAGE(PG8_SB(0, 0), cB, voffB); PG8_STAGE(PG8_SB(0, 1), cB + hstep, voffB); PG8_STAGE(PG8_SA(0, 0), cA, voffA); PG8_STAGE(PG8_SA(0, 1), cA + hstep, voffA);
        if (wr == 1) PG8_BAR;
        PG8_WAIT_V(2); PG8_BAR;
        PG8_STAGE(PG8_SB(1, 0), cB + kstep, voffB); PG8_STAGE(PG8_SA(1, 0), cA + kstep, voffA); PG8_STAGE(PG8_SB(1, 1), cB + hstep + kstep, voffB);
        PG8_WAIT_V(6); PG8_BAR;
    } else {
        PG8_STAGE(PG8_SB(0, 0), cB, voffB); PG8_STAGE(PG8_SA(0, 0), cA, voffA); PG8_STAGE(PG8_SB(0, 1), cB + hstep, voffB); PG8_STAGE(PG8_SA(0, 1), cA + hstep, voffA);
        if (wr == 1) PG8_BAR;
        PG8_WAIT_V(4); PG8_BAR;
        PG8_STAGE(PG8_SB(1, 0), cB + kstep, voffB); PG8_STAGE(PG8_SA(1, 0), cA + kstep, voffA); PG8_STAGE(PG8_SB(1, 1), cB + hstep + kstep, voffB);
        PG8_WAIT_V(6); PG8_BAR;
    }
    for (;;) {
        const bool has_next = S.next(ui + 1, nxt);
        const char* nA = has_next ? (const char*)g.A + (size_t)nxt.pm * tstep : cA; const char* nB = has_next ? (const char*)g.Bt + (size_t)nxt.pn * tstep : cB;
#pragma unroll
        for (int sgi = 0; sgi < Epi::NSEG; ++sgi) {
        const int t_beg = sgi == 0 ? 0 : Epi::seg_end(sgi - 1), t_end = sgi == Epi::NSEG - 1 ? nt : Epi::seg_end(sgi);
        for (int t = t_beg; t < t_end; t += 2) {
            const bool last = (t == nt - 2);
            const char* a1 = cA + (size_t)(t + 1) * kstep;
            const char* a2 = last ? nA : cA + (size_t)(t + 2) * kstep; const char* b2 = last ? nB : cB + (size_t)(t + 2) * kstep;
            const char* a3 = a2 + kstep; const char* b3 = b2 + kstep;
            if (last && has_next) S.a_ready(nxt);
            if constexpr (SP2) {
            PG8_LDB(B0, 0, 0); PG8_LDB(B1, 0, 1); PG8_SCHED; PG8_LDA(At, 0, 0); PG8_STAGE(PG8_SA(1, 1), a1 + hstep, voffA);
            PG8_WAIT_V(8); PG8_WAIT_L(0); PG8_BAR; PG8_MMA(0, 0, At, B0); PG8_MMA(0, 1, At, B1); PG8_BAR; PG8_SCHED;
            PG8_LDA(At, 0, 1); PG8_STAGE(PG8_SB(0, 0), b2, voffB); PG8_STAGE(PG8_SB(0, 1), b2 + hstep, voffB); PG8_STAGE(PG8_SA(0, 0), a2, voffA);
            PG8_WAIT_V(8); PG8_WAIT_L(0); PG8_BAR; PG8_MMA(1, 0, At, B0); PG8_MMA(1, 1, At, B1); PG8_BAR; PG8_SCHED;
            PG8_LDB(B0, 1, 0); PG8_LDB(B1, 1, 1); PG8_SCHED; PG8_LDA(At, 1, 0); PG8_STAGE(PG8_SA(0, 1), a2 + hstep, voffA);
            PG8_WAIT_V(8); PG8_WAIT_L(0); PG8_BAR; PG8_MMA(0, 0, At, B0); PG8_MMA(0, 1, At, B1); PG8_BAR; PG8_SCHED;
            PG8_LDA(At, 1, 1); PG8_STAGE(PG8_SB(1, 0), b3, voffB); PG8_STAGE(PG8_SB(1, 1), b3 + hstep, voffB); PG8_STAGE(PG8_SA(1, 0), a3, voffA);
            PG8_WAIT_V(8); PG8_WAIT_L(0); PG8_BAR; PG8_MMA(1, 0, At, B0); PG8_MMA(1, 1, At, B1); PG8_BAR; PG8_SCHED;
            } else {
            PG8_LDB(B0, 0, 0); PG8_SCHED; PG8_LDA(At, 0, 0); PG8_STAGE(PG8_SA(1, 1), a1 + hstep, voffA);
            PG8_WAIT_L(8); PG8_BAR; PG8_WAIT_L(0); PG8_MMA(0, 0, At, B0); PG8_BAR; PG8_SCHED;
            PG8_LDB(B1, 0, 1); PG8_STAGE(PG8_SB(0, 0), b2, voffB);
            PG8_BAR; PG8_WAIT_L(0); PG8_MMA(0, 1, At, B1); PG8_BAR;
            PG8_LDA(At, 0, 1); PG8_STAGE(PG8_SA(0, 0), a2, voffA);
            PG8_BAR; PG8_WAIT_L(0); PG8_MMA(1, 0, At, B0); PG8_BAR; PG8_SCHED;
            PG8_STAGE(PG8_SB(0, 1), b2 + hstep, voffB);
            PG8_WAIT_V(6); PG8_BAR; PG8_MMA(1, 1, At, B1); PG8_BAR;
            PG8_LDB(B0, 1, 0); PG8_SCHED; PG8_LDA(At, 1, 0); PG8_STAGE(PG8_SA(0, 1), a2 + hstep, voffA);
            PG8_WAIT_L(8); PG8_BAR; PG8_WAIT_L(0); PG8_MMA(0, 0, At, B0); PG8_BAR; PG8_SCHED;
            PG8_LDB(B1, 1, 1); PG8_STAGE(PG8_SB(1, 0), b3, voffB);
            PG8_BAR; PG8_WAIT_L(0); PG8_MMA(0, 1, At, B1); PG8_BAR;
            PG8_LDA(At, 1, 1); PG8_STAGE(PG8_SA(1, 0), a3, voffA);
            PG8_BAR; PG8_WAIT_L(0); PG8_MMA(1, 0, At, B0); PG8_BAR; PG8_SCHED;
            PG8_STAGE(PG8_SB(1, 1), b3 + hstep, voffB);
            PG8_WAIT_V(6); PG8_BAR; PG8_MMA(1, 1, At, B1); PG8_BAR;
            }
        }
        if constexpr (Epi::NSEG > 1) { if (sgi < Epi::NSEG - 1) E.mid(acc, cur, sgi, wr, wc, fr, fq); }
        }
        if constexpr (ALIGN_EPI) { if (wr == 0) PG8_BAR; }
        E(acc, cur, wr, wc, fr, fq); S.done(cur);
        if (!has_next) break;
#pragma unroll
        for (int a = 0; a < 2; ++a)
#pragma unroll
            for (int b = 0; b < 2; ++b)
#pragma unroll
                for (int m = 0; m < 4; ++m)
#pragma unroll
                    for (int n = 0; n < 2; ++n) acc[a][b][m][n] = (f32x4){0.f, 0.f, 0.f, 0.f};
        cur = nxt; cA = nA; cB = nB; ++ui;
        if constexpr (ALIGN_EPI) { if (wr == 1) PG8_BAR; }
    }
    PG8_WAIT_V(0);
    if constexpr (!ALIGN_EPI) { if (wr == 0) PG8_BAR; }
    PG8_BAR;
#undef PG8_SA
#undef PG8_SB
#undef PG8_STAGE
#undef PG8_LDA
#undef PG8_LDB
#undef PG8_MMA
#undef PG8_WAIT_V
#undef PG8_WAIT_L
#undef PG8_BAR
#undef PG8_SCHED
}

struct EpiStoreBf16 {
    static constexpr bool PERM = true; static constexpr int NSEG = 1; static constexpr int seg_end(int) { return 0; }
    bf16_t* O; int ldc;
    __device__ __forceinline__ void operator()(f32x4 (&acc)[2][2][4][2], const Unit& u, int wr, int wc, int fr, int fq) const {
        bf16_t* base = O + (size_t)(u.pm * BM + wr * 64 + fr) * ldc + u.pn * BM + wc * 32 + 8 * fq;
#pragma unroll
        for (int ai = 0; ai < 2; ++ai)
#pragma unroll
            for (int m = 0; m < 4; ++m) { bf16_t* rowp = base + (size_t)(ai * HALF + m * 16) * ldc;
#pragma unroll
                for (int bj = 0; bj < 2; ++bj) { const f32x4 v0 = acc[ai][bj][m][0], v1 = acc[ai][bj][m][1];
                    u32x4 w; w.x = pk_act(v0[0], v0[1]); w.y = pk_act(v0[2], v0[3]); w.z = pk_act(v1[0], v1[1]); w.w = pk_act(v1[2], v1[3]);
                    *(u32x4*)(rowp + bj * HALF) = w; } }
    }
};
struct EpiDft {
    static constexpr bool PERM = true; static constexpr int NSEG = 1; static constexpr int seg_end(int) { return 0; }
    bf16_t* AM; int tshift, tokbase;
    __device__ __forceinline__ void operator()(f32x4 (&acc)[2][2][4][2], const Unit& u, int wr, int wc, int fr, int fq) const {
        const int k0 = u.pm * BM, part = k0 >> tshift, kk0 = k0 & ((1 << tshift) - 1), b = u.pn >> 2, ch0 = (u.pn & 3) * BM;
        bf16_t* base = AM + (size_t)(tokbase + (b << tshift) + kk0 + wr * 64 + fr) * KMRG + part * 1024 + ch0 + wc * 32 + 8 * fq;
#pragma unroll
        for (int ai = 0; ai < 2; ++ai)
#pragma unroll
            for (int m = 0; m < 4; ++m) { bf16_t* rowp = base + (size_t)(ai * HALF + m * 16) * KMRG;
#pragma unroll
                for (int bj = 0; bj < 2; ++bj) { const f32x4 v0 = acc[ai][bj][m][0], v1 = acc[ai][bj][m][1];
                    u32x4 w; w.x = pk_act(v0[0], v0[1]); w.y = pk_act(v0[2], v0[3]); w.z = pk_act(v1[0], v1[1]); w.w = pk_act(v1[2], v1[3]);
                    *(u32x4*)(rowp + bj * HALF) = w; } }
    }
};
struct EpiMerged {
    static constexpr bool PERM = true; static constexpr int NSEG = 3; static constexpr int seg_end(int s) { return s == 0 ? 32 : 48; }
    bf16_t* O; const bf16_t* Z;
    __device__ __forceinline__ void scale_by(f32x4 (&acc)[2][2][4][2], const Unit& u, int wr, int wc, int fr, int fq, int gnum, int gden) const {
        int lo_ = fr * NZ + 8 * fq; asm volatile("" : "+v"(lo_));
        const bf16_t* zb = Z + (size_t)(u.pm * BM + wr * 64) * NZ + ZGATE + u.pn * BM + wc * 32 + lo_;
#pragma unroll
        for (int ai = 0; ai < 2; ++ai) {
            u32x4 gn[4][2], gd[4][2];
#pragma unroll
            for (int m = 0; m < 4; ++m)
#pragma unroll
                for (int bj = 0; bj < 2; ++bj) { const bf16_t* zr = zb + (size_t)(ai * HALF + m * 16) * NZ + bj * HALF;
                    gn[m][bj] = *(const u32x4*)(zr + gnum * DM); if (gden >= 0) gd[m][bj] = *(const u32x4*)(zr + gden * DM); else gd[m][bj] = (u32x4){0u, 0u, 0u, 0u}; }
#pragma unroll
            for (int m = 0; m < 4; ++m)
#pragma unroll
                for (int bj = 0; bj < 2; ++bj) {
                    float s[8];
#pragma unroll
                    for (int q = 0; q < 4; ++q) {
                        const float n0 = 1.f + __expf(-lo_act(gn[m][bj][q])), n1 = 1.f + __expf(-hi_act(gn[m][bj][q]));
                        float d0 = 1.f, d1 = 1.f; if (gden >= 0) { d0 = 1.f + __expf(-lo_act(gd[m][bj][q])); d1 = 1.f + __expf(-hi_act(gd[m][bj][q])); }
                        s[2 * q] = d0 * __builtin_amdgcn_rcpf(n0); s[2 * q + 1] = d1 * __builtin_amdgcn_rcpf(n1); }
                    f32x4 v0 = acc[ai][bj][m][0], v1 = acc[ai][bj][m][1];
                    v0[0] *= s[0]; v0[1] *= s[1]; v0[2] *= s[2]; v0[3] *= s[3]; v1[0] *= s[4]; v1[1] *= s[5]; v1[2] *= s[6]; v1[3] *= s[7];
                    acc[ai][bj][m][0] = v0; acc[ai][bj][m][1] = v1; }
            asm volatile("" ::: "memory"); }
    }
    __device__ __forceinline__ void mid(f32x4 (&acc)[2][2][4][2], const Unit& u, int s, int wr, int wc, int fr, int fq) const {
        if (s == 0) scale_by(acc, u, wr, wc, fr, fq, 0, 1); else scale_by(acc, u, wr, wc, fr, fq, 1, 2);
    }
    __device__ __forceinline__ void operator()(f32x4 (&acc)[2][2][4][2], const Unit& u, int wr, int wc, int fr, int fq) const {
        scale_by(acc, u, wr, wc, fr, fq, 2, -1);
        bf16_t* base = O + (size_t)(u.pm * BM + wr * 64 + fr) * DM + u.pn * BM + wc * 32 + 8 * fq;
#pragma unroll
        for (int ai = 0; ai < 2; ++ai)
#pragma unroll
            for (int m = 0; m < 4; ++m) { bf16_t* rowp = base + (size_t)(ai * HALF + m * 16) * DM;
#pragma unroll
                for (int bj = 0; bj < 2; ++bj) { const f32x4 v0 = acc[ai][bj][m][0], v1 = acc[ai][bj][m][1];
                    u32x4 w; w.x = pk_act(v0[0], v0[1]); w.y = pk_act(v0[2], v0[3]); w.z = pk_act(v1[0], v1[1]); w.w = pk_act(v1[2], v1[3]);
                    *(u32x4*)(rowp + bj * HALF) = w; } }
    }
};
struct EpiResid {
    static constexpr bool PERM = false; static constexpr int NSEG = 1; static constexpr int seg_end(int) { return 0; }
    float* X; const float* gate;
    __device__ __forceinline__ void operator()(f32x4 (&acc)[2][2][4][2], const Unit& u, int wr, int wc, int fr, int fq) const {
        int lo_ = fr * DM + 4 * fq; asm volatile("" : "+v"(lo_));
        const int col0 = u.pn * BM + wc * 32;
        const float* gp = gate + (size_t)mod_row(u.pm * BM) * NMOD + col0 + 4 * fq;
        float* xb = X + (size_t)(u.pm * BM + wr * 64) * DM + col0 + lo_;
        f32x4 gv[2][2];
#pragma unroll
        for (int bj = 0; bj < 2; ++bj)
#pragma unroll
            for (int n = 0; n < 2; ++n) gv[bj][n] = *(const f32x4*)(gp + bj * HALF + n * 16);
#pragma unroll
        for (int ai = 0; ai < 2; ++ai) {
            f32x4 xv[4][2][2];
#pragma unroll
            for (int m = 0; m < 4; ++m)
#pragma unroll
                for (int bj = 0; bj < 2; ++bj)
#pragma unroll
                    for (int n = 0; n < 2; ++n) xv[m][bj][n] = *(const f32x4*)(xb + (size_t)(ai * HALF + m * 16) * DM + bj * HALF + n * 16);
#pragma unroll
            for (int m = 0; m < 4; ++m)
#pragma unroll
                for (int bj = 0; bj < 2; ++bj)
#pragma unroll
                    for (int n = 0; n < 2; ++n) *(f32x4*)(xb + (size_t)(ai * HALF + m * 16) * DM + bj * HALF + n * 16) = xv[m][bj][n] + gv[bj][n] * acc[ai][bj][m][n];
            asm volatile("" ::: "memory"); }
    }
};
}

namespace att {
constexpr int D = 128, NW = 8, QBLK = 32, KVBLK = 64;
constexpr float SCALE = 0.088388347648318440f;
constexpr float THR = 8.f;
constexpr int LDQ = 1024, LDK = 256, LDO = KMRG;
constexpr int SHM_V = KVBLK * D * 2, SHM_K = KVBLK * D * 2, SHM_ATTN = 2 * SHM_V + 2 * SHM_K + NW * 64 * 4;
typedef __attribute__((ext_vector_type(4))) short s16x4;
typedef __attribute__((ext_vector_type(16))) float f32x16;
#define KSWZ(row, colB) ((row) * 256 + ((colB) ^ (((row) & 7) << 4)))
#define SBAR() __builtin_amdgcn_sched_barrier(0)
__device__ __forceinline__ int crow(int r, int hi) { return (r & 3) + 8 * (r >> 2) + 4 * hi; }

__device__ __forceinline__ void partialSM(f32x16& p0, f32x16& p1, float& m_reg, float& mn, float& alpha) {
  constexpr float C = SCALE * 1.4426950408889634f;
  float pmax = p0[0];
#pragma unroll
  for (int r = 1; r < 16; ++r) pmax = fmaxf(pmax, p0[r]);
#pragma unroll
  for (int r = 0; r < 16; ++r) pmax = fmaxf(pmax, p1[r]);
  { auto rr = __builtin_amdgcn_permlane32_swap(__float_as_uint(pmax), __float_as_uint(pmax), false, false);
    pmax = fmaxf(__uint_as_float(rr[0]), __uint_as_float(rr[1])); }
  if (__builtin_expect(__all(pmax - m_reg <= THR / SCALE), 1)) { mn = m_reg; alpha = 1.f; }
  else { mn = fmaxf(m_reg, pmax); alpha = __builtin_amdgcn_exp2f((m_reg - mn) * C); m_reg = mn; }
  float mnC = -mn * C;
#pragma unroll
  for (int r = 0; r < 16; ++r) p0[r] = fmaf(p0[r], C, mnC);
#pragma unroll
  for (int r = 0; r < 16; ++r) p1[r] = fmaf(p1[r], C, mnC);
#pragma unroll
  for (int r = 0; r < 16; ++r) p0[r] = __builtin_amdgcn_exp2f(p0[r]);
}
__device__ __forceinline__ void finishSM(f32x16& p0, f32x16& p1, float alpha, float& l_reg, bf16x8& pa0, bf16x8& pa1, bf16x8& pa2, bf16x8& pa3) {
#pragma unroll
  for (int r = 0; r < 16; ++r) p1[r] = __builtin_amdgcn_exp2f(p1[r]);
  float ps = 0;
#pragma unroll
  for (int r = 0; r < 16; ++r) ps += p0[r];
#pragma unroll
  for (int r = 0; r < 16; ++r) ps += p1[r];
  { auto rr = __builtin_amdgcn_permlane32_swap(__float_as_uint(ps), __float_as_uint(ps), false, false);
    ps = __uint_as_float(rr[0]) + __uint_as_float(rr[1]); }
  l_reg = l_reg * alpha + ps;
#define PK4(P, BASE, OUT) do { unsigned a0 = pk_act(P[BASE + 0], P[BASE + 1]), a1 = pk_act(P[BASE + 2], P[BASE + 3]);   \
    unsigned b0 = pk_act(P[BASE + 4], P[BASE + 5]), b1 = pk_act(P[BASE + 6], P[BASE + 7]);                              \
    auto r0 = __builtin_amdgcn_permlane32_swap(a0, b0, false, false); auto r1 = __builtin_amdgcn_permlane32_swap(a1, b1, false, false); \
    u32x4 w = {r0[0], r1[0], r0[1], r1[1]}; OUT = *reinterpret_cast<bf16x8*>(&w); } while (0)
  PK4(p0, 0, pa0); PK4(p0, 8, pa1); PK4(p1, 0, pa2); PK4(p1, 8, pa3);
#undef PK4
}
__device__ __forceinline__ void qkt(f32x16& p0, f32x16& p1, const LAS char* Ks, const bf16x8* qr, int r32, int hi) {
  p0 = f32x16{}; p1 = f32x16{};
#pragma unroll
  for (int d0 = 0; d0 < 8; ++d0) { int cb = (d0 * 16 + hi * 8) * 2;
    bf16x8 b0 = *reinterpret_cast<const LAS bf16x8*>(Ks + KSWZ(r32, cb));
    bf16x8 b1 = *reinterpret_cast<const LAS bf16x8*>(Ks + KSWZ(32 + r32, cb));
    p0 = mma32_act(b0, qr[d0], p0);
    p1 = mma32_act(b1, qr[d0], p1); }
}
__device__ __forceinline__ int v_st(int k, int c) { const int kk = (k & ~0xC) | ((k & 4) << 1) | ((k & 8) >> 1); return ((kk >> 3) * 4 + (c >> 5)) * 512 + ((kk & 7) * 32 + (c & 31)) * 2; }
__device__ __forceinline__ int v_rd_base(int lane) { return ((lane & 3) << 3) | (((lane >> 2) & 3) << 6) | (((lane >> 4) & 1) << 5) | (((lane >> 5) & 1) << 8); }
constexpr int v_rd_off(int d0, int ks, int half) { return d0 * 512 + ks * 4096 + half * 2048; }
template <int OFF> __device__ __forceinline__ s16x4 tr_read(int vb) {
  s16x4 r; asm volatile("ds_read_b64_tr_b16 %0, %1 offset:%2" : "=&v"(r) : "v"(vb), "i"(OFF) : "memory"); return r;
}
template <int D0> __device__ __forceinline__ void pv_one(f32x16& od, int vb, bf16x8 pa0, bf16x8 pa1, bf16x8 pa2, bf16x8 pa3) {
  const s16x4 l0 = tr_read<v_rd_off(D0, 0, 0)>(vb), h0 = tr_read<v_rd_off(D0, 0, 1)>(vb), l1 = tr_read<v_rd_off(D0, 1, 0)>(vb), h1 = tr_read<v_rd_off(D0, 1, 1)>(vb);
  const s16x4 l2 = tr_read<v_rd_off(D0, 2, 0)>(vb), h2 = tr_read<v_rd_off(D0, 2, 1)>(vb), l3 = tr_read<v_rd_off(D0, 3, 0)>(vb), h3 = tr_read<v_rd_off(D0, 3, 1)>(vb);
  asm volatile("s_waitcnt lgkmcnt(0)" ::: "memory"); SBAR();
#define PK(L, H) (bf16x8){L[0], L[1], L[2], L[3], H[0], H[1], H[2], H[3]}
  od = mma32_act(pa0, PK(l0, h0), od);
  od = mma32_act(pa1, PK(l1, h1), od);
  od = mma32_act(pa2, PK(l2, h2), od);
  od = mma32_act(pa3, PK(l3, h3), od);
#undef PK
}
__device__ __forceinline__ void pv_d0(f32x16* o, int vb, bf16x8 pa0, bf16x8 pa1, bf16x8 pa2, bf16x8 pa3) {
  pv_one<0>(o[0], vb, pa0, pa1, pa2, pa3); pv_one<1>(o[1], vb, pa0, pa1, pa2, pa3); pv_one<2>(o[2], vb, pa0, pa1, pa2, pa3); pv_one<3>(o[3], vb, pa0, pa1, pa2, pa3);
}

__device__ __forceinline__ void attn_dense_body(const bf16* __restrict__ Qb, const bf16* __restrict__ Kh, const bf16* __restrict__ Vh,
                                                bf16* __restrict__ Ob, int seq, LAS char* lds) {
  const int tid = opaque_tid(), wid = tid >> 6, lane = tid & 63, r32 = lane & 31, hi = lane >> 5;
  LAS char* V_lds = lds; LAS char* K_lds = lds + 2 * SHM_V;
  LAS float* ws = (LAS float*)(lds + 2 * SHM_V + 2 * SHM_K) + wid * 64; LAS float* li_l = ws; LAS float* al_l = ws + 32;
  float m_reg = -1e30f, l_reg = 0; f32x16 o[4] = {}; bf16x8 qr[8];
  { const bf16* Qw = Qb + (long)(wid * QBLK + r32) * LDQ + hi * 8;
#pragma unroll
    for (int d0 = 0; d0 < 8; ++d0) qr[d0] = *reinterpret_cast<const bf16x8*>(Qw + d0 * 16); }
  const int sr = tid >> 4, sc = (tid & 15) * 8, vst0 = v_st(sr, sc), vst1 = v_st(32 + sr, sc);
  const int vb0 = (int)(unsigned)(uintptr_t)V_lds + v_rd_base(lane);
  struct { bf16x8 vs0, vs1, ks0, ks1; } sr_[2];
#define SLOAD(i, k0) do { sr_[i].vs0 = *reinterpret_cast<const bf16x8*>(&Vh[(long)((k0) + sr) * LDK + sc]); sr_[i].vs1 = *reinterpret_cast<const bf16x8*>(&Vh[(long)((k0) + 32 + sr) * LDK + sc]); \
    sr_[i].ks0 = *reinterpret_cast<const bf16x8*>(&Kh[(long)((k0) + sr) * LDK + sc]); sr_[i].ks1 = *reinterpret_cast<const bf16x8*>(&Kh[(long)((k0) + 32 + sr) * LDK + sc]); } while (0)
#define SWRITE(b, i) do { *(LAS bf16x8*)(V_lds + (b) * SHM_V + vst0) = sr_[i].vs0;          \
    *(LAS bf16x8*)(V_lds + (b) * SHM_V + vst1) = sr_[i].vs1; int kc = sc * 2;               \
    *(LAS bf16x8*)(K_lds + (b) * SHM_K + KSWZ(sr, kc)) = sr_[i].ks0;                       \
    *(LAS bf16x8*)(K_lds + (b) * SHM_K + KSWZ(32 + sr, kc)) = sr_[i].ks1; } while (0)
#define SWAIT() asm volatile("s_waitcnt vmcnt(4)" ::: "memory")
#define RESC(a) do { if (__any((a) < 1.f)) { if (hi == 0) al_l[r32] = (a); asm volatile("s_waitcnt lgkmcnt(0)" ::: "memory"); \
    _Pragma("unroll") for (int d = 0; d < 4; ++d) _Pragma("unroll") for (int r = 0; r < 16; ++r) o[d][r] *= al_l[crow(r, hi)]; } } while (0)
  f32x16 pA0, pA1, pB0, pB1; float mnA, mnB, alA, alB; bf16x8 pa0, pa1, pa2, pa3; const int NT = seq / KVBLK;
  constexpr int SE = 0, SO = 1;
  SLOAD(SE, 0); asm volatile("s_waitcnt vmcnt(0)" ::: "memory"); SWRITE(0, SE); __syncthreads();
  qkt(pA0, pA1, K_lds, qr, r32, hi); partialSM(pA0, pA1, m_reg, mnA, alA);
  SLOAD(SO, KVBLK); if (2 < NT) SLOAD(SE, 2 * KVBLK);
  SWAIT(); SWRITE(1, SO); __syncthreads();
  for (int j = 1; j + 1 < NT; j += 2) {
    SBAR(); qkt(pB0, pB1, K_lds + SHM_K, qr, r32, hi);
    finishSM(pA0, pA1, alA, l_reg, pa0, pa1, pa2, pa3); SBAR();
    SLOAD(SO, (j + 2) * KVBLK); SBAR();
    pv_d0(o, vb0, pa0, pa1, pa2, pa3); partialSM(pB0, pB1, m_reg, mnB, alB);
    __syncthreads(); SWAIT(); SWRITE(0, SE);
    RESC(alB); __syncthreads();
    SBAR(); qkt(pA0, pA1, K_lds, qr, r32, hi);
    finishSM(pB0, pB1, alB, l_reg, pa0, pa1, pa2, pa3); SBAR();
    if (j + 3 < NT) SLOAD(SE, (j + 3) * KVBLK); SBAR();
    pv_d0(o, vb0 + (int)SHM_V, pa0, pa1, pa2, pa3); partialSM(pA0, pA1, m_reg, mnA, alA);
    __syncthreads(); SWAIT(); SWRITE(1, SO);
    RESC(alA); __syncthreads();
  }
  SBAR(); qkt(pB0, pB1, K_lds + SHM_K, qr, r32, hi);
  finishSM(pA0, pA1, alA, l_reg, pa0, pa1, pa2, pa3); SBAR();
  pv_d0(o, vb0, pa0, pa1, pa2, pa3); partialSM(pB0, pB1, m_reg, mnB, alB);
  __syncthreads(); RESC(alB);
  finishSM(pB0, pB1, alB, l_reg, pa0, pa1, pa2, pa3); SBAR();
  pv_d0(o, vb0 + (int)SHM_V, pa0, pa1, pa2, pa3);
  if (hi == 0) li_l[r32] = l_reg; asm volatile("s_waitcnt lgkmcnt(0)" ::: "memory");
  float rli[16];
#pragma unroll
  for (int r = 0; r < 16; ++r) rli[r] = __builtin_amdgcn_rcpf(li_l[crow(r, hi)]);
  bf16* Ow = Ob + (long)(wid * QBLK) * LDO;
#pragma unroll
  for (int r = 0; r < 16; ++r) { int orow = crow(r, hi);
#pragma unroll
    for (int d0 = 0; d0 < 4; ++d0) Ow[(long)orow * LDO + d0 * 32 + r32] = f2act(o[d0][r] * rli[r]); }
  __syncthreads();
#undef SLOAD
#undef SWRITE
#undef SWAIT
#undef RESC
}
#undef KSWZ
#undef SBAR
}

namespace gla {
constexpr int L_LA = 0;
constexpr int L_TOT = L_LA + 64 * 132 * 4;
constexpr int L_EB = L_TOT + 2048;
constexpr int L_WG = L_EB + 512;
constexpr int L_BG = L_WG + 8192;
constexpr int L_QE = L_BG + 512;
constexpr int L_KE = L_QE + 64 * 136 * 2;
constexpr int L_SB = L_KE + 64 * 136 * 2;
constexpr int L_KLT = L_SB + 64 * 136 * 2;
constexpr int L_VT = L_KLT + 128 * 72 * 2;
constexpr int L_ATT = L_VT + 64 * 72 * 2;
constexpr int L_END = L_ATT + 64 * 72 * 2;
static_assert(L_END <= MISC_OFF, "GLA LDS map");

__device__ __forceinline__ float log_sigmoid(float x) { return fminf(x, 0.f) - __logf(1.f + __expf(-fabsf(x))); }
__device__ __forceinline__ f32x4 mma16(bf16x8 a, bf16x8 b, f32x4 c) { return __builtin_amdgcn_mfma_f32_16x16x32_bf16(a, b, c, 0, 0, 0); }

__device__ __forceinline__ void gla_item(LAS unsigned char* lds, const bf16* __restrict__ Z, float* __restrict__ OUT, const float* __restrict__ wg, const float* __restrict__ bg,
                                         const float* __restrict__ st_in, float* __restrict__ st_out, int T, int tokbase, int h, int dir, int dvq) {
    const int tid = opaque_tid(), lane = tid & 63, w = __builtin_amdgcn_readfirstlane(tid >> 6), fr = lane & 15, fq = lane >> 4;
    LAS float* LA = (LAS float*)(lds + L_LA); LAS float* TOT = (LAS float*)(lds + L_TOT); LAS float* EB = (LAS float*)(lds + L_EB);
    LAS float* WG = (LAS float*)(lds + L_WG); LAS float* BG = (LAS float*)(lds + L_BG);
    LAS unsigned char* QE = lds + L_QE; LAS unsigned char* KE = lds + L_KE; LAS unsigned char* SB = lds + L_SB;
    LAS unsigned char* KLT = lds + L_KLT; LAS unsigned char* VT = lds + L_VT; LAS unsigned char* ATT = lds + L_ATT;
    const int NC = T >> 6;
    for (int idx = tid; idx < 16 * 128; idx += 512) WG[idx] = wg[(idx >> 7) * 512 + (idx & 127)];
    if (tid < 128) BG[tid] = bg[tid];
    f32x4 S[4];
    const int soff = (16 * w + 4 * fq) * 256 + dvq * 64 + fr;
#pragma unroll
    for (int n = 0; n < 4; ++n) S[n] = (f32x4){0.f, 0.f, 0.f, 0.f};
    if (st_in) {
#pragma unroll
        for (int n = 0; n < 4; ++n)
#pragma unroll
            for (int r = 0; r < 4; ++r) S[n][r] = st_in[soff + r * 256 + n * 16];
    }
    const int i0 = tid >> 4, g8 = tid & 15;
    const int iv = tid >> 3, vg = tid & 7;
    const int gacol = dir ? ZGAB : ZGAF;
    u32x4 rq[2], rk[2], rga[2][2], rv;
#define GLA_ROW(c, i) ((size_t)(tokbase + (dir ? (T - 1 - ((c) * 64 + (i))) : ((c) * 64 + (i)))))
#define GLA_LOAD(c) do { _Pragma("unroll") for (int e = 0; e < 2; ++e) { const bf16* zr = Z + GLA_ROW(c, i0 + 32 * e) * NZ; \
        rq[e] = *(const u32x4*)(zr + ZGQ + h * 128 + g8 * 8); rk[e] = *(const u32x4*)(zr + ZGK + h * 128 + g8 * 8); \
        rga[e][0] = *(const u32x4*)(zr + gacol); rga[e][1] = *(const u32x4*)(zr + gacol + 8); } \
        rv = *(const u32x4*)(Z + GLA_ROW(c, iv) * NZ + ZGV + h * 256 + dvq * 64 + vg * 8); } while (0)
    GLA_LOAD(0);
    __syncthreads();
    for (int c = 0; c < NC; ++c) {
#pragma unroll
        for (int e = 0; e < 2; ++e) {
            float x[8];
            { const f32x4 b0 = *(const LAS f32x4*)(BG + g8 * 8), b1 = *(const LAS f32x4*)(BG + g8 * 8 + 4);
#pragma unroll
              for (int j = 0; j < 4; ++j) { x[j] = b0[j]; x[4 + j] = b1[j]; } }
#pragma unroll
            for (int r = 0; r < 16; ++r) { const unsigned wd = rga[e][r >> 3][(r & 7) >> 1]; const float gar = (r & 1) ? hi_act(wd) : lo_act(wd);
                const f32x4 w0 = *(const LAS f32x4*)(WG + r * 128 + g8 * 8), w1 = *(const LAS f32x4*)(WG + r * 128 + g8 * 8 + 4);
#pragma unroll
                for (int j = 0; j < 4; ++j) { x[j] = fmaf(gar, w0[j], x[j]); x[4 + j] = fmaf(gar, w1[j], x[4 + j]); }
                if (r & 1) asm volatile("" ::: "memory"); }
            f32x4 o0, o1;
#pragma unroll
            for (int j = 0; j < 4; ++j) { o0[j] = log_sigmoid(x[j]) * 0.0625f; o1[j] = log_sigmoid(x[4 + j]) * 0.0625f; }
            *(LAS f32x4*)(LA + (i0 + 32 * e) * 132 + g8 * 8) = o0; *(LAS f32x4*)(LA + (i0 + 32 * e) * 132 + g8 * 8 + 4) = o1;
        }
        __syncthreads();
        { const int d = tid & 127, seg = tid >> 7; float run = 0.f;
#pragma unroll
          for (int ii = 0; ii < 16; ++ii) { run += LA[(seg * 16 + ii) * 132 + d]; LA[(seg * 16 + ii) * 132 + d] = run; }
          TOT[seg * 128 + d] = run; }
        __syncthreads();
        {
            float t0[8], t1[8], t2[8], t3[8];
            { const f32x4 a0 = *(const LAS f32x4*)(TOT + g8 * 8), a1 = *(const LAS f32x4*)(TOT + g8 * 8 + 4), b0 = *(const LAS f32x4*)(TOT + 128 + g8 * 8), b1 = *(const LAS f32x4*)(TOT + 128 + g8 * 8 + 4);
              const f32x4 c0 = *(const LAS f32x4*)(TOT + 256 + g8 * 8), c1 = *(const LAS f32x4*)(TOT + 256 + g8 * 8 + 4), d0 = *(const LAS f32x4*)(TOT + 384 + g8 * 8), d1 = *(const LAS f32x4*)(TOT + 384 + g8 * 8 + 4);
#pragma unroll
              for (int j = 0; j < 4; ++j) { t0[j] = a0[j]; t0[4 + j] = a1[j]; t1[j] = b0[j]; t1[4 + j] = b1[j]; t2[j] = c0[j]; t2[4 + j] = c1[j]; t3[j] = d0[j]; t3[4 + j] = d1[j]; } }
            float blast[8];
#pragma unroll
            for (int j = 0; j < 8; ++j) blast[j] = (t0[j] + t1[j]) + (t2[j] + t3[j]);
            if (tid < 16) {
#pragma unroll
                for (int j = 0; j < 8; ++j) EB[g8 * 8 + j] = __expf(blast[j]); }
#pragma unroll
            for (int e = 0; e < 2; ++e) {
                const int i = i0 + 32 * e, seg = i >> 4;
                const f32x4 l0 = *(const LAS f32x4*)(LA + i * 132 + g8 * 8), l1 = *(const LAS f32x4*)(LA + i * 132 + g8 * 8 + 4);
                float bq[8], kl[8], qe[8], ke[8], qv[8], kv[8];
#pragma unroll
                for (int q = 0; q < 4; ++q) { qv[2 * q] = lo_act(rq[e][q]); qv[2 * q + 1] = hi_act(rq[e][q]); kv[2 * q] = lo_act(rk[e][q]); kv[2 * q + 1] = hi_act(rk[e][q]); }
#pragma unroll
                for (int j = 0; j < 8; ++j) { float off = 0.f; if (seg > 0) off += t0[j]; if (seg > 1) off += t1[j]; if (seg > 2) off += t2[j];
                    bq[j] = (j < 4 ? l0[j] : l1[j - 4]) + off;
                    qe[j] = qv[j] * 0.088388347648318440f * __expf(bq[j]); ke[j] = kv[j] * __expf(-bq[j]); kl[j] = kv[j] * __expf(blast[j] - bq[j]); }
                u32x4 wq = {cvt_pk_bf16(qe[0], qe[1]), cvt_pk_bf16(qe[2], qe[3]), cvt_pk_bf16(qe[4], qe[5]), cvt_pk_bf16(qe[6], qe[7])};
                u32x4 wk = {cvt_pk_bf16(ke[0], ke[1]), cvt_pk_bf16(ke[2], ke[3]), cvt_pk_bf16(ke[4], ke[5]), cvt_pk_bf16(ke[6], ke[7])};
                *(LAS u32x4*)(QE + i * 272 + g8 * 16) = wq; *(LAS u32x4*)(KE + i * 272 + g8 * 16) = wk;
#pragma unroll
                for (int j = 0; j < 8; ++j) *(LAS bf16*)(KLT + (g8 * 8 + j) * 144 + i * 2) = f2bf(kl[j]);
            }
#pragma unroll
            for (int q = 0; q < 4; ++q) { *(LAS bf16*)(VT + (vg * 8 + 2 * q) * 144 + iv * 2) = f2bf(lo_act(rv[q])); *(LAS bf16*)(VT + (vg * 8 + 2 * q + 1) * 144 + iv * 2) = f2bf(hi_act(rv[q])); }
#pragma unroll
            for (int n = 0; n < 4; ++n) { u32x2 ws2 = {cvt_pk_bf16(S[n][0], S[n][1]), cvt_pk_bf16(S[n][2], S[n][3])}; *(LAS u32x2*)(SB + (n * 16 + fr) * 272 + (16 * w + 4 * fq) * 2) = ws2; }
        }
        if (c + 1 < NC) GLA_LOAD(c + 1);
        __syncthreads();
        { const int ti = w >> 1;
#pragma unroll
          for (int jj = 0; jj < 2; ++jj) { const int tj = (w & 1) * 2 + jj; f32x4 a = {0.f, 0.f, 0.f, 0.f};
              if (tj <= ti) {
#pragma unroll
                  for (int ks = 0; ks < 4; ++ks) { const bf16x8 af = *(const LAS bf16x8*)(QE + (ti * 16 + fr) * 272 + (ks * 32 + fq * 8) * 2), bfr = *(const LAS bf16x8*)(KE + (tj * 16 + fr) * 272 + (ks * 32 + fq * 8) * 2);
                      a = mma16(af, bfr, a); } }
#pragma unroll
              for (int r = 0; r < 4; ++r) { const int i = ti * 16 + 4 * fq + r, j = tj * 16 + fr; *(LAS bf16*)(ATT + i * 144 + j * 2) = f2bf(j <= i ? a[r] : 0.f); } } }
        __syncthreads();
        { const int ti = w >> 1;
#pragma unroll
          for (int jj = 0; jj < 2; ++jj) { const int tn = (w & 1) * 2 + jj; f32x4 a = {0.f, 0.f, 0.f, 0.f};
#pragma unroll
              for (int ks = 0; ks < 4; ++ks) { const bf16x8 af = *(const LAS bf16x8*)(QE + (ti * 16 + fr) * 272 + (ks * 32 + fq * 8) * 2), bfr = *(const LAS bf16x8*)(SB + (tn * 16 + fr) * 272 + (ks * 32 + fq * 8) * 2);
                  a = mma16(af, bfr, a); }
#pragma unroll
              for (int ks = 0; ks < 2; ++ks) { const bf16x8 af = *(const LAS bf16x8*)(ATT + (ti * 16 + fr) * 144 + (ks * 32 + fq * 8) * 2), bfr = *(const LAS bf16x8*)(VT + (tn * 16 + fr) * 144 + (ks * 32 + fq * 8) * 2);
                  a = mma16(af, bfr, a); }
#pragma unroll
              for (int r = 0; r < 4; ++r) { const int i = ti * 16 + 4 * fq + r; OUT[GLA_ROW(c, i) * 1024 + h * 256 + dvq * 64 + tn * 16 + fr] = a[r]; } } }
        { const f32x4 eb = *(const LAS f32x4*)(EB + 16 * w + 4 * fq);
#pragma unroll
          for (int n = 0; n < 4; ++n) { S[n] = S[n] * eb;
#pragma unroll
              for (int ks = 0; ks < 2; ++ks) { const bf16x8 af = *(const LAS bf16x8*)(KLT + (16 * w + fr) * 144 + (ks * 32 + fq * 8) * 2), bfr = *(const LAS bf16x8*)(VT + (n * 16 + fr) * 144 + (ks * 32 + fq * 8) * 2);
                  S[n] = mma16(af, bfr, S[n]); } } }
    }
    if (st_out) {
        int fr2 = fr; asm volatile("" : "+v"(fr2));
        const int soff2 = (16 * w + 4 * fq) * 256 + dvq * 64 + fr2;
#pragma unroll
        for (int n = 0; n < 4; ++n)
#pragma unroll
            for (int r = 0; r < 4; ++r) {
#ifdef MK_PROBE_SSCALE
                st_out[soff2 + r * 256 + n * 16] = S[n][r] * MK_PROBE_SSCALE;
#else
                st_out[soff2 + r * 256 + n * 16] = S[n][r];
#endif
            }
    }
    __syncthreads();
#undef GLA_ROW
#undef GLA_LOAD
}
}

#define XB_TMO      128
#define XB_XCNT(j)  (256  + 64 * (j))
#define XB_XSUB(j)  (1280 + 64 * (j))
#define XB_XGEN(j)  (2304 + 64 * (j))
#define XB_TOP      3328
#define XB_TOPGEN   3392
#define XCD_BAR_WORDS 3456
#define XB_SPIN_CAP (1u << 18)
__device__ __forceinline__ unsigned xb_ld(unsigned* p)              { return __hip_atomic_load(p, __ATOMIC_RELAXED, __HIP_MEMORY_SCOPE_AGENT); }
__device__ __forceinline__ unsigned xb_add(unsigned* p, unsigned v) { return __hip_atomic_fetch_add(p, v, __ATOMIC_RELAXED, __HIP_MEMORY_SCOPE_AGENT); }
__device__ __forceinline__ unsigned xb_xcc_id() { return (unsigned)__builtin_amdgcn_s_getreg((3 << 11) | 20) & 0xFu; }
#define XB_SPIN(cond, bar) do { unsigned _sp = 0; while (cond) { __builtin_amdgcn_s_sleep(1); \
    if ((++_sp & 255u) == 0u) { if (xb_ld(&(bar)[XB_TMO])) break; if (_sp > XB_SPIN_CAP) { atomicAdd(&(bar)[XB_TMO], 1u); break; } } } } while (0)
struct XcdBarrier { unsigned* bar; unsigned x; volatile LAS unsigned* st; };
__device__ __forceinline__ XcdBarrier xcd_barrier_post(unsigned* bar, volatile LAS unsigned* st) {
    XcdBarrier b; b.bar = bar; b.x = xb_xcc_id(); b.st = st;
    if (threadIdx.x == 0) (void)xb_add(&bar[XB_XCNT(b.x)], 1u);
    return b;
}
__device__ __forceinline__ void xcd_barrier_complete(unsigned* bar, unsigned x, unsigned& nloc, unsigned& nx) {
    const unsigned G = gridDim.x * gridDim.y * gridDim.z;
    unsigned sum, cnt, mine, sp = 0u;
    for (;;) {
        sum = 0u; cnt = 0u; mine = 0u;
#pragma unroll
        for (unsigned j = 0; j < 16; ++j) { const unsigned c = xb_ld(&bar[XB_XCNT(j)]); sum += c; cnt += (c > 0u) ? 1u : 0u; mine = (j == x) ? c : mine; }
        if (sum == G) break;
        __builtin_amdgcn_s_sleep(1);
        if ((++sp & 255u) == 0u) { if (xb_ld(&bar[XB_TMO])) break; if (sp > XB_SPIN_CAP) { atomicAdd(&bar[XB_TMO], 1u); break; } }
    }
    nloc = mine > 0u ? mine : 1u; nx = cnt > 0u ? cnt : 1u;
}
__device__ __forceinline__ void xcd_barrier(const XcdBarrier& b) {
    asm volatile("s_waitcnt vmcnt(0)" ::: "memory");
    __syncthreads();
    if (threadIdx.x == 0) {
        unsigned* bar = b.bar;
        __builtin_amdgcn_s_waitcnt(0);
        unsigned nloc = b.st[0], nx = b.st[1];
        if (nloc == 0u) { xcd_barrier_complete(bar, b.x, nloc, nx); b.st[0] = nloc; b.st[1] = nx; }
        const unsigned old = xb_add(&bar[XB_XSUB(b.x)], 1u);
        const unsigned gen = old / nloc;
        if (old + 1u == (gen + 1u) * nloc) {
            __builtin_amdgcn_fence(__ATOMIC_RELEASE, "agent");
            asm volatile("s_waitcnt vmcnt(0)" ::: "memory");
            const unsigned og = xb_add(&bar[XB_TOP], 1u);
            const unsigned tg = og / nx;
            if (og + 1u == (tg + 1u) * nx) xb_add(&bar[XB_TOPGEN], 1u);
            else XB_SPIN(xb_ld(&bar[XB_TOPGEN]) == tg, bar);
            __builtin_amdgcn_fence(__ATOMIC_ACQUIRE, "agent");
            xb_add(&bar[XB_XGEN(b.x)], 1u);
            asm volatile("s_waitcnt vmcnt(0)" ::: "memory");
        } else {
            XB_SPIN(xb_ld(&bar[XB_XGEN(b.x)]) == gen, bar);
            __builtin_amdgcn_fence(__ATOMIC_ACQUIRE, "agent");
            asm volatile("s_waitcnt vmcnt(0)" ::: "memory");
        }
    }
    __syncthreads();
}

struct Args {
    const float *x_prompt, *x_sample, *cache_k, *cache_v, *state_f, *state_b, *cvec, *c_ctx, *w_ada, *b_ada, *norm1, *w_in, *q_norm, *k_norm, *w_fourier, *w_attn,
                *w_gate_f, *b_gate_f, *w_gate_b, *b_gate_b, *gla_norm, *w_gla, *w_out, *norm2, *w_up, *conv_w, *conv_b, *w_down, *final_norm;
    float* out; unsigned char* ws;
    int s_lo, s_hi, li, pad;
};
constexpr size_t OUT_YP = 0, OUT_YS = (size_t)NCTX * DM, OUT_CK = (size_t)NTOK * DM, OUT_CV = OUT_CK + (size_t)BCTX * DEPTH * TC * 256,
                 OUT_SF = OUT_CV + (size_t)BCTX * DEPTH * TC * 256, OUT_SB = OUT_SF + (size_t)BCTX * DEPTH * 4 * 128 * 256, OUT_END = OUT_SB + (size_t)BCTX * DEPTH * 4 * 128 * 256;

struct Frame { LAS unsigned char* lds; int tid, lane, wave, G, bid; };
__device__ __forceinline__ Frame frame_now(LAS unsigned char* lds) {
    Frame F; F.lds = lds; F.tid = opaque_tid(); F.lane = F.tid & 63; F.wave = __builtin_amdgcn_readfirstlane(F.tid >> 6); F.G = gridDim.x; F.bid = blockIdx.x; return F; }

__device__ __forceinline__ void transpose_item(const float* __restrict__ W, int N, bf16* __restrict__ WT, int ldd, int koff, int kb, int nb, int row_shift_from, int row_shift, LAS unsigned char* scr, int lane) {
    const int k0 = kb * 128, n0 = nb * 32, c4 = lane & 7, kr = lane >> 3;
#pragma unroll 4
    for (int i = 0; i < 16; ++i) { const int k = 8 * i + kr; const f32x4 v = *(const f32x4*)(W + (size_t)(k0 + k) * N + n0 + 4 * c4);
#pragma unroll
        for (int j = 0; j < 4; ++j) *(LAS bf16*)(scr + (4 * c4 + j) * 272 + k * 2) = f2act(v[j]); }
    LDS_WAIT(); asm volatile("" ::: "memory");
    const int kc = lane & 15;
#pragma unroll
    for (int j = 0; j < 8; ++j) { const int n = (lane >> 4) + 4 * j; const u32x4 o = *(const LAS u32x4*)(scr + n * 272 + kc * 16);
        int row = n0 + n; if (row >= row_shift_from) row += row_shift;
        *(u32x4*)(WT + (size_t)row * ldd + koff + k0 + kc * 8) = o; }
    LDS_WAIT(); asm volatile("" ::: "memory");
}
constexpr int TI_IN = 16 * 369, TI_F = 8 * 64, TI_AT = 8 * 64, TI_GL = 8 * 64, TI_OUT = 16 * 64, TI_UP = 16 * 352, TI_DN = 44 * 64;
constexpr int TI_LAYER = TI_IN + TI_F + TI_AT + TI_GL + TI_OUT + TI_UP + TI_DN;

__device__ __forceinline__ void phase_prologue_a(LAS unsigned char* lds_, const Args& a) {
    const Frame F = frame_now(lds_);
    unsigned char* ws = a.ws;
    {
        LAS unsigned char* scr = F.lds + F.wave * 8704;
        const int gw = F.bid * NWAVES + F.wave, NGW = F.G * NWAVES;
        for (int it = gw; it < DEPTH * TI_LAYER; it += NGW) {
            const int l = it / TI_LAYER; int r = it - l * TI_LAYER;
            if (r < TI_IN) { transpose_item(a.w_in + (size_t)l * DM * N_IN, N_IN, (bf16*)(ws + WS_WIN + l * SZ_WIN), DM, 0, r / 369, r % 369, ZPAD, ZGATE - ZPAD, scr, F.lane); continue; } r -= TI_IN;
            if (r < TI_F) { transpose_item(a.w_fourier + (size_t)l * 1024 * DM, DM, (bf16*)(ws + WS_WFT + l * SZ_WFT), 1024, 0, r / 64, r % 64, 1 << 30, 0, scr, F.lane); continue; } r -= TI_F;
            if (r < TI_AT) { transpose_item(a.w_attn + (size_t)l * 1024 * DM, DM, (bf16*)(ws + WS_WMRG + l * SZ_WMRG), KMRG, 2048, r / 64, r % 64, 1 << 30, 0, scr, F.lane); continue; } r -= TI_AT;
            if (r < TI_GL) { transpose_item(a.w_gla + (size_t)l * 1024 * DM, DM, (bf16*)(ws + WS_WMRG + l * SZ_WMRG), KMRG, 3072, r / 64, r % 64, 1 << 30, 0, scr, F.lane); continue; } r -= TI_GL;
            if (r < TI_OUT) { transpose_item(a.w_out + (size_t)l * DM * DM, DM, (bf16*)(ws + WS_WOUT + l * SZ_WOUT), DM, 0, r / 64, r % 64, 1 << 30, 0, scr, F.lane); continue; } r -= TI_OUT;
            if (r < TI_UP) { transpose_item(a.w_up + (size_t)l * DM * NUP, NUP, (bf16*)(ws + WS_WUP + l * SZ_WUP), DM, 0, r / 352, r % 352, 1 << 30, 0, scr, F.lane); continue; } r -= TI_UP;
            transpose_item(a.w_down + (size_t)l * DFF * DM, DM, (bf16*)(ws + WS_WDN + l * SZ_WDN), DFF, 0, r / 64, r % 64, 1 << 30, 0, scr, F.lane);
        }
    }
    const size_t gt = (size_t)F.bid * 512 + F.tid, NGT = (size_t)F.G * 512;
    for (size_t i = gt; i < (size_t)DEPTH * (ZGATE - ZPAD) * DM / 8; i += NGT) { const size_t l = i / ((ZGATE - ZPAD) * DM / 8), r = i % ((ZGATE - ZPAD) * DM / 8);
        *(u32x4*)(ws + WS_WIN + l * SZ_WIN + (size_t)ZPAD * DM * 2 + r * 16) = (u32x4){0u, 0u, 0u, 0u}; }
    for (size_t i = gt; i < (size_t)2048 * 1024; i += NGT) {
        const int kp = (int)(i >> 10), j = (int)(i & 1023), cs = kp >> 10, g = (kp >> 7) & 7, c = kp & 127, g2 = j >> 7, jj = j & 127; float v = 0.f;
        if (g == g2) { const int m = (c * jj) & 127; const float ang = (float)m * (1.f / 128.f); v = (cs ? -sinpif(2.f * ang) : cospif(2.f * ang)) * 0.088388347648318440f; }
        ((bf16*)(ws + WS_DT))[i] = f2act(v); }
    for (size_t i = gt; i < (size_t)512 * 256; i += NGT) { const int kp = (int)(i >> 8), t = (int)(i & 255), cs = kp >> 8, k = kp & 255, m = (k * t) & 255; const float ang = (float)m * (1.f / 256.f);
        ((bf16*)(ws + WS_ACTX))[i] = f2act((cs ? sinpif(2.f * ang) : cospif(2.f * ang)) * 0.0625f); }
    for (size_t i = gt; i < (size_t)2048 * 1024; i += NGT) { const int kp = (int)(i >> 10), t = (int)(i & 1023), cs = kp >> 10, k = kp & 1023, m = (k * t) & 1023; const float ang = (float)m * (1.f / 1024.f);
        ((bf16*)(ws + WS_ALAT))[i] = f2act((cs ? sinpif(2.f * ang) : cospif(2.f * ang)) * 0.03125f); }
    __syncthreads();
    {
        LAS float* SC = (LAS float*)F.lds;
        for (int i = F.tid; i < NMODV * DM; i += 512) { const int j = i >> 11, k = i & 2047; const float cv = j == 0 ? a.c_ctx[k] : a.cvec[(j - 1) * DM + k]; SC[i] = siluf_(cv); }
        __syncthreads();
        float* MP = (float*)(ws + WS_MODP);
        for (int u = F.bid; u < DEPTH * 16 * 6; u += F.G) {
            const int l = u / 96, kc = (u % 96) / 6, nb = u % 6, n = nb * 2048 + F.tid * 4;
            f32x4 acc[NMODV];
#pragma unroll
            for (int j = 0; j < NMODV; ++j) acc[j] = (f32x4){0.f, 0.f, 0.f, 0.f};
            const float* wp = a.w_ada + ((size_t)l * DM + kc * 128) * NMOD + n;
#pragma unroll 8
            for (int k = 0; k < 128; ++k) { const f32x4 wv = *(const f32x4*)(wp + (size_t)k * NMOD);
#pragma unroll
                for (int j = 0; j < NMODV; ++j) acc[j] = acc[j] + wv * SC[j * DM + kc * 128 + k]; }
#pragma unroll
            for (int j = 0; j < NMODV; ++j) *(f32x4*)(MP + (((size_t)kc * DEPTH + l) * NMODV + j) * NMOD + n) = acc[j];
        }
        __syncthreads();
    }
}
__device__ __forceinline__ void phase_mod_reduce(LAS unsigned char* lds_, const Args& a) {
    const Frame F = frame_now(lds_);
    const float* MP = (const float*)(a.ws + WS_MODP); float* MOD = (float*)(a.ws + WS_MOD);
    for (size_t i = (size_t)F.bid * 512 + F.tid; i < (size_t)DEPTH * NMODV * NMOD / 4; i += (size_t)F.G * 512) {
        const size_t e = i * 4; const int n = (int)(e % NMOD), l = (int)(e / ((size_t)NMODV * NMOD));
        f32x4 s = *(const f32x4*)(a.b_ada + (size_t)l * NMOD + n);
#pragma unroll
        for (int kc = 0; kc < 16; ++kc) s = s + *(const f32x4*)(MP + (size_t)kc * DEPTH * NMODV * NMOD + e);
        *(f32x4*)(MOD + e) = s; }
}

__device__ __forceinline__ void phase_norm(LAS unsigned char* lds_, const Args& a, int l, int which, bool first) {
    const Frame F = frame_now(lds_);
    const float* MOD = (const float*)(a.ws + WS_MOD) + (size_t)l * NMODV * NMOD + (which ? 3 * DM : 0);
    const float* wn = (which ? a.norm2 : a.norm1) + (size_t)l * DM;
    float* X = (float*)(a.ws + WS_X); bf16* H = (bf16*)(a.ws + WS_H);
    const int gw = F.bid * NWAVES + F.wave, NGW = F.G * NWAVES;
    for (int r = gw; r < NTOK; r += NGW) {
        const float* src = first ? (r < NCTX ? a.x_prompt + (size_t)r * DM : a.x_sample + (size_t)(r - NCTX) * DM) : X + (size_t)r * DM;
        f32x4 v[8]; float ss = 0.f;
#pragma unroll
        for (int j = 0; j < 8; ++j) { v[j] = *(const f32x4*)(src + 4 * F.lane + 256 * j); ss += (v[j][0] * v[j][0] + v[j][1] * v[j][1]) + (v[j][2] * v[j][2] + v[j][3] * v[j][3]); }
        if (first) {
#pragma unroll
            for (int j = 0; j < 8; ++j) *(f32x4*)(X + (size_t)r * DM + 4 * F.lane + 256 * j) = v[j]; }
        const float rstd = rsqrtf(wave_sum(ss) * (1.f / DM) + EPS);
        const float* mr = MOD + (size_t)mod_row(r) * NMOD;
#pragma unroll
        for (int j = 0; j < 8; ++j) { const int c = 4 * F.lane + 256 * j; const f32x4 w4 = *(const f32x4*)(wn + c), sh = *(const f32x4*)(mr + c), sc = *(const f32x4*)(mr + DM + c);
            const f32x4 hval = v[j] * rstd * w4 * (sc + 1.f) + sh;
            u32x2 o = {pk_act(hval[0], hval[1]), pk_act(hval[2], hval[3])}; *(u32x2*)(H + (size_t)r * DM + c) = o; }
    }
}
__device__ __forceinline__ void phase_final_norm(LAS unsigned char* lds_, const Args& a) {
    const Frame F = frame_now(lds_);
    const float* X = (const float*)(a.ws + WS_X);
    const int gw = F.bid * NWAVES + F.wave, NGW = F.G * NWAVES;
    for (int r = gw; r < NTOK; r += NGW) {
        f32x4 v[8]; float ss = 0.f;
#pragma unroll
        for (int j = 0; j < 8; ++j) { v[j] = *(const f32x4*)(X + (size_t)r * DM + 4 * F.lane + 256 * j); ss += (v[j][0] * v[j][0] + v[j][1] * v[j][1]) + (v[j][2] * v[j][2] + v[j][3] * v[j][3]); }
        const float rstd = rsqrtf(wave_sum(ss) * (1.f / DM) + EPS);
#pragma unroll
        for (int j = 0; j < 8; ++j) { const int c = 4 * F.lane + 256 * j; f32x4 yv = v[j] * rstd * *(const f32x4*)(a.final_norm + c);
#ifdef MK_PROBE_NOISE
            { const unsigned hsh = ((unsigned)r * 2654435761u) ^ ((unsigned)c * 40503u); const float dn = 0.03f;
              yv[0] += (hsh & 1u) ? dn : -dn; yv[1] += (hsh & 2u) ? dn : -dn; yv[2] += (hsh & 4u) ? dn : -dn; yv[3] += (hsh & 8u) ? dn : -dn; }
#endif
            *(f32x4*)(a.out + OUT_YP + (size_t)r * DM + c) = yv; }
    }
}

__device__ __forceinline__ void phase_prep(LAS unsigned char* lds_, const Args& a, int l) {
    const Frame F = frame_now(lds_);
    const bf16* Z = (const bf16*)(a.ws + WS_Z);
    bf16* KC = (bf16*)(a.ws + WS_KC); bf16* VC = (bf16*)(a.ws + WS_VC); bf16* KL = (bf16*)(a.ws + WS_KL); bf16* VL = (bf16*)(a.ws + WS_VL);
    const int gw = F.bid * NWAVES + F.wave, NGW = F.G * NWAVES, lane = F.lane;
    LAS bf16* tile = (LAS bf16*)(F.lds + F.wave * 8448);
    for (int it = gw; it < NTOK + 1024 + 2048; it += NGW) {
        if (it < NTOK) {
            const int r = it, hh = lane >> 5, i = lane & 31; const bf16* zr = Z + (size_t)r * NZ;
            float kx[4]; float ss = 0.f;
#pragma unroll
            for (int q = 0; q < 4; ++q) { kx[q] = act2f(zr[ZK + hh * 128 + i + 32 * q]); ss += kx[q] * kx[q]; }
            ss = half_sum(ss);
            const float rstd = rsqrtf(ss * (1.f / 128.f) + EPS);
#pragma unroll
            for (int q = 0; q < 4; ++q) kx[q] *= rstd * a.k_norm[l * 128 + i + 32 * q];
            const u32x2 vv = *(const u32x2*)(zr + ZV + 4 * lane);
            {
                bf16* qo = (bf16*)(a.ws + WS_QN) + (size_t)r * 1024;
                const bool lat = r >= NCTX; const int tq = (r - NCTX) & 1023; const float prow = (float)(tq >> 6), pcol = (float)(tq & 63);
                const float inv = exp2f(-(float)i * 0.41524101186092029f);
                float sr = 0.f, cr = 1.f, sc2 = 0.f, cc2 = 1.f;
                if (lat) { sr = __sinf(prow * inv); cr = __cosf(prow * inv); sc2 = __sinf(pcol * inv); cc2 = __cosf(pcol * inv); }
                float qg[4];
#pragma unroll
                for (int q = 0; q < 4; ++q) qg[q] = a.q_norm[l * 128 + i + 32 * q];
#pragma unroll
                for (int hp = 0; hp < 4; ++hp) { const int hd = 2 * hp + hh; float qx[4]; float s2 = 0.f;
#pragma unroll
                    for (int q = 0; q < 4; ++q) { qx[q] = act2f(zr[ZQ + hd * 128 + i + 32 * q]); s2 += qx[q] * qx[q]; }
                    s2 = half_sum(s2);
                    const float rs = rsqrtf(s2 * (1.f / 128.f) + EPS);
#pragma unroll
                    for (int q = 0; q < 4; ++q) qx[q] *= rs * qg[q];
                    const float y0 = qx[0] * cr - qx[1] * sr, y1 = qx[1] * cr + qx[0] * sr, y2 = qx[2] * cc2 - qx[3] * sc2, y3 = qx[3] * cc2 + qx[2] * sc2;
                    qo[hd * 128 + i] = f2act(y0); qo[hd * 128 + i + 32] = f2act(y1); qo[hd * 128 + i + 64] = f2act(y2); qo[hd * 128 + i + 96] = f2act(y3); }
            }
            if (r < NCTX) {
                const int b = r >> 8, t = r & 255; const size_t oo = ((size_t)(b * DEPTH + l) * TC + t) * 256;
#pragma unroll
                for (int q = 0; q < 4; ++q) { KC[(size_t)r * 256 + hh * 128 + i + 32 * q] = f2act(kx[q]); a.out[OUT_CK + oo + hh * 128 + i + 32 * q] = kx[q]; }
                *(u32x2*)(VC + (size_t)r * 256 + 4 * lane) = vv;
                *(f32x4*)(a.out + OUT_CV + oo + 4 * lane) = (f32x4){lo_act(vv[0]), hi_act(vv[0]), lo_act(vv[1]), hi_act(vv[1])};
            } else {
                const int rr = r - NCTX, b = rr >> 10, t = rr & 1023; const float prow = (float)(t >> 6), pcol = (float)(t & 63);
                const float inv = exp2f(-(float)i * 0.41524101186092029f);
                { const float s = __sinf(prow * inv), c = __cosf(prow * inv), x1 = kx[0], x2 = kx[1]; kx[0] = x1 * c - x2 * s; kx[1] = x2 * c + x1 * s; }
                { const float s = __sinf(pcol * inv), c = __cosf(pcol * inv), x1 = kx[2], x2 = kx[3]; kx[2] = x1 * c - x2 * s; kx[3] = x2 * c + x1 * s; }
                const size_t ko = ((size_t)b * 1280 + 256 + t) * 256;
#pragma unroll
                for (int q = 0; q < 4; ++q) KL[ko + hh * 128 + i + 32 * q] = f2act(kx[q]);
                *(u32x2*)(VL + ko + 4 * lane) = vv;
            }
        } else if (it < NTOK + 1024) {
            const int rr = it - NTOK, b = rr >> 8, s = rr & 255; const size_t so = ((size_t)(b * DEPTH + l) * PAST + s) * 256 + 4 * lane, dst_o = ((size_t)b * 1280 + s) * 256 + 4 * lane;
            const f32x4 kk = *(const f32x4*)(a.cache_k + so), vv = *(const f32x4*)(a.cache_v + so);
            u32x2 ko = {pk_act(kk[0], kk[1]), pk_act(kk[2], kk[3])}, vo = {pk_act(vv[0], vv[1]), pk_act(vv[2], vv[3])};
            *(u32x2*)(KL + dst_o) = ko; *(u32x2*)(VL + dst_o) = vo;
        } else {
            const int ti = it - NTOK - 1024, tb = ti >> 4, cb = ti & 15, r0 = tb * 64, c0 = cb * 64;
#pragma unroll
            for (int j = 0; j < 8; ++j) { const int row = (lane >> 3) + 8 * j, cc = (lane & 7) * 8; const u32x4 w = *(const u32x4*)(Z + (size_t)(r0 + row) * NZ + ZF + c0 + cc);
#pragma unroll
                for (int q = 0; q < 4; ++q) *(LAS unsigned*)(tile + row * 66 + cc + 2 * q) = w[q]; }
            LDS_WAIT(); asm volatile("" ::: "memory");
            bf16* XT; int T, b, t0;
            if (r0 < NCTX) { XT = (bf16*)(a.ws + WS_XT); T = TC; b = r0 >> 8; t0 = r0 & 255; } else { XT = (bf16*)(a.ws + WS_XT) + (size_t)16384 * 256; T = TL; b = (r0 - NCTX) >> 10; t0 = (r0 - NCTX) & 1023; }
#pragma unroll
            for (int j = 0; j < 8; ++j) { const int ch = (lane >> 3) + 8 * j, tt = (lane & 7) * 8; unsigned o[4];
#pragma unroll
                for (int q = 0; q < 4; ++q) o[q] = (unsigned)tile[(tt + 2 * q) * 66 + ch] | ((unsigned)tile[(tt + 2 * q + 1) * 66 + ch] << 16);
                *(u32x4*)(XT + ((size_t)b * 1024 + c0 + ch) * T + t0 + tt) = (u32x4){o[0], o[1], o[2], o[3]}; }
            LDS_WAIT(); asm volatile("" ::: "memory");
        }
    }
}

__device__ __forceinline__ void phase_attn(LAS unsigned char* lds_, const Args& a, int l) {
    const Frame F = frame_now(lds_);
    bf16* AM = (bf16*)(a.ws + WS_AM);
    for (int u = F.bid; u < 256; u += F.G) {
        const bool lat = u < 128; const int uu = lat ? u : u - 128;
        const int b = lat ? (uu >> 5) : (uu >> 3), h = lat ? ((uu >> 2) & 7) : (uu & 7), qb = lat ? (uu & 3) : 0;
        const size_t row0 = lat ? (size_t)NCTX + b * 1024 + qb * 256 : (size_t)b * 256;
        const size_t kvo = (lat ? (size_t)b * 1280 * 256 : (size_t)b * 256 * 256) + (h >> 2) * 128;
        const bf16* Kp = (const bf16*)(a.ws + (lat ? WS_KL : WS_KC)) + kvo; const bf16* Vp = (const bf16*)(a.ws + (lat ? WS_VL : WS_VC)) + kvo;
        att::attn_dense_body((const bf16*)(a.ws + WS_QN) + row0 * 1024 + h * 128, Kp, Vp, AM + row0 * KMRG + 2048 + h * 128, lat ? 1280 : 256, (LAS char*)F.lds);
    }
}

__device__ __forceinline__ void phase_gla(LAS unsigned char* lds_, const Args& a, int l) {
    const Frame F = frame_now(lds_);
    const bf16* Z = (const bf16*)(a.ws + WS_Z);
    for (int slot = F.bid; slot < 256; slot += F.G) {
        const int nit = slot < 128 ? 1 : 4;
        for (int k = 0; k < nit; ++k) {
            int path, b, h, dir, dvq;
            if (slot < 128) { path = 1; b = slot >> 5; h = (slot >> 3) & 3; dir = (slot >> 2) & 1; dvq = slot & 3; }
            else { const int it = (slot - 128) * 4 + k; path = 0; b = it >> 5; h = (it >> 3) & 3; dir = (it >> 2) & 1; dvq = it & 3; }
            const float* wg = (dir ? a.w_gate_b : a.w_gate_f) + (size_t)l * 16 * 512 + h * 128;
            const float* bg = (dir ? a.b_gate_b : a.b_gate_f) + (size_t)l * 512 + h * 128;
            float* OUT = (float*)(a.ws + (dir ? WS_OB : WS_OF));
            const size_t so = ((size_t)(b * DEPTH + l) * 4 + h) * 128 * 256;
            const float* st_in = path ? (dir ? a.state_b : a.state_f) + so : nullptr;
            float* st_out = path ? nullptr : a.out + (dir ? OUT_SB : OUT_SF) + so;
            gla::gla_item(F.lds, Z, OUT, wg, bg, st_in, st_out, path ? TL : TC, path ? NCTX + b * 1024 : b * 256, h, dir, dvq);
        }
    }
}
__device__ __forceinline__ void phase_gla_fin(LAS unsigned char* lds_, const Args& a, int l) {
    const Frame F = frame_now(lds_);
    const bf16* Z = (const bf16*)(a.ws + WS_Z); bf16* AM = (bf16*)(a.ws + WS_AM);
    const float* OF = (const float*)(a.ws + WS_OF); const float* OB = (const float*)(a.ws + WS_OB);
    const int gw = F.bid * NWAVES + F.wave, NGW = F.G * NWAVES;
    const f32x4 gn = *(const f32x4*)(a.gla_norm + l * 256 + 4 * F.lane);
    for (int it = gw; it < NTOK * 4; it += NGW) { const int r = it >> 2, h = it & 3; const size_t o = (size_t)r * 1024 + h * 256 + 4 * F.lane;
        const f32x4 v = *(const f32x4*)(OF + o) + *(const f32x4*)(OB + o);
        const float ss = wave_sum((v[0] * v[0] + v[1] * v[1]) + (v[2] * v[2] + v[3] * v[3]));
        const float rstd = rsqrtf(ss * (1.f / 256.f) + EPS);
        const u32x2 g = *(const u32x2*)(Z + (size_t)r * NZ + ZGR + h * 256 + 4 * F.lane);
        const f32x4 y = v * rstd * gn;
        u32x2 w = {pk_act(y[0] * siluf_(lo_act(g[0])), y[1] * siluf_(hi_act(g[0]))), pk_act(y[2] * siluf_(lo_act(g[1])), y[3] * siluf_(hi_act(g[1])))};
        *(u32x2*)(AM + (size_t)r * KMRG + 3072 + h * 256 + 4 * F.lane) = w; }
}
__device__ __forceinline__ void phase_conv(LAS unsigned char* lds_, const Args& a, int l) {
    const Frame F = frame_now(lds_);
    const bf16* U = (const bf16*)(a.ws + WS_Z); bf16* ACT = (bf16*)(a.ws + WS_ACT);
    const float* cw = a.conv_w + (size_t)l * 3 * NUP; const float* cb = a.conv_b + (size_t)l * NUP;
    constexpr int NCG = DFF / 8, STRIP = 32, NS = NTOK / STRIP;
    for (int it = F.bid * 512 + F.tid; it < NCG * NS; it += F.G * 512) {
        const int cg = it % NCG, st = it / NCG, c = cg * 8, r0 = st * STRIP; const int T = r0 < NCTX ? TC : TL;
        float wg[3][8], wv[3][8], bgv[8], bvv[8];
#pragma unroll
        for (int k = 0; k < 3; ++k) { const f32x4 a0 = *(const f32x4*)(cw + k * NUP + c), a1 = *(const f32x4*)(cw + k * NUP + c + 4), b0 = *(const f32x4*)(cw + k * NUP + DFF + c), b1 = *(const f32x4*)(cw + k * NUP + DFF + c + 4);
#pragma unroll
            for (int j = 0; j < 4; ++j) { wg[k][j] = a0[j]; wg[k][4 + j] = a1[j]; wv[k][j] = b0[j]; wv[k][4 + j] = b1[j]; } }
        { const f32x4 a0 = *(const f32x4*)(cb + c), a1 = *(const f32x4*)(cb + c + 4), b0 = *(const f32x4*)(cb + DFF + c), b1 = *(const f32x4*)(cb + DFF + c + 4);
#pragma unroll
          for (int j = 0; j < 4; ++j) { bgv[j] = a0[j]; bgv[4 + j] = a1[j]; bvv[j] = b0[j]; bvv[4 + j] = b1[j]; } }
        const u32x4 zero = {0u, 0u, 0u, 0u};
        u32x4 gp = zero, vp = zero, gc, vc;
        if ((r0 & (T - 1)) != 0) { gp = *(const u32x4*)(U + (size_t)(r0 - 1) * NUP + c); vp = *(const u32x4*)(U + (size_t)(r0 - 1) * NUP + DFF + c); }
        gc = *(const u32x4*)(U + (size_t)r0 * NUP + c); vc = *(const u32x4*)(U + (size_t)r0 * NUP + DFF + c);
        for (int i = 0; i < STRIP; i += 4) {
            u32x4 gnx[4], vnx[4];
#pragma unroll
            for (int e = 0; e < 4; ++e) { const int rn = r0 + i + e + 1;
                if ((rn & (T - 1)) != 0) { gnx[e] = *(const u32x4*)(U + (size_t)rn * NUP + c); vnx[e] = *(const u32x4*)(U + (size_t)rn * NUP + DFF + c); } else { gnx[e] = zero; vnx[e] = zero; } }
#pragma unroll
            for (int e = 0; e < 4; ++e) { const int r = r0 + i + e; const u32x4 gn = gnx[e], vn = vnx[e];
                float o[8];
#pragma unroll
                for (int q = 0; q < 4; ++q) {
                    const float g0 = wg[0][2 * q] * lo_act(gp[q]) + wg[1][2 * q] * lo_act(gc[q]) + wg[2][2 * q] * lo_act(gn[q]) + bgv[2 * q];
                    const float g1 = wg[0][2 * q + 1] * hi_act(gp[q]) + wg[1][2 * q + 1] * hi_act(gc[q]) + wg[2][2 * q + 1] * hi_act(gn[q]) + bgv[2 * q + 1];
                    const float v0 = wv[0][2 * q] * lo_act(vp[q]) + wv[1][2 * q] * lo_act(vc[q]) + wv[2][2 * q] * lo_act(vn[q]) + bvv[2 * q];
                    const float v1 = wv[0][2 * q + 1] * hi_act(vp[q]) + wv[1][2 * q + 1] * hi_act(vc[q]) + wv[2][2 * q + 1] * hi_act(vn[q]) + bvv[2 * q + 1];
                    o[2 * q] = siluf_(g0) * v0; o[2 * q + 1] = siluf_(g1) * v1; }
                *(u32x4*)(ACT + (size_t)r * DFF + c) = (u32x4){pk_act(o[0], o[1]), pk_act(o[2], o[3]), pk_act(o[4], o[5]), pk_act(o[6], o[7])};
                gp = gc; vp = vc; gc = gn; vc = vn; }
        }
    }
}

#ifdef MK_PROBE
constexpr size_t WS_DIAG = WS_END;
__device__ __forceinline__ void diag_max(float* slot, float v) { atomicMax((unsigned*)slot, __builtin_bit_cast(unsigned, fabsf(v))); }
__global__ void k_probe_zero(float* diag) { if (threadIdx.x < 4) diag[threadIdx.x] = 0.f; }
__global__ void k_probe_fill(float* out, const float* diag) {
    for (size_t i = (size_t)blockIdx.x * blockDim.x + threadIdx.x; i < OUT_END; i += (size_t)gridDim.x * blockDim.x) out[i] = 0.f;
    __syncthreads();
    if (blockIdx.x == 0 && threadIdx.x == 0) out[0] = 1e6f * diag[0] / fmaxf(diag[1], 1e-20f);
}
__global__ void k_probe_fill2(float* out, const float* diag) { if (blockIdx.x == 0 && threadIdx.x == 0) out[0] = 1e6f * diag[0] / fmaxf(diag[1], 1e-20f); }
__global__ void k_probe_z(Args a) {
    const bf16* H = (const bf16*)(a.ws + WS_H); const bf16* W = (const bf16*)(a.ws + WS_WIN); const bf16* Z = (const bf16*)(a.ws + WS_Z); float* diag = (float*)(a.ws + WS_DIAG);
    const unsigned id = blockIdx.x * blockDim.x + threadIdx.x; const unsigned hsh = id * 2654435761u + 12345u;
    const int r = (hsh >> 8) % NTOK, c = (hsh * 40503u >> 7) % NZ;
    float s = 0.f; for (int k = 0; k < DM; ++k) s += act2f(H[(size_t)r * DM + k]) * act2f(W[(size_t)c * DM + k]);
    const float z = act2f(Z[(size_t)r * NZ + c]); diag_max(diag, z - s); diag_max(diag + 1, s);
}
__global__ void k_probe_wt(Args a, int l) {
    const bf16* W = (const bf16*)(a.ws + WS_WIN + (size_t)l * SZ_WIN); float* diag = (float*)(a.ws + WS_DIAG);
    for (size_t i = (size_t)blockIdx.x * blockDim.x + threadIdx.x; i < (size_t)N_IN * DM; i += (size_t)gridDim.x * blockDim.x) {
        const int n = (int)(i / DM), k = (int)(i % DM); const int row = n >= ZPAD ? n + (ZGATE - ZPAD) : n;
        const float ref = act2f(f2act(a.w_in[((size_t)l * DM + k) * N_IN + n])); diag_max(diag, act2f(W[(size_t)row * DM + k]) - ref); diag_max(diag + 1, ref); }
}
__global__ void k_probe_gla(Args a) {
    __shared__ float red[4];
    const bf16* Z = (const bf16*)(a.ws + WS_Z); float* diag = (float*)(a.ws + WS_DIAG);
    const int l = 0, blk = blockIdx.x, b = blk & 15, h = (blk >> 4) & 3, dir = (blk >> 6) & 1, dv0 = ((blk >> 7) * 52 + 3) & 252;
    const int d = threadIdx.x & 127, dvi = threadIdx.x >> 7, dv = dv0 + dvi, T = TC, tokbase = b * TC;
    const float* wg = (dir ? a.w_gate_b : a.w_gate_f) + (size_t)l * 16 * 512 + h * 128; const float* bg = (dir ? a.b_gate_b : a.b_gate_f) + (size_t)l * 512 + h * 128;
    const float* OUT = (const float*)(a.ws + (dir ? WS_OB : WS_OF));
    float S = 0.f;
    for (int i = 0; i < T; ++i) { const int t = dir ? T - 1 - i : i; const bf16* zr = Z + (size_t)(tokbase + t) * NZ;
        float x = bg[d]; for (int r = 0; r < 16; ++r) x += act2f(zr[(dir ? ZGAB : ZGAF) + r]) * wg[r * 512 + d];
        const float la = (fminf(x, 0.f) - logf(1.f + expf(-fabsf(x)))) * 0.0625f;
        S = expf(la) * S + act2f(zr[ZGK + h * 128 + d]) * act2f(zr[ZGV + h * 256 + dv]);
        if (threadIdx.x < 4) red[threadIdx.x] = 0.f;
        __syncthreads();
        atomicAdd(&red[dvi], act2f(zr[ZGQ + h * 128 + d]) * 0.088388347648318440f * S);
        __syncthreads();
        if (d == 0) { const float o = OUT[(size_t)(tokbase + t) * 1024 + h * 256 + dv]; diag_max(diag, o - red[dvi]); diag_max(diag + 1, red[dvi]); }
        __syncthreads(); }
    const float sref = S, sgot = a.out[(dir ? OUT_SB : OUT_SF) + (((size_t)(b * DEPTH + l) * 4 + h) * 128 + d) * 256 + dv];
    diag_max(diag + 2, sgot - sref); diag_max(diag + 3, sref);
}

__global__ void k_probe_h(Args a) {
    const bf16* H = (const bf16*)(a.ws + WS_H); float* diag = (float*)(a.ws + WS_DIAG);
    const unsigned id = blockIdx.x * blockDim.x + threadIdx.x; const unsigned hsh = id * 2654435761u + 777u;
    const int r = (hsh >> 8) % NTOK, c = (hsh * 40503u >> 7) % DM, j = mod_row(r);
    const float* xr = r < NCTX ? a.x_prompt + (size_t)r * DM : a.x_sample + (size_t)(r - NCTX) * DM;
    float ss = 0.f, sh = a.b_ada[c], sc = a.b_ada[DM + c];
    for (int k = 0; k < DM; ++k) { ss += xr[k] * xr[k]; const float cv = j == 0 ? a.c_ctx[k] : a.cvec[(j - 1) * DM + k]; const float sl = cv / (1.f + expf(-cv));
        sh += sl * a.w_ada[(size_t)k * NMOD + c]; sc += sl * a.w_ada[(size_t)k * NMOD + DM + c]; }
    const float ref = xr[c] * (1.f / sqrtf(ss / DM + EPS)) * a.norm1[c] * (1.f + sc) + sh;
    diag_max(diag, act2f(H[(size_t)r * DM + c]) - ref); diag_max(diag + 1, ref);
}

__global__ void k_probe_mod(Args a, int l) {
    const float* MOD = (const float*)(a.ws + WS_MOD) + (size_t)l * NMODV * NMOD; float* diag = (float*)(a.ws + WS_DIAG);
    const unsigned id = blockIdx.x * blockDim.x + threadIdx.x; const int j = id % NMODV, n = (int)(((id / NMODV) * 2654435761u >> 8) % NMOD);
    float s = a.b_ada[(size_t)l * NMOD + n];
    for (int k = 0; k < DM; ++k) { const float cv = j == 0 ? a.c_ctx[k] : a.cvec[(j - 1) * DM + k]; s += cv / (1.f + expf(-cv)) * a.w_ada[((size_t)l * DM + k) * NMOD + n]; }
    diag_max(diag, MOD[(size_t)j * NMOD + n] - s); diag_max(diag + 1, s);
}
#endif

constexpr int STEPS_PER_LAYER = 13, STEP_L0 = 2, STEP_FINAL = STEP_L0 + DEPTH * STEPS_PER_LAYER, N_STEPS = STEP_FINAL + 1;
#ifndef MK_PH_MASK
#define MK_PH_MASK 0xFFFFFFFFu
#endif
#define EN(k) (((MK_PH_MASK) >> (k)) & 1u)
#ifndef MK_REP_MASK
#define MK_REP_MASK 0u
#endif
#define REP(k) (((MK_REP_MASK) >> (k)) & 1u)
#ifndef MK_SP2
#define MK_SP2 true
#endif
#ifndef MK_ALIGN
#define MK_ALIGN true
#endif
__global__ void __launch_bounds__(NWAVES * 64, 2) mk_fwd(Args a) {
    extern __shared__ __attribute__((aligned(16))) unsigned char lds_raw[];
    LAS unsigned char* const lds = (LAS unsigned char*)lds_raw;
    volatile LAS unsigned* MISC = (volatile LAS unsigned*)(lds + MISC_OFF);
    if (threadIdx.x < 64) MISC[threadIdx.x] = 0u;
    __syncthreads();
    unsigned* barw = (unsigned*)(a.ws + WS_CTL) + CW_BAR + a.li * XCD_BAR_WORDS;
    XcdBarrier bar = xcd_barrier_post(barw, MISC + 8);
    const int lo = a.s_lo, hi = a.s_hi;
#define IN(s) (lo <= (s) && (s) < hi)
#define SEAM(s) do { if (IN(s) && IN((s) + 1)) xcd_barrier(bar); else __syncthreads(); } while (0)
    unsigned char* ws = a.ws;
    const int G = gridDim.x, bid = blockIdx.x;

    if (EN(13) && IN(0)) { phase_prologue_a(lds, a); if (REP(13)) { xcd_barrier(bar); phase_prologue_a(lds, a); } SEAM(0); }
    if (EN(14) && IN(1)) {
        phase_mod_reduce(lds, a);
        pg8::Gemm g{(const bf16*)(ws + WS_WFT), (const bf16*)(ws + WS_DT), DEPTH * DM, 2048, 1024}; pg8::StaticOrder S; S.init(g.M, g.N, G, bid);
        pg8::EpiStoreBf16 E{(bf16*)(ws + WS_WMRG), KMRG};
        pg8::gemm_phase<pg8::EpiStoreBf16, pg8::StaticOrder, MK_ALIGN, MK_SP2>(lds, g, S, E);
        SEAM(1);
    }
    for (int l = 0; l < DEPTH; ++l) {
        const int sb = STEP_L0 + l * STEPS_PER_LAYER;
        if (hi <= sb || lo >= sb + STEPS_PER_LAYER) continue;
        const float* MODL = (const float*)(ws + WS_MOD) + (size_t)l * NMODV * NMOD;
        if (EN(0) && IN(sb + 0)) { phase_norm(lds, a, l, 0, l == 0); if (REP(0)) { xcd_barrier(bar); phase_norm(lds, a, l, 0, l == 0); } SEAM(sb + 0); }
        if (EN(1) && IN(sb + 1)) {
            pg8::Gemm g{(const bf16*)(ws + WS_H), (const bf16*)(ws + WS_WIN + l * SZ_WIN), NTOK, NZ, DM}; pg8::StaticOrder S; S.init(g.M, g.N, G, bid);
            pg8::EpiStoreBf16 E{(bf16*)(ws + WS_Z), NZ};
            pg8::gemm_phase<pg8::EpiStoreBf16, pg8::StaticOrder, MK_ALIGN, MK_SP2>(lds, g, S, E);
#ifdef MK_REP_Z
            xcd_barrier(bar); pg8::gemm_phase<pg8::EpiStoreBf16, pg8::StaticOrder, MK_ALIGN, MK_SP2>(lds, g, S, E);
#endif
            SEAM(sb + 1);
        }
        if (EN(2) && IN(sb + 2)) { phase_prep(lds, a, l); if (REP(2)) { xcd_barrier(bar); phase_prep(lds, a, l); } SEAM(sb + 2); }
        if (EN(3) && IN(sb + 3)) { phase_attn(lds, a, l); if (REP(3)) { xcd_barrier(bar); phase_attn(lds, a, l); } SEAM(sb + 3); }
        if (EN(4) && IN(sb + 4)) {
            { pg8::Gemm g{(const bf16*)(ws + WS_ALAT), (const bf16*)(ws + WS_XT) + (size_t)16384 * 256, 2048, 4096, 1024}; pg8::StaticOrder S; S.init(g.M, g.N, G, bid);
              pg8::EpiDft E{(bf16*)(ws + WS_AM), 10, NCTX};
              pg8::gemm_phase<pg8::EpiDft, pg8::StaticOrder, MK_ALIGN, MK_SP2>(lds, g, S, E); }
            { pg8::Gemm g{(const bf16*)(ws + WS_ACTX), (const bf16*)(ws + WS_XT), 512, 16384, 256}; pg8::StaticOrder S; S.init(g.M, g.N, G, (bid + G / 2) % G);
              pg8::EpiDft E{(bf16*)(ws + WS_AM), 8, 0};
              pg8::gemm_phase<pg8::EpiDft, pg8::StaticOrder, MK_ALIGN, MK_SP2>(lds, g, S, E); }
#if (MK_REP_MASK >> 4) & 1
            xcd_barrier(bar);
            {

            { pg8::Gemm g{(const bf16*)(ws + WS_ALAT), (const bf16*)(ws + WS_XT) + (size_t)16384 * 256, 2048, 4096, 1024}; pg8::StaticOrder S; S.init(g.M, g.N, G, bid);
              pg8::EpiDft E{(bf16*)(ws + WS_AM), 10, NCTX};
              pg8::gemm_phase<pg8::EpiDft, pg8::StaticOrder, MK_ALIGN, MK_SP2>(lds, g, S, E); }
            { pg8::Gemm g{(const bf16*)(ws + WS_ACTX), (const bf16*)(ws + WS_XT), 512, 16384, 256}; pg8::StaticOrder S; S.init(g.M, g.N, G, (bid + G / 2) % G);
              pg8::EpiDft E{(bf16*)(ws + WS_AM), 8, 0};
              pg8::gemm_phase<pg8::EpiDft, pg8::StaticOrder, MK_ALIGN, MK_SP2>(lds, g, S, E); }
            }
#endif
                        SEAM(sb + 4);
        }
        if (EN(5) && IN(sb + 5)) { phase_gla(lds, a, l); if (REP(5)) { xcd_barrier(bar); phase_gla(lds, a, l); } SEAM(sb + 5); }
        if (EN(6) && IN(sb + 6)) { phase_gla_fin(lds, a, l); if (REP(6)) { xcd_barrier(bar); phase_gla_fin(lds, a, l); } SEAM(sb + 6); }
        if (EN(7) && IN(sb + 7)) {
            pg8::Gemm g{(const bf16*)(ws + WS_AM), (const bf16*)(ws + WS_WMRG + l * SZ_WMRG), NTOK, DM, KMRG}; pg8::StaticOrder S; S.init(g.M, g.N, G, bid);
            pg8::EpiMerged E{(bf16*)(ws + WS_MG), (const bf16*)(ws + WS_Z)};
            pg8::gemm_phase<pg8::EpiMerged, pg8::StaticOrder, MK_ALIGN, MK_SP2>(lds, g, S, E);
#if (MK_REP_MASK >> 7) & 1
            xcd_barrier(bar);
            {

            pg8::Gemm g{(const bf16*)(ws + WS_AM), (const bf16*)(ws + WS_WMRG + l * SZ_WMRG), NTOK, DM, KMRG}; pg8::StaticOrder S; S.init(g.M, g.N, G, bid);
            pg8::EpiMerged E{(bf16*)(ws + WS_MG), (const bf16*)(ws + WS_Z)};
            pg8::gemm_phase<pg8::EpiMerged, pg8::StaticOrder, MK_ALIGN, MK_SP2>(lds, g, S, E);
            }
#endif
                        SEAM(sb + 7);
        }
        if (EN(8) && IN(sb + 8)) {
            pg8::Gemm g{(const bf16*)(ws + WS_MG), (const bf16*)(ws + WS_WOUT + l * SZ_WOUT), NTOK, DM, DM}; pg8::StaticOrder S; S.init(g.M, g.N, G, bid);
            pg8::EpiResid E{(float*)(ws + WS_X), MODL + 2 * DM};
            pg8::gemm_phase<pg8::EpiResid, pg8::StaticOrder, MK_ALIGN, MK_SP2>(lds, g, S, E);
#if (MK_REP_MASK >> 8) & 1
            xcd_barrier(bar);
            {

            pg8::Gemm g{(const bf16*)(ws + WS_MG), (const bf16*)(ws + WS_WOUT + l * SZ_WOUT), NTOK, DM, DM}; pg8::StaticOrder S; S.init(g.M, g.N, G, bid);
            pg8::EpiResid E{(float*)(ws + WS_X), (const float*)(ws + WS_CTL + 512 * 1024)};
            pg8::gemm_phase<pg8::EpiResid, pg8::StaticOrder, MK_ALIGN, MK_SP2>(lds, g, S, E);
            }
#endif
            SEAM(sb + 8);
        }
        if (EN(9) && IN(sb + 9)) { phase_norm(lds, a, l, 1, false); if (REP(9)) { xcd_barrier(bar); phase_norm(lds, a, l, 1, false); } SEAM(sb + 9); }
        if (EN(10) && IN(sb + 10)) {
            pg8::Gemm g{(const bf16*)(ws + WS_H), (const bf16*)(ws + WS_WUP + l * SZ_WUP), NTOK, NUP, DM}; pg8::StaticOrder S; S.init(g.M, g.N, G, bid);
            pg8::EpiStoreBf16 E{(bf16*)(ws + WS_Z), NUP};
            pg8::gemm_phase<pg8::EpiStoreBf16, pg8::StaticOrder, MK_ALIGN, MK_SP2>(lds, g, S, E);
#if (MK_REP_MASK >> 10) & 1
            xcd_barrier(bar);
            {

            pg8::Gemm g{(const bf16*)(ws + WS_H), (const bf16*)(ws + WS_WUP + l * SZ_WUP), NTOK, NUP, DM}; pg8::StaticOrder S; S.init(g.M, g.N, G, bid);
            pg8::EpiStoreBf16 E{(bf16*)(ws + WS_Z), NUP};
            pg8::gemm_phase<pg8::EpiStoreBf16, pg8::StaticOrder, MK_ALIGN, MK_SP2>(lds, g, S, E);
            }
#endif
                        SEAM(sb + 10);
        }
        if (EN(11) && IN(sb + 11)) { phase_conv(lds, a, l); if (REP(11)) { xcd_barrier(bar); phase_conv(lds, a, l); } SEAM(sb + 11); }
        if (EN(12) && IN(sb + 12)) {
            pg8::Gemm g{(const bf16*)(ws + WS_ACT), (const bf16*)(ws + WS_WDN + l * SZ_WDN), NTOK, DM, DFF}; pg8::StaticOrder S; S.init(g.M, g.N, G, bid);
            pg8::EpiResid E{(float*)(ws + WS_X), MODL + 5 * DM};
            pg8::gemm_phase<pg8::EpiResid, pg8::StaticOrder, MK_ALIGN, MK_SP2>(lds, g, S, E);
#if (MK_REP_MASK >> 12) & 1
            xcd_barrier(bar);
            {

            pg8::Gemm g{(const bf16*)(ws + WS_ACT), (const bf16*)(ws + WS_WDN + l * SZ_WDN), NTOK, DM, DFF}; pg8::StaticOrder S; S.init(g.M, g.N, G, bid);
            pg8::EpiResid E{(float*)(ws + WS_X), (const float*)(ws + WS_CTL + 512 * 1024)};
            pg8::gemm_phase<pg8::EpiResid, pg8::StaticOrder, MK_ALIGN, MK_SP2>(lds, g, S, E);
            }
#endif
            SEAM(sb + 12);
        }
    }
    if (EN(15) && IN(STEP_FINAL)) phase_final_norm(lds, a);
#undef IN
#undef SEAM
}

#ifndef MK_LAUNCH_MODE
#define MK_LAUNCH_MODE 0
#endif
extern "C" void kernel_launch(void* const* d_in, const int* in_sizes, int n_in, void* d_out, int out_size, void* d_ws, size_t ws_size, hipStream_t stream) {
    static int grid = 0;
    if (grid == 0) {
        if (n_in != 29 || (size_t)out_size != OUT_END || ws_size < WS_END + 4096) { fprintf(stderr, "kernel_launch: unexpected shapes: n_in %d out %d ws %zu (need %zu)\n", n_in, out_size, ws_size, (size_t)WS_END); grid = -1; return; }
        int dev = 0, cus = 0;
        if (hipGetDevice(&dev) != hipSuccess || hipDeviceGetAttribute(&cus, hipDeviceAttributeMultiprocessorCount, dev) != hipSuccess) { grid = -1; return; }
        if (hipFuncSetAttribute((const void*)mk_fwd, hipFuncAttributeMaxDynamicSharedMemorySize, LDS_BYTES) != hipSuccess) { fprintf(stderr, "kernel_launch: hipFuncSetAttribute failed\n"); grid = -1; return; }
        int per_cu = 0;
        if (hipOccupancyMaxActiveBlocksPerMultiprocessor(&per_cu, (const void*)mk_fwd, NWAVES * 64, LDS_BYTES) != hipSuccess || per_cu < 1) { fprintf(stderr, "kernel_launch: occupancy query says %d\n", per_cu); }
        (void)hipGetLastError();
        grid = cus;
    }
    if (grid < 0) return;
    (void)hipMemsetAsync((char*)d_ws + WS_CTL, 0, CTL_ZERO_BYTES, stream);
    Args a{};
    const float** p = (const float**)&a;
    for (int i = 0; i < 29; ++i) p[i] = (const float*)d_in[i];
    a.out = (float*)d_out; a.ws = (unsigned char*)d_ws; a.pad = 0;
#ifdef MK_PROBE
    {
        constexpr int PROBE_STEPS = (MK_PROBE == 2) ? 1 : (MK_PROBE == 1) ? STEP_L0 + 2 : (MK_PROBE == 4) ? STEP_L0 + 1 : (MK_PROBE == 5) ? 2 : STEP_L0 + 6;
        float* diag = (float*)((char*)d_ws + WS_DIAG);
        for (int s = 0; s < PROBE_STEPS; ++s) { a.s_lo = s; a.s_hi = s + 1; a.li = s; hipLaunchKernelGGL(mk_fwd, dim3(grid), dim3(NWAVES * 64), LDS_BYTES, stream, a); }
        hipLaunchKernelGGL(k_probe_zero, dim3(1), dim3(64), 0, stream, diag);
        if (MK_PROBE == 1) hipLaunchKernelGGL(k_probe_z, dim3(128), dim3(512), 0, stream, a);
        if (MK_PROBE == 2) hipLaunchKernelGGL(k_probe_wt, dim3(1024), dim3(256), 0, stream, a, MK_PROBE_L);
        if (MK_PROBE == 4) hipLaunchKernelGGL(k_probe_h, dim3(32), dim3(512), 0, stream, a);
        if (MK_PROBE == 5) hipLaunchKernelGGL(k_probe_mod, dim3(40), dim3(512), 0, stream, a, MK_PROBE_L);
        if (MK_PROBE == 3) hipLaunchKernelGGL(k_probe_gla, dim3(512), dim3(512), 0, stream, a);
        hipLaunchKernelGGL(k_probe_fill, dim3(1024), dim3(256), 0, stream, (float*)d_out, (const float*)(diag + 2 * MK_PROBE_SEL));
        hipLaunchKernelGGL(k_probe_fill2, dim3(1), dim3(64), 0, stream, (float*)d_out, (const float*)(diag + 2 * MK_PROBE_SEL));
        return;
    }
#endif
#if MK_LAUNCH_MODE == 1
    a.s_lo = 0; a.s_hi = N_STEPS; a.li = 0;
    hipLaunchKernelGGL(mk_fwd, dim3(grid), dim3(NWAVES * 64), LDS_BYTES, stream, a);
#else
    for (int s = 0; s < N_STEPS; ++s) { a.s_lo = s; a.s_hi = s + 1; a.li = s;
        hipLaunchKernelGGL(mk_fwd, dim3(grid), dim3(NWAVES * 64), LDS_BYTES, stream, a); }
#endif
}
```

```cpp
#define MK_LAUNCH_MODE 1
#include <hip/hip_runtime.h>
#include <cstdio>
#include <cstdint>

#define GAS __attribute__((address_space(1)))
#define LAS __attribute__((address_space(3)))
typedef unsigned short bf16;
typedef short bf16x8 __attribute__((ext_vector_type(8)));
typedef float f32x4 __attribute__((ext_vector_type(4)));
typedef float f32x2 __attribute__((ext_vector_type(2)));
typedef unsigned u32x4 __attribute__((ext_vector_type(4)));
typedef unsigned u32x2 __attribute__((ext_vector_type(2)));
typedef GAS unsigned gu32;

constexpr int DM = 2048, NTOK = 8192, NCTX = 4096, TC = 256, TL = 1024, BCTX = 16, BLAT = 4, PAST = 256, DEPTH = 4;
constexpr int N_IN = 11808, NZ = 12032;
constexpr int ZF = 0, ZQ = 1024, ZK = 2048, ZV = 2304, ZGQ = 2560, ZGK = 3072, ZGV = 3584, ZGR = 4608, ZGAF = 5632, ZGAB = 5648, ZPAD = 5664, ZGATE = 5888;
constexpr int NUP = 11264, DFF = 5632, NMOD = 12288, KMRG = 4096;
constexpr int NMODV = 5;
constexpr float EPS = 1e-6f;

constexpr size_t MiB = 1u << 20;
constexpr size_t WS_CTL = 0, CTL_ZERO_BYTES = 1 * MiB;
constexpr size_t WS_MOD = 1 * MiB;
constexpr size_t WS_MODP = 2 * MiB;
constexpr size_t WS_DT = 17 * MiB;
constexpr size_t WS_ACTX = 21 * MiB;
constexpr size_t WS_ALAT = 22 * MiB;
constexpr size_t WS_WIN = 26 * MiB;
constexpr size_t WS_WMRG = 214 * MiB;
constexpr size_t WS_WFT = 278 * MiB;
constexpr size_t WS_WOUT = 294 * MiB;
constexpr size_t WS_WUP = 326 * MiB;
constexpr size_t WS_WDN = 502 * MiB;
constexpr size_t WS_X = 590 * MiB;
constexpr size_t WS_H = 654 * MiB;
constexpr size_t WS_Z = 686 * MiB;
constexpr size_t WS_XT = 874 * MiB;
constexpr size_t WS_KC = 890 * MiB, WS_VC = 892 * MiB;
constexpr size_t WS_KL = 894 * MiB, WS_VL = 897 * MiB;
constexpr size_t WS_AM = 900 * MiB;
constexpr size_t WS_OF = 964 * MiB, WS_OB = 996 * MiB;
constexpr size_t WS_MG = 1028 * MiB;
constexpr size_t WS_ACT = 1060 * MiB;
constexpr size_t WS_QN = 1148 * MiB;
constexpr size_t WS_GQE = 1164 * MiB, WS_GKLT = 1180 * MiB, WS_GATT = 1196 * MiB, WS_GEB = 1204 * MiB;
constexpr size_t WS_END = 1205 * MiB;
constexpr size_t SZ_WIN = (size_t)NZ * DM * 2, SZ_WMRG = (size_t)DM * KMRG * 2, SZ_WFT = (size_t)DM * 1024 * 2, SZ_WOUT = (size_t)DM * DM * 2, SZ_WUP = (size_t)NUP * DM * 2, SZ_WDN = (size_t)DM * DFF * 2;
static_assert(WS_WIN + 4 * SZ_WIN <= WS_WMRG && WS_WMRG + 4 * SZ_WMRG <= WS_WFT && WS_WFT + 4 * SZ_WFT <= WS_WOUT && WS_WOUT + 4 * SZ_WOUT <= WS_WUP && WS_WUP + 4 * SZ_WUP <= WS_WDN && WS_WDN + 4 * SZ_WDN <= WS_X, "ws map (weights)");
static_assert(WS_Z + (size_t)NTOK * NZ * 2 <= WS_XT && WS_MODP + (size_t)16 * 4 * 5 * NMOD * 4 <= WS_DT && WS_AM + (size_t)NTOK * KMRG * 2 <= WS_OF && WS_ACT + (size_t)NTOK * DFF * 2 <= WS_END, "ws map (activations)");
constexpr int CW_BAR = 4096;

constexpr int LDS_BYTES = 163840;
constexpr int MISC_OFF = LDS_BYTES - 256;
constexpr int NWAVES = 8;

#define RLX_AGENT __ATOMIC_RELAXED, __HIP_MEMORY_SCOPE_AGENT
#define LDS_WAIT() asm volatile("s_waitcnt lgkmcnt(0)" ::: "memory")
#define VM_WAIT() asm volatile("s_waitcnt vmcnt(0)" ::: "memory")
__device__ __forceinline__ unsigned cvt_pk_bf16(float lo, float hi) { unsigned r; asm volatile("v_cvt_pk_bf16_f32 %0, %1, %2" : "=v"(r) : "v"(lo), "v"(hi)); return r; }
__device__ __forceinline__ float bf_lo(unsigned w) { return __builtin_bit_cast(float, w << 16); }
__device__ __forceinline__ float bf_hi(unsigned w) { return __builtin_bit_cast(float, w & 0xffff0000u); }
__device__ __forceinline__ float bf2f(bf16 h) { return __builtin_bit_cast(float, (unsigned)h << 16); }
__device__ __forceinline__ bf16 f2bf(float f) { return (bf16)(cvt_pk_bf16(f, 0.f) & 0xffffu); }
#ifndef MK_F16
#define MK_F16 1
#endif
typedef _Float16 h16x2 __attribute__((ext_vector_type(2)));
typedef _Float16 h16x8 __attribute__((ext_vector_type(8)));
typedef float f32x16_t __attribute__((ext_vector_type(16)));
#if MK_F16
__device__ __forceinline__ unsigned pk_act(float lo, float hi) { h16x2 v; v[0] = (_Float16)lo; v[1] = (_Float16)hi; return __builtin_bit_cast(unsigned, v); }
__device__ __forceinline__ float lo_act(unsigned w) { return (float)__builtin_bit_cast(h16x2, w)[0]; }
__device__ __forceinline__ float hi_act(unsigned w) { return (float)__builtin_bit_cast(h16x2, w)[1]; }
__device__ __forceinline__ float act2f(bf16 h) { return (float)__builtin_bit_cast(_Float16, h); }
__device__ __forceinline__ bf16 f2act(float f) { return __builtin_bit_cast(bf16, (_Float16)f); }
__device__ __forceinline__ f32x4 mma16_act(bf16x8 a, bf16x8 b, f32x4 c) { return __builtin_amdgcn_mfma_f32_16x16x32_f16(__builtin_bit_cast(h16x8, a), __builtin_bit_cast(h16x8, b), c, 0, 0, 0); }
__device__ __forceinline__ f32x16_t mma32_act(bf16x8 a, bf16x8 b, f32x16_t c) { return __builtin_amdgcn_mfma_f32_32x32x16_f16(__builtin_bit_cast(h16x8, a), __builtin_bit_cast(h16x8, b), c, 0, 0, 0); }
#else
__device__ __forceinline__ unsigned pk_act(float lo, float hi) { return cvt_pk_bf16(lo, hi); }
__device__ __forceinline__ float lo_act(unsigned w) { return bf_lo(w); }
__device__ __forceinline__ float hi_act(unsigned w) { return bf_hi(w); }
__device__ __forceinline__ float act2f(bf16 h) { return bf2f(h); }
__device__ __forceinline__ bf16 f2act(float f) { return f2bf(f); }
__device__ __forceinline__ f32x4 mma16_act(bf16x8 a, bf16x8 b, f32x4 c) { return __builtin_amdgcn_mfma_f32_16x16x32_bf16(a, b, c, 0, 0, 0); }
__device__ __forceinline__ f32x16_t mma32_act(bf16x8 a, bf16x8 b, f32x16_t c) { return __builtin_amdgcn_mfma_f32_32x32x16_bf16(a, b, c, 0, 0, 0); }
#endif
template <int M> __device__ __forceinline__ float swz_xor(float v) { return __builtin_bit_cast(float, __builtin_amdgcn_ds_swizzle(__builtin_bit_cast(int, v), (M << 10) | 0x1f)); }
__device__ __forceinline__ float half_sum(float v) { v += swz_xor<1>(v); v += swz_xor<2>(v); v += swz_xor<4>(v); v += swz_xor<8>(v); v += swz_xor<16>(v); return v; }
__device__ __forceinline__ float wave_sum(float v) { v = half_sum(v);
    auto rr = __builtin_amdgcn_permlane32_swap(__float_as_uint(v), __float_as_uint(v), false, false); return __uint_as_float(rr[0]) + __uint_as_float(rr[1]); }
__device__ __forceinline__ float sigmoidf_(float x) { return __builtin_amdgcn_rcpf(1.f + __expf(-x)); }
__device__ __forceinline__ float siluf_(float x) { return x * sigmoidf_(x); }
__device__ __forceinline__ int opaque_tid() { int t = threadIdx.x; asm volatile("" : "+v"(t)); return t; }
__device__ __forceinline__ int mod_row(int r) { return r < NCTX ? 0 : 1 + ((r - NCTX) >> 10); }

namespace pg8 {
#define PG8_LAS __attribute__((address_space(3)))
typedef unsigned short bf16_t;
constexpr int BM = 256, BK = 64, HALF = 128, HTB = HALF * BK * 2  , STAGE_BYTES = 8 * HTB, NXCD = 8, WGM = 8;

__host__ __device__ __forceinline__ int lds_byte(int r, int c) { const int st = (r >> 4) * 2 + (c >> 5), rr = r & 15, cc = c & 31, ob = rr * 64 + cc * 2; return st * 1024 + (ob ^ (((ob >> 9) & 1) << 5)); }
__host__ __device__ __forceinline__ void stage_rc(int b, int& R, int& C) { const int st = b / 1024, sb = b % 1024, swz = sb ^ (((sb >> 9) & 1) << 5); R = (st >> 1) * 16 + swz / 64; C = (st & 1) * 32 + (swz % 64) / 2; }
__host__ __device__ __forceinline__ int perm32(int rho) { const int n = rho >> 4, i = rho & 15; return 8 * (i >> 2) + 4 * n + (i & 3); }

struct Unit { int pm, pn; };
struct Gemm { const bf16_t* A; const bf16_t* Bt; int M, N, K; };

struct StaticOrder {
    int nM, nN, nwg, G, c;
    __host__ __device__ void init(int M, int N, int G_, int c_) { nM = M / BM; nN = N / BM; nwg = nM * nN; G = G_; c = c_; }
    __host__ __device__ bool next(int i, Unit& u) const {
        const long L = (long)i * G + c; if (L >= nwg) return false;
        int wgid = (int)L; { const int q = nwg / NXCD, r = nwg % NXCD, xcd = wgid % NXCD, off = wgid / NXCD; wgid = (xcd < r ? xcd * (q + 1) : r * (q + 1) + (xcd - r) * q) + off; }
        const int nig = WGM * nN, gid = wgid / nig, fm = gid * WGM, gsz = (nM - fm) < WGM ? (nM - fm) : WGM;
        u.pm = fm + ((wgid % nig) % gsz); u.pn = (wgid % nig) / gsz; return true;
    }
    __device__ __forceinline__ void a_ready(const Unit&) const {}
    __device__ __forceinline__ void done(const Unit&) const {}
};

template <class Epi, class Sched, bool ALIGN_EPI = false, bool SP2 = false>
__device__ __forceinline__ void gemm_phase(PG8_LAS unsigned char* lds, const Gemm g, const Sched& S, const Epi& E) {
    const int tid = opaque_tid(), wid = __builtin_amdgcn_readfirstlane(tid >> 6), lane = tid & 63, wr = wid >> 2, wc = wid & 3, fr = lane & 15, fq = lane >> 4;
    const int K = g.K, nt = K / BK;
    unsigned voffA[2], voffB[2];
#pragma unroll
    for (int i = 0; i < 2; ++i) { int R, C; stage_rc(tid * 16 + i * 8192, R, C); const int Rb = Epi::PERM ? ((R & ~31) + perm32(R & 31)) : R;
        voffA[i] = (unsigned)(R * K + C) * 2u; voffB[i] = (unsigned)(Rb * K + C) * 2u; }
    const size_t kstep = (size_t)(BK * 2);
    const size_t hstep = (size_t)HALF * K * 2;
    const size_t tstep = 2 * hstep;
    const unsigned ldsw = (unsigned)wid * 1024u;
    const int aoff = lds_byte(wr * 64 + fr, fq * 8), boff = lds_byte(wc * 32 + fr, fq * 8);
#define PG8_SA(b, h) (((b) * 2 + (h)) * HTB)
#define PG8_SB(b, h) ((4 + (b) * 2 + (h)) * HTB)
#define PG8_STAGE(bufoff, gbase, voff) do { _Pragma("unroll") for (int _i = 0; _i < 2; ++_i) \
        __builtin_amdgcn_global_load_lds((const unsigned*)((const char*)(gbase) + (voff)[_i]), (PG8_LAS unsigned*)(lds + (bufoff) + ldsw + _i * 8192), 16, 0, 0); } while (0)
#define PG8_LDA(dst, b, h) do { _Pragma("unroll") for (int m = 0; m < 4; ++m) _Pragma("unroll") for (int k = 0; k < 2; ++k) dst[m][k] = *(const PG8_LAS bf16x8*)(lds + PG8_SA(b, h) + aoff + m * 2048 + k * 1024); } while (0)
#define PG8_LDB(dst, b, h) do { _Pragma("unroll") for (int n = 0; n < 2; ++n) _Pragma("unroll") for (int k = 0; k < 2; ++k) dst[n][k] = *(const PG8_LAS bf16x8*)(lds + PG8_SB(b, h) + boff + n * 2048 + k * 1024); } while (0)
#define PG8_MMA(ai, bj, At, Bt) do { __builtin_amdgcn_s_setprio(1); _Pragma("unroll") for (int m = 0; m < 4; ++m) _Pragma("unroll") for (int n = 0; n < 2; ++n) _Pragma("unroll") for (int k = 0; k < 2; ++k) \
        acc[ai][bj][m][n] = mma16_act(Bt[n][k], At[m][k], acc[ai][bj][m][n]); __builtin_amdgcn_s_setprio(0); } while (0)
#define PG8_WAIT_V(n) asm volatile("s_waitcnt vmcnt(" #n ")" ::: "memory")
#define PG8_WAIT_L(n) asm volatile("s_waitcnt lgkmcnt(" #n ")" ::: "memory")
#define PG8_BAR __builtin_amdgcn_s_barrier()
#define PG8_SCHED __builtin_amdgcn_sched_barrier(0)
    Unit cur, nxt; int ui = 0;
    if (!S.next(0, cur)) return;
    f32x4 acc[2][2][4][2];
#pragma unroll
    for (int a = 0; a < 2; ++a)
#pragma unroll
        for (int b = 0; b < 2; ++b)
#pragma unroll
            for (int m = 0; m < 4; ++m)
#pragma unroll
                for (int n = 0; n < 2; ++n) acc[a][b][m][n] = (f32x4){0.f, 0.f, 0.f, 0.f};
    bf16x8 At[4][2], B0[2][2], B1[2][2];
    const char* cA = (const char*)g.A + (size_t)cur.pm * tstep; const char* cB = (const char*)g.Bt + (size_t)cur.pn * tstep;
    S.a_ready(cur);
    if constexpr (SP2) {
        PG8_STAGE(PG8_SB(0, 0), cB, voffB); PG8_STAGE(PG8_SB(0, 1), cB + hstep, voffB); PG8_STAGE(PG8_SA(0, 0), cA, voffA); PG8_STAGE(PG8_SA(0, 1), cA + hstep, voffA);
        if (wr == 1) PG8_BAR;
        PG8_WAIT_V(2); PG8_BAR;
        PG8_STAGE(PG8_SB(1, 0), cB + kstep, voffB); PG8_STAGE(PG8_SA(1, 0), cA + kstep, voffA); PG8_STAGE(PG8_SB(1, 1), cB + hstep + kstep, voffB);
        PG8_WAIT_V(6); PG8_BAR;
    } else {
        PG8_STAGE(PG8_SB(0, 0), cB, voffB); PG8_STAGE(PG8_SA(0, 0), cA, voffA); PG8_STAGE(PG8_SB(0, 1), cB + hstep, voffB); PG8_STAGE(PG8_SA(0, 1), cA + hstep, voffA);
        if (wr == 1) PG8_BAR;
        PG8_WAIT_V(4); PG8_BAR;
        PG8_STAGE(PG8_SB(1, 0), cB + kstep, voffB); PG8_STAGE(PG8_SA(1, 0), cA + kstep, voffA); PG8_STAGE(PG8_SB(1, 1), cB + hstep + kstep, voffB);
        PG8_WAIT_V(6); PG8_BAR;
    }
    for (;;) {
        const bool has_next = S.next(ui + 1, nxt);
        const char* nA = has_next ? (const char*)g.A + (size_t)nxt.pm * tstep : cA; const char* nB = has_next ? (const char*)g.Bt + (size_t)nxt.pn * tstep : cB;
#pragma unroll
        for (int sgi = 0; sgi < Epi::NSEG; ++sgi) {
        const int t_beg = sgi == 0 ? 0 : Epi::seg_end(sgi - 1), t_end = sgi == Epi::NSEG - 1 ? nt : Epi::seg_end(sgi);
        for (int t = t_beg; t < t_end; t += 2) {
            const bool last = (t == nt - 2);
            const char* a1 = cA + (size_t)(t + 1) * kstep;
            const char* a2 = last ? nA : cA + (size_t)(t + 2) * kstep; const char* b2 = last ? nB : cB + (size_t)(t + 2) * kstep;
            const char* a3 = a2 + kstep; const char* b3 = b2 + kstep;
            if (last && has_next) S.a_ready(nxt);
            if constexpr (SP2) {
            PG8_LDB(B0, 0, 0); PG8_LDB(B1, 0, 1); PG8_SCHED; PG8_LDA(At, 0, 0); PG8_STAGE(PG8_SA(1, 1), a1 + hstep, voffA);
            PG8_WAIT_V(8); PG8_WAIT_L(0); PG8_BAR; PG8_MMA(0, 0, At, B0); PG8_MMA(0, 1, At, B1); PG8_BAR; PG8_SCHED;
            PG8_LDA(At, 0, 1); PG8_STAGE(PG8_SB(0, 0), b2, voffB); PG8_STAGE(PG8_SB(0, 1), b2 + hstep, voffB); PG8_STAGE(PG8_SA(0, 0), a2, voffA);
            PG8_WAIT_V(8); PG8_WAIT_L(0); PG8_BAR; PG8_MMA(1, 0, At, B0); PG8_MMA(1, 1, At, B1); PG8_BAR; PG8_SCHED;
            PG8_LDB(B0, 1, 0); PG8_LDB(B1, 1, 1); PG8_SCHED; PG8_LDA(At, 1, 0); PG8_STAGE(PG8_SA(0, 1), a2 + hstep, voffA);
            PG8_WAIT_V(8); PG8_WAIT_L(0); PG8_BAR; PG8_MMA(0, 0, At, B0); PG8_MMA(0, 1, At, B1); PG8_BAR; PG8_SCHED;
            PG8_LDA(At, 1, 1); PG8_STAGE(PG8_SB(1, 0), b3, voffB); PG8_STAGE(PG8_SB(1, 1), b3 + hstep, voffB); PG8_STAGE(PG8_SA(1, 0), a3, voffA);
            PG8_WAIT_V(8); PG8_WAIT_L(0); PG8_BAR; PG8_MMA(1, 0, At, B0); PG8_MMA(1, 1, At, B1); PG8_BAR; PG8_SCHED;
            } else {
            PG8_LDB(B0, 0, 0); PG8_SCHED; PG8_LDA(At, 0, 0); PG8_STAGE(PG8_SA(1, 1), a1 + hstep, voffA);
            PG8_WAIT_L(8); PG8_BAR; PG8_WAIT_L(0); PG8_MMA(0, 0, At, B0); PG8_BAR; PG8_SCHED;
            PG8_LDB(B1, 0, 1); PG8_STAGE(PG8_SB(0, 0), b2, voffB);
            PG8_BAR; PG8_WAIT_L(0); PG8_MMA(0, 1, At, B1); PG8_BAR;
            PG8_LDA(At, 0, 1); PG8_STAGE(PG8_SA(0, 0), a2, voffA);
            PG8_BAR; PG8_WAIT_L(0); PG8_MMA(1, 0, At, B0); PG8_BAR; PG8_SCHED;
            PG8_STAGE(PG8_SB(0, 1), b2 + hstep, voffB);
            PG8_WAIT_V(6); PG8_BAR; PG8_MMA(1, 1, At, B1); PG8_BAR;
            PG8_LDB(B0, 1, 0); PG8_SCHED; PG8_LDA(At, 1, 0); PG8_STAGE(PG8_SA(0, 1), a2 + hstep, voffA);
            PG8_WAIT_L(8); PG8_BAR; PG8_WAIT_L(0); PG8_MMA(0, 0, At, B0); PG8_BAR; PG8_SCHED;
            PG8_LDB(B1, 1, 1); PG8_STAGE(PG8_SB(1, 0), b3, voffB);
            PG8_BAR; PG8_WAIT_L(0); PG8_MMA(0, 1, At, B1); PG8_BAR;
            PG8_LDA(At, 1, 1); PG8_STAGE(PG8_SA(1, 0), a3, voffA);
            PG8_BAR; PG8_WAIT_L(0); PG8_MMA(1, 0, At, B0); PG8_BAR; PG8_SCHED;
            PG8_STAGE(PG8_SB(1, 1), b3 + hstep, voffB);
            PG8_WAIT_V(6); PG8_BAR; PG8_MMA(1, 1, At, B1); PG8_BAR;
            }
        }
        if constexpr (Epi::NSEG > 1) { if (sgi < Epi::NSEG - 1) E.mid(acc, cur, sgi, wr, wc, fr, fq); }
        }
        if constexpr (ALIGN_EPI) { if (wr == 0) PG8_BAR; }
        E(acc, cur, wr, wc, fr, fq); S.done(cur);
        if (!has_next) break;
#pragma unroll
        for (int a = 0; a < 2; ++a)
#pragma unroll
            for (int b = 0; b < 2; ++b)
#pragma unroll
                for (int m = 0; m < 4; ++m)
#pragma unroll
                    for (int n = 0; n < 2; ++n) acc[a][b][m][n] = (f32x4){0.f, 0.f, 0.f, 0.f};
        cur = nxt; cA = nA; cB = nB; ++ui;
        if constexpr (ALIGN_EPI) { if (wr == 1) PG8_BAR; }
    }
    PG8_WAIT_V(0);
    if constexpr (!ALIGN_EPI) { if (wr == 0) PG8_BAR; }
    PG8_BAR;
#undef PG8_SA
#undef PG8_SB
#undef PG8_STAGE
#undef PG8_LDA
#undef PG8_LDB
#undef PG8_MMA
#undef PG8_WAIT_V
#undef PG8_WAIT_L
#undef PG8_BAR
#undef PG8_SCHED
}

struct EpiStoreBf16 {
    static constexpr bool PERM = true; static constexpr int NSEG = 1; static constexpr int seg_end(int) { return 0; }
    bf16_t* O; int ldc;
    __device__ __forceinline__ void operator()(f32x4 (&acc)[2][2][4][2], const Unit& u, int wr, int wc, int fr, int fq) const {
        bf16_t* base = O + (size_t)(u.pm * BM + wr * 64 + fr) * ldc + u.pn * BM + wc * 32 + 8 * fq;
#pragma unroll
        for (int ai = 0; ai < 2; ++ai)
#pragma unroll
            for (int m = 0; m < 4; ++m) { bf16_t* rowp = base + (size_t)(ai * HALF + m * 16) * ldc;
#pragma unroll
                for (int bj = 0; bj < 2; ++bj) { const f32x4 v0 = acc[ai][bj][m][0], v1 = acc[ai][bj][m][1];
                    u32x4 w; w.x = pk_act(v0[0], v0[1]); w.y = pk_act(v0[2], v0[3]); w.z = pk_act(v1[0], v1[1]); w.w = pk_act(v1[2], v1[3]);
                    *(u32x4*)(rowp + bj * HALF) = w; } }
    }
};
struct EpiDft {
    static constexpr bool PERM = true; static constexpr int NSEG = 1; static constexpr int seg_end(int) { return 0; }
    bf16_t* AM; int tshift, tokbase;
    __device__ __forceinline__ void operator()(f32x4 (&acc)[2][2][4][2], const Unit& u, int wr, int wc, int fr, int fq) const {
        const int k0 = u.pm * BM, part = k0 >> tshift, kk0 = k0 & ((1 << tshift) - 1), b = u.pn >> 2, ch0 = (u.pn & 3) * BM;
        bf16_t* base = AM + (size_t)(tokbase + (b << tshift) + kk0 + wr * 64 + fr) * KMRG + part * 1024 + ch0 + wc * 32 + 8 * fq;
#pragma unroll
        for (int ai = 0; ai < 2; ++ai)
#pragma unroll
            for (int m = 0; m < 4; ++m) { bf16_t* rowp = base + (size_t)(ai * HALF + m * 16) * KMRG;
#pragma unroll
                for (int bj = 0; bj < 2; ++bj) { const f32x4 v0 = acc[ai][bj][m][0], v1 = acc[ai][bj][m][1];
                    u32x4 w; w.x = pk_act(v0[0], v0[1]); w.y = pk_act(v0[2], v0[3]); w.z = pk_act(v1[0], v1[1]); w.w = pk_act(v1[2], v1[3]);
                    *(u32x4*)(rowp + bj * HALF) = w; } }
    }
};
struct EpiMerged {
    static constexpr bool PERM = true; static constexpr int NSEG = 3; static constexpr int seg_end(int s) { return s == 0 ? 32 : 48; }
    bf16_t* O; const bf16_t* Z;
    __device__ __forceinline__ void scale_by(f32x4 (&acc)[2][2][4][2], const Unit& u, int wr, int wc, int fr, int fq, int gnum, int gden) const {
        int lo_ = fr * NZ + 8 * fq; asm volatile("" : "+v"(lo_));
        const bf16_t* zb = Z + (size_t)(u.pm * BM + wr * 64) * NZ + ZGATE + u.pn * BM + wc * 32 + lo_;
#pragma unroll
        for (int ai = 0; ai < 2; ++ai) {
            u32x4 gn[4][2], gd[4][2];
#pragma unroll
            for (int m = 0; m < 4; ++m)
#pragma unroll
                for (int bj = 0; bj < 2; ++bj) { const bf16_t* zr = zb + (size_t)(ai * HALF + m * 16) * NZ + bj * HALF;
                    gn[m][bj] = *(const u32x4*)(zr + gnum * DM); if (gden >= 0) gd[m][bj] = *(const u32x4*)(zr + gden * DM); else gd[m][bj] = (u32x4){0u, 0u, 0u, 0u}; }
#pragma unroll
            for (int m = 0; m < 4; ++m)
#pragma unroll
                for (int bj = 0; bj < 2; ++bj) {
                    float s[8];
#pragma unroll
                    for (int q = 0; q < 4; ++q) {
                        const float n0 = 1.f + __expf(-lo_act(gn[m][bj][q])), n1 = 1.f + __expf(-hi_act(gn[m][bj][q]));
                        float d0 = 1.f, d1 = 1.f; if (gden >= 0) { d0 = 1.f + __expf(-lo_act(gd[m][bj][q])); d1 = 1.f + __expf(-hi_act(gd[m][bj][q])); }
                        s[2 * q] = d0 * __builtin_amdgcn_rcpf(n0); s[2 * q + 1] = d1 * __builtin_amdgcn_rcpf(n1); }
                    f32x4 v0 = acc[ai][bj][m][0], v1 = acc[ai][bj][m][1];
                    v0[0] *= s[0]; v0[1] *= s[1]; v0[2] *= s[2]; v0[3] *= s[3]; v1[0] *= s[4]; v1[1] *= s[5]; v1[2] *= s[6]; v1[3] *= s[7];
                    acc[ai][bj][m][0] = v0; acc[ai][bj][m][1] = v1; }
            asm volatile("" ::: "memory"); }
    }
    __device__ __forceinline__ void mid(f32x4 (&acc)[2][2][4][2], const Unit& u, int s, int wr, int wc, int fr, int fq) const {
        if (s == 0) scale_by(acc, u, wr, wc, fr, fq, 0, 1); else scale_by(acc, u, wr, wc, fr, fq, 1, 2);
    }
    __device__ __forceinline__ void operator()(f32x4 (&acc)[2][2][4][2], const Unit& u, int wr, int wc, int fr, int fq) const {
        scale_by(acc, u, wr, wc, fr, fq, 2, -1);
        bf16_t* base = O + (size_t)(u.pm * BM + wr * 64 + fr) * DM + u.pn * BM + wc * 32 + 8 * fq;
#pragma unroll
        for (int ai = 0; ai < 2; ++ai)
#pragma unroll
            for (int m = 0; m < 4; ++m) { bf16_t* rowp = base + (size_t)(ai * HALF + m * 16) * DM;
#pragma unroll
                for (int bj = 0; bj < 2; ++bj) { const f32x4 v0 = acc[ai][bj][m][0], v1 = acc[ai][bj][m][1];
                    u32x4 w; w.x = pk_act(v0[0], v0[1]); w.y = pk_act(v0[2], v0[3]); w.z = pk_act(v1[0], v1[1]); w.w = pk_act(v1[2], v1[3]);
                    *(u32x4*)(rowp + bj * HALF) = w; } }
    }
};
struct EpiResid {
    static constexpr bool PERM = false; static constexpr int NSEG = 1; static constexpr int seg_end(int) { return 0; }
    float* X; const float* gate;
    __device__ __forceinline__ void operator()(f32x4 (&acc)[2][2][4][2], const Unit& u, int wr, int wc, int fr, int fq) const {
        int lo_ = fr * DM + 4 * fq; asm volatile("" : "+v"(lo_));
        const int col0 = u.pn * BM + wc * 32;
        const float* gp = gate + (size_t)mod_row(u.pm * BM) * NMOD + col0 + 4 * fq;
        float* xb = X + (size_t)(u.pm * BM + wr * 64) * DM + col0 + lo_;
        f32x4 gv[2][2];
#pragma unroll
        for (int bj = 0; bj < 2; ++bj)
#pragma unroll
            for (int n = 0; n < 2; ++n) gv[bj][n] = *(const f32x4*)(gp + bj * HALF + n * 16);
#pragma unroll
        for (int ai = 0; ai < 2; ++ai) {
            f32x4 xv[4][2][2];
#pragma unroll
            for (int m = 0; m < 4; ++m)
#pragma unroll
                for (int bj = 0; bj < 2; ++bj)
#pragma unroll
                    for (int n = 0; n < 2; ++n) xv[m][bj][n] = *(const f32x4*)(xb + (size_t)(ai * HALF + m * 16) * DM + bj * HALF + n * 16);
#pragma unroll
            for (int m = 0; m < 4; ++m)
#pragma unroll
                for (int bj = 0; bj < 2; ++bj)
#pragma unroll
                    for (int n = 0; n < 2; ++n) *(f32x4*)(xb + (size_t)(ai * HALF + m * 16) * DM + bj * HALF + n * 16) = xv[m][bj][n] + gv[bj][n] * acc[ai][bj][m][n];
            asm volatile("" ::: "memory"); }
    }
};
}

namespace att {
constexpr int D = 128, NW = 8, QBLK = 32, KVBLK = 64;
constexpr float SCALE = 0.088388347648318440f;
constexpr float THR = 8.f;
constexpr int LDQ = 1024, LDK = 256, LDO = KMRG;
constexpr int SHM_V = KVBLK * D * 2, SHM_K = KVBLK * D * 2, SHM_ATTN = 2 * SHM_V + 2 * SHM_K + NW * 64 * 4;
typedef __attribute__((ext_vector_type(4))) short s16x4;
typedef __attribute__((ext_vector_type(16))) float f32x16;
#define KSWZ(row, colB) ((row) * 256 + ((colB) ^ (((row) & 7) << 4)))
#define SBAR() __builtin_amdgcn_sched_barrier(0)
__device__ __forceinline__ int crow(int r, int hi) { return (r & 3) + 8 * (r >> 2) + 4 * hi; }

__device__ __forceinline__ void partialSM(f32x16& p0, f32x16& p1, float& m_reg, float& mn, float& alpha) {
  constexpr float C = SCALE * 1.4426950408889634f;
  float pmax = p0[0];
#pragma unroll
  for (int r = 1; r < 16; ++r) pmax = fmaxf(pmax, p0[r]);
#pragma unroll
  for (int r = 0; r < 16; ++r) pmax = fmaxf(pmax, p1[r]);
  { auto rr = __builtin_amdgcn_permlane32_swap(__float_as_uint(pmax), __float_as_uint(pmax), false, false);
    pmax = fmaxf(__uint_as_float(rr[0]), __uint_as_float(rr[1])); }
  if (__builtin_expect(__all(pmax - m_reg <= THR / SCALE), 1)) { mn = m_reg; alpha = 1.f; }
  else { mn = fmaxf(m_reg, pmax); alpha = __builtin_amdgcn_exp2f((m_reg - mn) * C); m_reg = mn; }
  float mnC = -mn * C;
#pragma unroll
  for (int r = 0; r < 16; ++r) p0[r] = fmaf(p0[r], C, mnC);
#pragma unroll
  for (int r = 0; r < 16; ++r) p1[r] = fmaf(p1[r], C, mnC);
#pragma unroll
  for (int r = 0; r < 16; ++r) p0[r] = __builtin_amdgcn_exp2f(p0[r]);
}
__device__ __forceinline__ void finishSM(f32x16& p0, f32x16& p1, float alpha, float& l_reg, bf16x8& pa0, bf16x8& pa1, bf16x8& pa2, bf16x8& pa3) {
#pragma unroll
  for (int r = 0; r < 16; ++r) p1[r] = __builtin_amdgcn_exp2f(p1[r]);
  float ps = 0;
#pragma unroll
  for (int r = 0; r < 16; ++r) ps += p0[r];
#pragma unroll
  for (int r = 0; r < 16; ++r) ps += p1[r];
  { auto rr = __builtin_amdgcn_permlane32_swap(__float_as_uint(ps), __float_as_uint(ps), false, false);
    ps = __uint_as_float(rr[0]) + __uint_as_float(rr[1]); }
  l_reg = l_reg * alpha + ps;
#define PK4(P, BASE, OUT) do { unsigned a0 = pk_act(P[BASE + 0], P[BASE + 1]), a1 = pk_act(P[BASE + 2], P[BASE + 3]);   \
    unsigned b0 = pk_act(P[BASE + 4], P[BASE + 5]), b1 = pk_act(P[BASE + 6], P[BASE + 7]);                              \
    auto r0 = __builtin_amdgcn_permlane32_swap(a0, b0, false, false); auto r1 = __builtin_amdgcn_permlane32_swap(a1, b1, false, false); \
    u32x4 w = {r0[0], r1[0], r0[1], r1[1]}; OUT = *reinterpret_cast<bf16x8*>(&w); } while (0)
  PK4(p0, 0, pa0); PK4(p0, 8, pa1); PK4(p1, 0, pa2); PK4(p1, 8, pa3);
#undef PK4
}
__device__ __forceinline__ void qkt(f32x16& p0, f32x16& p1, const LAS char* Ks, const bf16x8* qr, int r32, int hi) {
  p0 = f32x16{}; p1 = f32x16{};
#pragma unroll
  for (int d0 = 0; d0 < 8; ++d0) { int cb = (d0 * 16 + hi * 8) * 2;
    bf16x8 b0 = *reinterpret_cast<const LAS bf16x8*>(Ks + KSWZ(r32, cb));
    bf16x8 b1 = *reinterpret_cast<const LAS bf16x8*>(Ks + KSWZ(32 + r32, cb));
    p0 = mma32_act(b0, qr[d0], p0);
    p1 = mma32_act(b1, qr[d0], p1); }
}
__device__ __forceinline__ int v_st(int k, int c) { const int kk = (k & ~0xC) | ((k & 4) << 1) | ((k & 8) >> 1); return ((kk >> 3) * 4 + (c >> 5)) * 512 + ((kk & 7) * 32 + (c & 31)) * 2; }
__device__ __forceinline__ int v_rd_base(int lane) { return ((lane & 3) << 3) | (((lane >> 2) & 3) << 6) | (((lane >> 4) & 1) << 5) | (((lane >> 5) & 1) << 8); }
constexpr int v_rd_off(int d0, int ks, int half) { return d0 * 512 + ks * 4096 + half * 2048; }
template <int OFF> __device__ __forceinline__ s16x4 tr_read(int vb) {
  s16x4 r; asm volatile("ds_read_b64_tr_b16 %0, %1 offset:%2" : "=&v"(r) : "v"(vb), "i"(OFF) : "memory"); return r;
}
template <int D0> __device__ __forceinline__ void pv_one(f32x16& od, int vb, bf16x8 pa0, bf16x8 pa1, bf16x8 pa2, bf16x8 pa3) {
  const s16x4 l0 = tr_read<v_rd_off(D0, 0, 0)>(vb), h0 = tr_read<v_rd_off(D0, 0, 1)>(vb), l1 = tr_read<v_rd_off(D0, 1, 0)>(vb), h1 = tr_read<v_rd_off(D0, 1, 1)>(vb);
  const s16x4 l2 = tr_read<v_rd_off(D0, 2, 0)>(vb), h2 = tr_read<v_rd_off(D0, 2, 1)>(vb), l3 = tr_read<v_rd_off(D0, 3, 0)>(vb), h3 = tr_read<v_rd_off(D0, 3, 1)>(vb);
  asm volatile("s_waitcnt lgkmcnt(0)" ::: "memory"); SBAR();
#define PK(L, H) (bf16x8){L[0], L[1], L[2], L[3], H[0], H[1], H[2], H[3]}
  od = mma32_act(pa0, PK(l0, h0), od);
  od = mma32_act(pa1, PK(l1, h1), od);
  od = mma32_act(pa2, PK(l2, h2), od);
  od = mma32_act(pa3, PK(l3, h3), od);
#undef PK
}
__device__ __forceinline__ void pv_d0(f32x16* o, int vb, bf16x8 pa0, bf16x8 pa1, bf16x8 pa2, bf16x8 pa3) {
  pv_one<0>(o[0], vb, pa0, pa1, pa2, pa3); pv_one<1>(o[1], vb, pa0, pa1, pa2, pa3); pv_one<2>(o[2], vb, pa0, pa1, pa2, pa3); pv_one<3>(o[3], vb, pa0, pa1, pa2, pa3);
}

__device__ __forceinline__ void attn_dense_body(const bf16* __restrict__ Qb, const bf16* __restrict__ Kh, const bf16* __restrict__ Vh,
                                                bf16* __restrict__ Ob, int seq, LAS char* lds) {
  const int tid = opaque_tid(), wid = tid >> 6, lane = tid & 63, r32 = lane & 31, hi = lane >> 5;
  LAS char* V_lds = lds; LAS char* K_lds = lds + 2 * SHM_V;
  LAS float* ws = (LAS float*)(lds + 2 * SHM_V + 2 * SHM_K) + wid * 64; LAS float* li_l = ws; LAS float* al_l = ws + 32;
  float m_reg = -1e30f, l_reg = 0; f32x16 o[4] = {}; bf16x8 qr[8];
  { const bf16* Qw = Qb + (long)(wid * QBLK + r32) * LDQ + hi * 8;
#pragma unroll
    for (int d0 = 0; d0 < 8; ++d0) qr[d0] = *reinterpret_cast<const bf16x8*>(Qw + d0 * 16); }
  const int sr = tid >> 4, sc = (tid & 15) * 8, vst0 = v_st(sr, sc), vst1 = v_st(32 + sr, sc);
  const int vb0 = (int)(unsigned)(uintptr_t)V_lds + v_rd_base(lane);
  struct { bf16x8 vs0, vs1, ks0, ks1; } sr_[2];
#define SLOAD(i, k0) do { sr_[i].vs0 = *reinterpret_cast<const bf16x8*>(&Vh[(long)((k0) + sr) * LDK + sc]); sr_[i].vs1 = *reinterpret_cast<const bf16x8*>(&Vh[(long)((k0) + 32 + sr) * LDK + sc]); \
    sr_[i].ks0 = *reinterpret_cast<const bf16x8*>(&Kh[(long)((k0) + sr) * LDK + sc]); sr_[i].ks1 = *reinterpret_cast<const bf16x8*>(&Kh[(long)((k0) + 32 + sr) * LDK + sc]); } while (0)
#define SWRITE(b, i) do { *(LAS bf16x8*)(V_lds + (b) * SHM_V + vst0) = sr_[i].vs0;          \
    *(LAS bf16x8*)(V_lds + (b) * SHM_V + vst1) = sr_[i].vs1; int kc = sc * 2;               \
    *(LAS bf16x8*)(K_lds + (b) * SHM_K + KSWZ(sr, kc)) = sr_[i].ks0;                       \
    *(LAS bf16x8*)(K_lds + (b) * SHM_K + KSWZ(32 + sr, kc)) = sr_[i].ks1; } while (0)
#define SWAIT() asm volatile("s_waitcnt vmcnt(4)" ::: "memory")
#define RESC(a) do { if (__any((a) < 1.f)) { if (hi == 0) al_l[r32] = (a); asm volatile("s_waitcnt lgkmcnt(0)" ::: "memory"); \
    _Pragma("unroll") for (int d = 0; d < 4; ++d) _Pragma("unroll") for (int r = 0; r < 16; ++r) o[d][r] *= al_l[crow(r, hi)]; } } while (0)
  f32x16 pA0, pA1, pB0, pB1; float mnA, mnB, alA, alB; bf16x8 pa0, pa1, pa2, pa3; const int NT = seq / KVBLK;
  constexpr int SE = 0, SO = 1;
  SLOAD(SE, 0); asm volatile("s_waitcnt vmcnt(0)" ::: "memory"); SWRITE(0, SE); __syncthreads();
  qkt(pA0, pA1, K_lds, qr, r32, hi); partialSM(pA0, pA1, m_reg, mnA, alA);
  SLOAD(SO, KVBLK); if (2 < NT) SLOAD(SE, 2 * KVBLK);
  SWAIT(); SWRITE(1, SO); __syncthreads();
  for (int j = 1; j + 1 < NT; j += 2) {
    SBAR(); qkt(pB0, pB1, K_lds + SHM_K, qr, r32, hi);
    finishSM(pA0, pA1, alA, l_reg, pa0, pa1, pa2, pa3); SBAR();
    SLOAD(SO, (j + 2) * KVBLK); SBAR();
    pv_d0(o, vb0, pa0, pa1, pa2, pa3); partialSM(pB0, pB1, m_reg, mnB, alB);
    __syncthreads(); SWAIT(); SWRITE(0, SE);
    RESC(alB); __syncthreads();
    SBAR(); qkt(pA0, pA1, K_lds, qr, r32, hi);
    finishSM(pB0, pB1, alB, l_reg, pa0, pa1, pa2, pa3); SBAR();
    if (j + 3 < NT) SLOAD(SE, (j + 3) * KVBLK); SBAR();
    pv_d0(o, vb0 + (int)SHM_V, pa0, pa1, pa2, pa3); partialSM(pA0, pA1, m_reg, mnA, alA);
    __syncthreads(); SWAIT(); SWRITE(1, SO);
    RESC(alA); __syncthreads();
  }
  SBAR(); qkt(pB0, pB1, K_lds + SHM_K, qr, r32, hi);
  finishSM(pA0, pA1, alA, l_reg, pa0, pa1, pa2, pa3); SBAR();
  pv_d0(o, vb0, pa0, pa1, pa2, pa3); partialSM(pB0, pB1, m_reg, mnB, alB);
  __syncthreads(); RESC(alB);
  finishSM(pB0, pB1, alB, l_reg, pa0, pa1, pa2, pa3); SBAR();
  pv_d0(o, vb0 + (int)SHM_V, pa0, pa1, pa2, pa3);
  if (hi == 0) li_l[r32] = l_reg; asm volatile("s_waitcnt lgkmcnt(0)" ::: "memory");
  float rli[16];
#pragma unroll
  for (int r = 0; r < 16; ++r) rli[r] = __builtin_amdgcn_rcpf(li_l[crow(r, hi)]);
  bf16* Ow = Ob + (long)(wid * QBLK) * LDO;
#pragma unroll
  for (int r = 0; r < 16; ++r) { int orow = crow(r, hi);
#pragma unroll
    for (int d0 = 0; d0 < 4; ++d0) Ow[(long)orow * LDO + d0 * 32 + r32] = f2act(o[d0][r] * rli[r]); }
  __syncthreads();
#undef SLOAD
#undef SWRITE
#undef SWAIT
#undef RESC
}
#undef KSWZ
#undef SBAR
}

namespace gla {
constexpr int L_LA = 0;
constexpr int L_TOT = L_LA + 64 * 132 * 4;
constexpr int L_WG = L_TOT + 2048;
constexpr int L_BG = L_WG + 8192;
constexpr int L_QE = L_BG + 512;
constexpr int L_KE = L_QE + 64 * 136 * 2;
constexpr int L_KLT = L_KE + 64 * 136 * 2;
constexpr int L_ATT = L_KLT + 128 * 72 * 2;
constexpr int L_END1 = L_ATT + 64 * 72 * 2;
constexpr int M_QE = 0, M_ATT = M_QE + 64 * 272, M_KLT = M_ATT + 64 * 144, M_VT = M_KLT + 128 * 144, M_SB = M_VT + 64 * 144, M_EB = M_SB + 64 * 272, M_BUF = M_EB + 512;
static_assert(L_END1 <= MISC_OFF && 2 * M_BUF <= MISC_OFF, "GLA LDS map");
constexpr size_t GW_QE_SZ = 64 * 128, GW_ATT_SZ = 64 * 64, GW_KLT_SZ = 128 * 64, GW_EB_SZ = 128;
constexpr int G1_ITEMS = (NTOK / 64) * 4 * 2;

__device__ __forceinline__ float log_sigmoid(float x) { return fminf(x, 0.f) - __logf(1.f + __expf(-fabsf(x))); }
__device__ __forceinline__ f32x4 mma16(bf16x8 a, bf16x8 b, f32x4 c) { return __builtin_amdgcn_mfma_f32_16x16x32_bf16(a, b, c, 0, 0, 0); }

__device__ __forceinline__ void g1_item(LAS unsigned char* lds, const bf16* __restrict__ Z, const float* __restrict__ wg, const float* __restrict__ bg,
                                        bf16* __restrict__ gQE, bf16* __restrict__ gATT, bf16* __restrict__ gKLT, float* __restrict__ gEB, int row0, int h, int dir) {
    const int tid = opaque_tid(), lane = tid & 63, w = __builtin_amdgcn_readfirstlane(tid >> 6), fr = lane & 15, fq = lane >> 4;
    LAS float* LA = (LAS float*)(lds + L_LA); LAS float* TOT = (LAS float*)(lds + L_TOT);
    LAS float* WG = (LAS float*)(lds + L_WG); LAS float* BG = (LAS float*)(lds + L_BG);
    LAS unsigned char* QE = lds + L_QE; LAS unsigned char* KE = lds + L_KE; LAS unsigned char* KLT = lds + L_KLT; LAS unsigned char* ATT = lds + L_ATT;
    for (int idx = tid; idx < 16 * 128; idx += 512) WG[idx] = wg[(idx >> 7) * 512 + (idx & 127)];
    if (tid < 128) BG[tid] = bg[tid];
    const int i0 = tid >> 4, g8 = tid & 15;
    const int gacol = dir ? ZGAB : ZGAF;
    u32x4 rq[2], rk[2], rga[2][2];
#pragma unroll
    for (int e = 0; e < 2; ++e) { const int i = i0 + 32 * e; const bf16* zr = Z + (size_t)(row0 + (dir ? 63 - i : i)) * NZ;
        rq[e] = *(const u32x4*)(zr + ZGQ + h * 128 + g8 * 8); rk[e] = *(const u32x4*)(zr + ZGK + h * 128 + g8 * 8);
        rga[e][0] = *(const u32x4*)(zr + gacol); rga[e][1] = *(const u32x4*)(zr + gacol + 8); }
    __syncthreads();
#pragma unroll
    for (int e = 0; e < 2; ++e) {
        float x[8];
        { const f32x4 b0 = *(const LAS f32x4*)(BG + g8 * 8), b1 = *(const LAS f32x4*)(BG + g8 * 8 + 4);
#pragma unroll
          for (int j = 0; j < 4; ++j) { x[j] = b0[j]; x[4 + j] = b1[j]; } }
#pragma unroll
        for (int r = 0; r < 16; ++r) { const unsigned wd = rga[e][r >> 3][(r & 7) >> 1]; const float gar = (r & 1) ? hi_act(wd) : lo_act(wd);
            const f32x4 w0 = *(const LAS f32x4*)(WG + r * 128 + g8 * 8), w1 = *(const LAS f32x4*)(WG + r * 128 + g8 * 8 + 4);
#pragma unroll
            for (int j = 0; j < 4; ++j) { x[j] = fmaf(gar, w0[j], x[j]); x[4 + j] = fmaf(gar, w1[j], x[4 + j]); }
            if ((r & 3) == 3) asm volatile("" ::: "memory"); }
        f32x4 o0, o1;
#pragma unroll
        for (int j = 0; j < 4; ++j) { o0[j] = log_sigmoid(x[j]) * 0.0625f; o1[j] = log_sigmoid(x[4 + j]) * 0.0625f; }
        *(LAS f32x4*)(LA + (i0 + 32 * e) * 132 + g8 * 8) = o0; *(LAS f32x4*)(LA + (i0 + 32 * e) * 132 + g8 * 8 + 4) = o1;
    }
    __syncthreads();
    { const int d = tid & 127, seg = tid >> 7; float v[16];
#pragma unroll
      for (int ii = 0; ii < 16; ++ii) v[ii] = LA[(seg * 16 + ii) * 132 + d];
      float run = 0.f;
#pragma unroll
      for (int ii = 0; ii < 16; ++ii) { run += v[ii]; LA[(seg * 16 + ii) * 132 + d] = run; }
      TOT[seg * 128 + d] = run; }
    __syncthreads();
    {
        float t0[8], t1[8], t2[8], t3[8];
        { const f32x4 a0 = *(const LAS f32x4*)(TOT + g8 * 8), a1 = *(const LAS f32x4*)(TOT + g8 * 8 + 4), b0 = *(const LAS f32x4*)(TOT + 128 + g8 * 8), b1 = *(const LAS f32x4*)(TOT + 128 + g8 * 8 + 4);
          const f32x4 c0 = *(const LAS f32x4*)(TOT + 256 + g8 * 8), c1 = *(const LAS f32x4*)(TOT + 256 + g8 * 8 + 4), d0 = *(const LAS f32x4*)(TOT + 384 + g8 * 8), d1 = *(const LAS f32x4*)(TOT + 384 + g8 * 8 + 4);
#pragma unroll
          for (int j = 0; j < 4; ++j) { t0[j] = a0[j]; t0[4 + j] = a1[j]; t1[j] = b0[j]; t1[4 + j] = b1[j]; t2[j] = c0[j]; t2[4 + j] = c1[j]; t3[j] = d0[j]; t3[4 + j] = d1[j]; } }
        float blast[8];
#pragma unroll
        for (int j = 0; j < 8; ++j) blast[j] = (t0[j] + t1[j]) + (t2[j] + t3[j]);
        if (tid < 16) { f32x4 e0, e1;
#pragma unroll
            for (int j = 0; j < 4; ++j) { e0[j] = __expf(blast[j]); e1[j] = __expf(blast[4 + j]); }
            *(f32x4*)(gEB + g8 * 8) = e0; *(f32x4*)(gEB + g8 * 8 + 4) = e1; }
#pragma unroll
        for (int e = 0; e < 2; ++e) {
            const int i = i0 + 32 * e, seg = i >> 4;
            const f32x4 l0 = *(const LAS f32x4*)(LA + i * 132 + g8 * 8), l1 = *(const LAS f32x4*)(LA + i * 132 + g8 * 8 + 4);
            float bq[8], kl[8], qe[8], ke[8], qv[8], kv[8];
#pragma unroll
            for (int q = 0; q < 4; ++q) { qv[2 * q] = lo_act(rq[e][q]); qv[2 * q + 1] = hi_act(rq[e][q]); kv[2 * q] = lo_act(rk[e][q]); kv[2 * q + 1] = hi_act(rk[e][q]); }
#pragma unroll
            for (int j = 0; j < 8; ++j) { float off = 0.f; if (seg > 0) off += t0[j]; if (seg > 1) off += t1[j]; if (seg > 2) off += t2[j];
                bq[j] = (j < 4 ? l0[j] : l1[j - 4]) + off;
                qe[j] = qv[j] * 0.088388347648318440f * __expf(bq[j]); ke[j] = kv[j] * __expf(-bq[j]); kl[j] = kv[j] * __expf(blast[j] - bq[j]); }
            const u32x4 wq = {cvt_pk_bf16(qe[0], qe[1]), cvt_pk_bf16(qe[2], qe[3]), cvt_pk_bf16(qe[4], qe[5]), cvt_pk_bf16(qe[6], qe[7])};
            const u32x4 wk = {cvt_pk_bf16(ke[0], ke[1]), cvt_pk_bf16(ke[2], ke[3]), cvt_pk_bf16(ke[4], ke[5]), cvt_pk_bf16(ke[6], ke[7])};
            *(LAS u32x4*)(QE + i * 272 + g8 * 16) = wq; *(LAS u32x4*)(KE + i * 272 + g8 * 16) = wk;
            *(u32x4*)(gQE + i * 128 + g8 * 8) = wq;
#pragma unroll
            for (int j = 0; j < 8; ++j) *(LAS bf16*)(KLT + (g8 * 8 + j) * 144 + i * 2) = f2bf(kl[j]);
        }
    }
    __syncthreads();
    { const int ti = w >> 1;
#pragma unroll
      for (int jj = 0; jj < 2; ++jj) { const int tj = (w & 1) * 2 + jj; f32x4 a = {0.f, 0.f, 0.f, 0.f};
          if (tj <= ti) {
#pragma unroll
              for (int ks = 0; ks < 4; ++ks) { const bf16x8 af = *(const LAS bf16x8*)(QE + (ti * 16 + fr) * 272 + (ks * 32 + fq * 8) * 2), bfr = *(const LAS bf16x8*)(KE + (tj * 16 + fr) * 272 + (ks * 32 + fq * 8) * 2);
                  a = mma16(af, bfr, a); } }
#pragma unroll
          for (int r = 0; r < 4; ++r) { const int i = ti * 16 + 4 * fq + r, j = tj * 16 + fr; *(LAS bf16*)(ATT + i * 144 + j * 2) = f2bf(j <= i ? a[r] : 0.f); } } }
#pragma unroll
    for (int e = 0; e < 2; ++e) { const int p = tid + 512 * e, row = p >> 3, c8 = p & 7; *(u32x4*)(gKLT + row * 64 + c8 * 8) = *(const LAS u32x4*)(KLT + row * 144 + c8 * 16); }
    __syncthreads();
    { const int row = tid >> 3, c8 = tid & 7; *(u32x4*)(gATT + row * 64 + c8 * 8) = *(const LAS u32x4*)(ATT + row * 144 + c8 * 16); }
    __syncthreads();
}

__device__ __forceinline__ void g2_item(LAS unsigned char* lds, const bf16* __restrict__ Z, float* __restrict__ OUT, const bf16* __restrict__ gQE, const bf16* __restrict__ gATT,
                                        const bf16* __restrict__ gKLT, const float* __restrict__ gEB, const float* __restrict__ st_in, float* __restrict__ st_out,
                                        int T, int tokbase, int h, int dir, int dvq) {
    const int tid = opaque_tid(), lane = tid & 63, w = __builtin_amdgcn_readfirstlane(tid >> 6), fr = lane & 15, fq = lane >> 4;
    const int NC = T >> 6;
    f32x4 S[4];
    const int soff = (16 * w + 4 * fq) * 256 + dvq * 64 + fr;
#pragma unroll
    for (int n = 0; n < 4; ++n) S[n] = (f32x4){0.f, 0.f, 0.f, 0.f};
    if (st_in) {
#pragma unroll
        for (int n = 0; n < 4; ++n)
#pragma unroll
            for (int r = 0; r < 4; ++r) S[n][r] = st_in[soff + r * 256 + n * 16];
    }
    const int iv = tid >> 3, vg = tid & 7;
    u32x4 pq[2], pk[2], pa, pv; float peb = 0.f;
#define G2_LOAD(cs) do { const int cf_ = dir ? NC - 1 - (cs) : (cs); const size_t gi_ = ((size_t)((tokbase >> 6) + cf_) * 4 + h) * 2 + dir; \
        const bf16* q_ = gQE + gi_ * GW_QE_SZ; const bf16* k_ = gKLT + gi_ * GW_KLT_SZ; \
        pq[0] = *(const u32x4*)(q_ + tid * 8); pq[1] = *(const u32x4*)(q_ + (tid + 512) * 8); pk[0] = *(const u32x4*)(k_ + tid * 8); pk[1] = *(const u32x4*)(k_ + (tid + 512) * 8); \
        pa = *(const u32x4*)(gATT + gi_ * GW_ATT_SZ + tid * 8); if (tid < 128) peb = gEB[gi_ * GW_EB_SZ + tid]; \
        pv = *(const u32x4*)(Z + (size_t)(tokbase + cf_ * 64 + (dir ? 63 - iv : iv)) * NZ + ZGV + h * 256 + dvq * 64 + vg * 8); } while (0)
    G2_LOAD(0);
    for (int cs = 0; cs < NC; ++cs) {
        LAS unsigned char* B = lds + (cs & 1) * M_BUF;
#pragma unroll
        for (int e = 0; e < 2; ++e) { const int p = tid + 512 * e; *(LAS u32x4*)(B + M_QE + (p >> 4) * 272 + (p & 15) * 16) = pq[e]; *(LAS u32x4*)(B + M_KLT + (p >> 3) * 144 + (p & 7) * 16) = pk[e]; }
        *(LAS u32x4*)(B + M_ATT + iv * 144 + vg * 16) = pa;
        if (tid < 128) *(LAS float*)(B + M_EB + tid * 4) = peb;
#pragma unroll
        for (int q = 0; q < 4; ++q) { *(LAS bf16*)(B + M_VT + (vg * 8 + 2 * q) * 144 + iv * 2) = f2bf(lo_act(pv[q])); *(LAS bf16*)(B + M_VT + (vg * 8 + 2 * q + 1) * 144 + iv * 2) = f2bf(hi_act(pv[q])); }
#pragma unroll
        for (int n = 0; n < 4; ++n) { const u32x2 ws2 = {cvt_pk_bf16(S[n][0], S[n][1]), cvt_pk_bf16(S[n][2], S[n][3])}; *(LAS u32x2*)(B + M_SB + (n * 16 + fr) * 272 + (16 * w + 4 * fq) * 2) = ws2; }
        if (cs + 1 < NC) G2_LOAD(cs + 1);
        __syncthreads();
        { const int ti = w >> 1; const int cf = dir ? NC - 1 - cs : cs;
#pragma unroll
          for (int jj = 0; jj < 2; ++jj) { const int tn = (w & 1) * 2 + jj; f32x4 a = {0.f, 0.f, 0.f, 0.f};
#pragma unroll
              for (int ks = 0; ks < 4; ++ks) { const bf16x8 af = *(const LAS bf16x8*)(B + M_QE + (ti * 16 + fr) * 272 + (ks * 32 + fq * 8) * 2), bfr = *(const LAS bf16x8*)(B + M_SB + (tn * 16 + fr) * 272 + (ks * 32 + fq * 8) * 2);
                  a = mma16(af, bfr, a); }
#pragma unroll
              for (int ks = 0; ks < 2; ++ks) { const bf16x8 af = *(const LAS bf16x8*)(B + M_ATT + (ti * 16 + fr) * 144 + (ks * 32 + fq * 8) * 2), bfr = *(const LAS bf16x8*)(B + M_VT + (tn * 16 + fr) * 144 + (ks * 32 + fq * 8) * 2);
                  a = mma16(af, bfr, a); }
#pragma unroll
              for (int r = 0; r < 4; ++r) { const int i = ti * 16 + 4 * fq + r; OUT[(size_t)(tokbase + cf * 64 + (dir ? 63 - i : i)) * 1024 + h * 256 + dvq * 64 + tn * 16 + fr] = a[r]; } } }
        { const f32x4 eb = *(const LAS f32x4*)(B + M_EB + (16 * w + 4 * fq) * 4);
#pragma unroll
          for (int n = 0; n < 4; ++n) { S[n] = S[n] * eb;
#pragma unroll
              for (int ks = 0; ks < 2; ++ks) { const bf16x8 af = *(const LAS bf16x8*)(B + M_KLT + (16 * w + fr) * 144 + (ks * 32 + fq * 8) * 2), bfr = *(const LAS bf16x8*)(B + M_VT + (n * 16 + fr) * 144 + (ks * 32 + fq * 8) * 2);
                  S[n] = mma16(af, bfr, S[n]); } } }
    }
    if (st_out) {
        int fr2 = fr; asm volatile("" : "+v"(fr2));
        const int soff2 = (16 * w + 4 * fq) * 256 + dvq * 64 + fr2;
#pragma unroll
        for (int n = 0; n < 4; ++n)
#pragma unroll
            for (int r = 0; r < 4; ++r) st_out[soff2 + r * 256 + n * 16] = S[n][r];
    }
    __syncthreads();
#undef G2_LOAD
}
}

#define XB_TMO      128
#define XB_XCNT(j)  (256  + 64 * (j))
#define XB_XSUB(j)  (1280 + 64 * (j))
#define XB_XGEN(j)  (2304 + 64 * (j))
#define XB_TOP      3328
#define XB_TOPGEN   3392
#define XCD_BAR_WORDS 3456
#define XB_SPIN_CAP (1u << 18)
__device__ __forceinline__ unsigned xb_ld(unsigned* p)              { return __hip_atomic_load(p, __ATOMIC_RELAXED, __HIP_MEMORY_SCOPE_AGENT); }
__device__ __forceinline__ unsigned xb_add(unsigned* p, unsigned v) { return __hip_atomic_fetch_add(p, v, __ATOMIC_RELAXED, __HIP_MEMORY_SCOPE_AGENT); }
__device__ __forceinline__ unsigned xb_xcc_id() { return (unsigned)__builtin_amdgcn_s_getreg((3 << 11) | 20) & 0xFu; }
#define XB_SPIN(cond, bar) do { unsigned _sp = 0; while (cond) { __builtin_amdgcn_s_sleep(1); \
    if ((++_sp & 255u) == 0u) { if (xb_ld(&(bar)[XB_TMO])) break; if (_sp > XB_SPIN_CAP) { atomicAdd(&(bar)[XB_TMO], 1u); break; } } } } while (0)
struct XcdBarrier { unsigned* bar; unsigned x; volatile LAS unsigned* st; };
__device__ __forceinline__ XcdBarrier xcd_barrier_post(unsigned* bar, volatile LAS unsigned* st) {
    XcdBarrier b; b.bar = bar; b.x = xb_xcc_id(); b.st = st;
    if (threadIdx.x == 0) (void)xb_add(&bar[XB_XCNT(b.x)], 1u);
    return b;
}
__device__ __forceinline__ void xcd_barrier_complete(unsigned* bar, unsigned x, unsigned& nloc, unsigned& nx) {
    const unsigned G = gridDim.x * gridDim.y * gridDim.z;
    unsigned sum, cnt, mine, sp = 0u;
    for (;;) {
        sum = 0u; cnt = 0u; mine = 0u;
#pragma unroll
        for (unsigned j = 0; j < 16; ++j) { const unsigned c = xb_ld(&bar[XB_XCNT(j)]); sum += c; cnt += (c > 0u) ? 1u : 0u; mine = (j == x) ? c : mine; }
        if (sum == G) break;
        __builtin_amdgcn_s_sleep(1);
        if ((++sp & 255u) == 0u) { if (xb_ld(&bar[XB_TMO])) break; if (sp > XB_SPIN_CAP) { atomicAdd(&bar[XB_TMO], 1u); break; } }
    }
    nloc = mine > 0u ? mine : 1u; nx = cnt > 0u ? cnt : 1u;
}
__device__ __forceinline__ void xcd_barrier(const XcdBarrier& b) {
    asm volatile("s_waitcnt vmcnt(0)" ::: "memory");
    __syncthreads();
    if (threadIdx.x == 0) {
        unsigned* bar = b.bar;
        __builtin_amdgcn_s_waitcnt(0);
        unsigned nloc = b.st[0], nx = b.st[1];
        if (nloc == 0u) { xcd_barrier_complete(bar, b.x, nloc, nx); b.st[0] = nloc; b.st[1] = nx; }
        const unsigned old = xb_add(&bar[XB_XSUB(b.x)], 1u);
        const unsigned gen = old / nloc;
        if (old + 1u == (gen + 1u) * nloc) {
            __builtin_amdgcn_fence(__ATOMIC_RELEASE, "agent");
            asm volatile("s_waitcnt vmcnt(0)" ::: "memory");
            const unsigned og = xb_add(&bar[XB_TOP], 1u);
            const unsigned tg = og / nx;
            if (og + 1u == (tg + 1u) * nx) xb_add(&bar[XB_TOPGEN], 1u);
            else XB_SPIN(xb_ld(&bar[XB_TOPGEN]) == tg, bar);
            __builtin_amdgcn_fence(__ATOMIC_ACQUIRE, "agent");
            xb_add(&bar[XB_XGEN(b.x)], 1u);
            asm volatile("s_waitcnt vmcnt(0)" ::: "memory");
        } else {
            XB_SPIN(xb_ld(&bar[XB_XGEN(b.x)]) == gen, bar);
            __builtin_amdgcn_fence(__ATOMIC_ACQUIRE, "agent");
            asm volatile("s_waitcnt vmcnt(0)" ::: "memory");
        }
    }
    __syncthreads();
}

struct Args {
    const float *x_prompt, *x_sample, *cache_k, *cache_v, *state_f, *state_b, *cvec, *c_ctx, *w_ada, *b_ada, *norm1, *w_in, *q_norm, *k_norm, *w_fourier, *w_attn,
                *w_gate_f, *b_gate_f, *w_gate_b, *b_gate_b, *gla_norm, *w_gla, *w_out, *norm2, *w_up, *conv_w, *conv_b, *w_down, *final_norm;
    float* out; unsigned char* ws;
    int s_lo, s_hi, li, pad;
};
constexpr size_t OUT_YP = 0, OUT_YS = (size_t)NCTX * DM, OUT_CK = (size_t)NTOK * DM, OUT_CV = OUT_CK + (size_t)BCTX * DEPTH * TC * 256,
                 OUT_SF = OUT_CV + (size_t)BCTX * DEPTH * TC * 256, OUT_SB = OUT_SF + (size_t)BCTX * DEPTH * 4 * 128 * 256, OUT_END = OUT_SB + (size_t)BCTX * DEPTH * 4 * 128 * 256;

struct Frame { LAS unsigned char* lds; int tid, lane, wave, G, bid; };
__device__ __forceinline__ Frame frame_now(LAS unsigned char* lds) {
    Frame F; F.lds = lds; F.tid = opaque_tid(); F.lane = F.tid & 63; F.wave = __builtin_amdgcn_readfirstlane(F.tid >> 6); F.G = gridDim.x; F.bid = blockIdx.x; return F; }

__device__ __forceinline__ void transpose_item(const float* __restrict__ W, int N, bf16* __restrict__ WT, int ldd, int koff, int kb, int nb, int row_shift_from, int row_shift, LAS unsigned char* scr, int lane) {
    const int k0 = kb * 128, n0 = nb * 32, c4 = lane & 7, kr = lane >> 3;
#pragma unroll 4
    for (int i = 0; i < 16; ++i) { const int k = 8 * i + kr; const f32x4 v = *(const f32x4*)(W + (size_t)(k0 + k) * N + n0 + 4 * c4);
#pragma unroll
        for (int j = 0; j < 4; ++j) *(LAS bf16*)(scr + (4 * c4 + j) * 272 + k * 2) = f2act(v[j]); }
    LDS_WAIT(); asm volatile("" ::: "memory");
    const int kc = lane & 15;
#pragma unroll
    for (int j = 0; j < 8; ++j) { const int n = (lane >> 4) + 4 * j; const u32x4 o = *(const LAS u32x4*)(scr + n * 272 + kc * 16);
        int row = n0 + n; if (row >= row_shift_from) row += row_shift;
        *(u32x4*)(WT + (size_t)row * ldd + koff + k0 + kc * 8) = o; }
    LDS_WAIT(); asm volatile("" ::: "memory");
}
constexpr int TI_IN = 16 * 369, TI_F = 8 * 64, TI_AT = 8 * 64, TI_GL = 8 * 64, TI_OUT = 16 * 64, TI_UP = 16 * 352, TI_DN = 44 * 64;
constexpr int TI_LAYER = TI_IN + TI_F + TI_AT + TI_GL + TI_OUT + TI_UP + TI_DN;

__device__ __forceinline__ void phase_prologue_a(LAS unsigned char* lds_, const Args& a) {
    const Frame F = frame_now(lds_);
    unsigned char* ws = a.ws;
    {
        LAS unsigned char* scr = F.lds + F.wave * 8704;
        const int gw = F.bid * NWAVES + F.wave, NGW = F.G * NWAVES;
        for (int it = gw; it < DEPTH * TI_LAYER; it += NGW) {
            const int l = it / TI_LAYER; int r = it - l * TI_LAYER;
            if (r < TI_IN) { transpose_item(a.w_in + (size_t)l * DM * N_IN, N_IN, (bf16*)(ws + WS_WIN + l * SZ_WIN), DM, 0, r / 369, r % 369, ZPAD, ZGATE - ZPAD, scr, F.lane); continue; } r -= TI_IN;
            if (r < TI_F) { transpose_item(a.w_fourier + (size_t)l * 1024 * DM, DM, (bf16*)(ws + WS_WFT + l * SZ_WFT), 1024, 0, r / 64, r % 64, 1 << 30, 0, scr, F.lane); continue; } r -= TI_F;
            if (r < TI_AT) { transpose_item(a.w_attn + (size_t)l * 1024 * DM, DM, (bf16*)(ws + WS_WMRG + l * SZ_WMRG), KMRG, 2048, r / 64, r % 64, 1 << 30, 0, scr, F.lane); continue; } r -= TI_AT;
            if (r < TI_GL) { transpose_item(a.w_gla + (size_t)l * 1024 * DM, DM, (bf16*)(ws + WS_WMRG + l * SZ_WMRG), KMRG, 3072, r / 64, r % 64, 1 << 30, 0, scr, F.lane); continue; } r -= TI_GL;
            if (r < TI_OUT) { transpose_item(a.w_out + (size_t)l * DM * DM, DM, (bf16*)(ws + WS_WOUT + l * SZ_WOUT), DM, 0, r / 64, r % 64, 1 << 30, 0, scr, F.lane); continue; } r -= TI_OUT;
            if (r < TI_UP) { transpose_item(a.w_up + (size_t)l * DM * NUP, NUP, (bf16*)(ws + WS_WUP + l * SZ_WUP), DM, 0, r / 352, r % 352, 1 << 30, 0, scr, F.lane); continue; } r -= TI_UP;
            transpose_item(a.w_down + (size_t)l * DFF * DM, DM, (bf16*)(ws + WS_WDN + l * SZ_WDN), DFF, 0, r / 64, r % 64, 1 << 30, 0, scr, F.lane);
        }
    }
    const size_t gt = (size_t)F.bid * 512 + F.tid, NGT = (size_t)F.G * 512;
    for (size_t i = gt; i < (size_t)DEPTH * (ZGATE - ZPAD) * DM / 8; i += NGT) { const size_t l = i / ((ZGATE - ZPAD) * DM / 8), r = i % ((ZGATE - ZPAD) * DM / 8);
        *(u32x4*)(ws + WS_WIN + l * SZ_WIN + (size_t)ZPAD * DM * 2 + r * 16) = (u32x4){0u, 0u, 0u, 0u}; }
    for (size_t i = gt; i < (size_t)2048 * 1024; i += NGT) {
        const int kp = (int)(i >> 10), j = (int)(i & 1023), cs = kp >> 10, g = (kp >> 7) & 7, c = kp & 127, g2 = j >> 7, jj = j & 127; float v = 0.f;
        if (g == g2) { const int m = (c * jj) & 127; const float ang = (float)m * (1.f / 128.f); v = (cs ? -sinpif(2.f * ang) : cospif(2.f * ang)) * 0.088388347648318440f; }
        ((bf16*)(ws + WS_DT))[i] = f2act(v); }
    for (size_t i = gt; i < (size_t)512 * 256; i += NGT) { const int kp = (int)(i >> 8), t = (int)(i & 255), cs = kp >> 8, k = kp & 255, m = (k * t) & 255; const float ang = (float)m * (1.f / 256.f);
        ((bf16*)(ws + WS_ACTX))[i] = f2act((cs ? sinpif(2.f * ang) : cospif(2.f * ang)) * 0.0625f); }
    for (size_t i = gt; i < (size_t)2048 * 1024; i += NGT) { const int kp = (int)(i >> 10), t = (int)(i & 1023), cs = kp >> 10, k = kp & 1023, m = (k * t) & 1023; const float ang = (float)m * (1.f / 1024.f);
        ((bf16*)(ws + WS_ALAT))[i] = f2act((cs ? sinpif(2.f * ang) : cospif(2.f * ang)) * 0.03125f); }
    __syncthreads();
    {
        LAS float* SC = (LAS float*)F.lds;
        for (int i = F.tid; i < NMODV * DM; i += 512) { const int j = i >> 11, k = i & 2047; const float cv = j == 0 ? a.c_ctx[k] : a.cvec[(j - 1) * DM + k]; SC[i] = siluf_(cv); }
        __syncthreads();
        float* MP = (float*)(ws + WS_MODP);
        for (int u = F.bid; u < DEPTH * 16 * 6; u += F.G) {
            const int l = u / 96, kc = (u % 96) / 6, nb = u % 6, n = nb * 2048 + F.tid * 4;
            f32x4 acc[NMODV];
#pragma unroll
            for (int j = 0; j < NMODV; ++j) acc[j] = (f32x4){0.f, 0.f, 0.f, 0.f};
            const float* wp = a.w_ada + ((size_t)l * DM + kc * 128) * NMOD + n;
#pragma unroll 8
            for (int k = 0; k < 128; ++k) { const f32x4 wv = *(const f32x4*)(wp + (size_t)k * NMOD);
#pragma unroll
                for (int j = 0; j < NMODV; ++j) acc[j] = acc[j] + wv * SC[j * DM + kc * 128 + k]; }
#pragma unroll
            for (int j = 0; j < NMODV; ++j) *(f32x4*)(MP + (((size_t)kc * DEPTH + l) * NMODV + j) * NMOD + n) = acc[j];
        }
        __syncthreads();
    }
}
__device__ __forceinline__ void phase_mod_reduce(LAS unsigned char* lds_, const Args& a) {
    const Frame F = frame_now(lds_);
    const float* MP = (const float*)(a.ws + WS_MODP); float* MOD = (float*)(a.ws + WS_MOD);
    for (size_t i = (size_t)F.bid * 512 + F.tid; i < (size_t)DEPTH * NMODV * NMOD / 4; i += (size_t)F.G * 512) {
        const size_t e = i * 4; const int n = (int)(e % NMOD), l = (int)(e / ((size_t)NMODV * NMOD));
        f32x4 s = *(const f32x4*)(a.b_ada + (size_t)l * NMOD + n);
#pragma unroll
        for (int kc = 0; kc < 16; ++kc) s = s + *(const f32x4*)(MP + (size_t)kc * DEPTH * NMODV * NMOD + e);
        *(f32x4*)(MOD + e) = s; }
}

__device__ __forceinline__ void phase_norm(LAS unsigned char* lds_, const Args& a, int l, int which, bool first) {
    const Frame F = frame_now(lds_);
    const float* MOD = (const float*)(a.ws + WS_MOD) + (size_t)l * NMODV * NMOD + (which ? 3 * DM : 0);
    const float* wn = (which ? a.norm2 : a.norm1) + (size_t)l * DM;
    float* X = (float*)(a.ws + WS_X); bf16* H = (bf16*)(a.ws + WS_H);
    const int gw = F.bid * NWAVES + F.wave, NGW = F.G * NWAVES;
    for (int r = gw; r < NTOK; r += NGW) {
        const float* src = first ? (r < NCTX ? a.x_prompt + (size_t)r * DM : a.x_sample + (size_t)(r - NCTX) * DM) : X + (size_t)r * DM;
        f32x4 v[8]; float ss = 0.f;
#pragma unroll
        for (int j = 0; j < 8; ++j) { v[j] = *(const f32x4*)(src + 4 * F.lane + 256 * j); ss += (v[j][0] * v[j][0] + v[j][1] * v[j][1]) + (v[j][2] * v[j][2] + v[j][3] * v[j][3]); }
        if (first) {
#pragma unroll
            for (int j = 0; j < 8; ++j) *(f32x4*)(X + (size_t)r * DM + 4 * F.lane + 256 * j) = v[j]; }
        const float rstd = rsqrtf(wave_sum(ss) * (1.f / DM) + EPS);
        const float* mr = MOD + (size_t)mod_row(r) * NMOD;
#pragma unroll
        for (int j = 0; j < 8; ++j) { const int c = 4 * F.lane + 256 * j; const f32x4 w4 = *(const f32x4*)(wn + c), sh = *(const f32x4*)(mr + c), sc = *(const f32x4*)(mr + DM + c);
            const f32x4 hval = v[j] * rstd * w4 * (sc + 1.f) + sh;
            u32x2 o = {pk_act(hval[0], hval[1]), pk_act(hval[2], hval[3])}; *(u32x2*)(H + (size_t)r * DM + c) = o; }
    }
}
__device__ __forceinline__ void phase_final_norm(LAS unsigned char* lds_, const Args& a) {
    const Frame F = frame_now(lds_);
    const float* X = (const float*)(a.ws + WS_X);
    const int gw = F.bid * NWAVES + F.wave, NGW = F.G * NWAVES;
    for (int r = gw; r < NTOK; r += NGW) {
        f32x4 v[8]; float ss = 0.f;
#pragma unroll
        for (int j = 0; j < 8; ++j) { v[j] = *(const f32x4*)(X + (size_t)r * DM + 4 * F.lane + 256 * j); ss += (v[j][0] * v[j][0] + v[j][1] * v[j][1]) + (v[j][2] * v[j][2] + v[j][3] * v[j][3]); }
        const float rstd = rsqrtf(wave_sum(ss) * (1.f / DM) + EPS);
#pragma unroll
        for (int j = 0; j < 8; ++j) { const int c = 4 * F.lane + 256 * j; f32x4 yv = v[j] * rstd * *(const f32x4*)(a.final_norm + c);
#ifdef MK_PROBE_NOISE
            { const unsigned hsh = ((unsigned)r * 2654435761u) ^ ((unsigned)c * 40503u); const float dn = 0.03f;
              yv[0] += (hsh & 1u) ? dn : -dn; yv[1] += (hsh & 2u) ? dn : -dn; yv[2] += (hsh & 4u) ? dn : -dn; yv[3] += (hsh & 8u) ? dn : -dn; }
#endif
            *(f32x4*)(a.out + OUT_YP + (size_t)r * DM + c) = yv; }
    }
}

__device__ __forceinline__ void phase_prep(LAS unsigned char* lds_, const Args& a, int l) {
    const Frame F = frame_now(lds_);
    const bf16* Z = (const bf16*)(a.ws + WS_Z);
    bf16* KC = (bf16*)(a.ws + WS_KC); bf16* VC = (bf16*)(a.ws + WS_VC); bf16* KL = (bf16*)(a.ws + WS_KL); bf16* VL = (bf16*)(a.ws + WS_VL);
    const int gw = F.bid * NWAVES + F.wave, NGW = F.G * NWAVES, lane = F.lane;
    LAS bf16* tile = (LAS bf16*)(F.lds + F.wave * 8448);
    for (int it = gw; it < NTOK + 1024 + 2048; it += NGW) {
        if (it < NTOK) {
            const int r = it, hh = lane >> 5, i = lane & 31; const bf16* zr = Z + (size_t)r * NZ;
            float kx[4]; float ss = 0.f;
#pragma unroll
            for (int q = 0; q < 4; ++q) { kx[q] = act2f(zr[ZK + hh * 128 + i + 32 * q]); ss += kx[q] * kx[q]; }
            ss = half_sum(ss);
            const float rstd = rsqrtf(ss * (1.f / 128.f) + EPS);
#pragma unroll
            for (int q = 0; q < 4; ++q) kx[q] *= rstd * a.k_norm[l * 128 + i + 32 * q];
            const u32x2 vv = *(const u32x2*)(zr + ZV + 4 * lane);
            {
                bf16* qo = (bf16*)(a.ws + WS_QN) + (size_t)r * 1024;
                const bool lat = r >= NCTX; const int tq = (r - NCTX) & 1023; const float prow = (float)(tq >> 6), pcol = (float)(tq & 63);
                const float inv = exp2f(-(float)i * 0.41524101186092029f);
                float sr = 0.f, cr = 1.f, sc2 = 0.f, cc2 = 1.f;
                if (lat) { sr = __sinf(prow * inv); cr = __cosf(prow * inv); sc2 = __sinf(pcol * inv); cc2 = __cosf(pcol * inv); }
                float qg[4];
#pragma unroll
                for (int q = 0; q < 4; ++q) qg[q] = a.q_norm[l * 128 + i + 32 * q];
#pragma unroll
                for (int hp = 0; hp < 4; ++hp) { const int hd = 2 * hp + hh; float qx[4]; float s2 = 0.f;
#pragma unroll
                    for (int q = 0; q < 4; ++q) { qx[q] = act2f(zr[ZQ + hd * 128 + i + 32 * q]); s2 += qx[q] * qx[q]; }
                    s2 = half_sum(s2);
                    const float rs = rsqrtf(s2 * (1.f / 128.f) + EPS);
#pragma unroll
                    for (int q = 0; q < 4; ++q) qx[q] *= rs * qg[q];
                    const float y0 = qx[0] * cr - qx[1] * sr, y1 = qx[1] * cr + qx[0] * sr, y2 = qx[2] * cc2 - qx[3] * sc2, y3 = qx[3] * cc2 + qx[2] * sc2;
                    qo[hd * 128 + i] = f2act(y0); qo[hd * 128 + i + 32] = f2act(y1); qo[hd * 128 + i + 64] = f2act(y2); qo[hd * 128 + i + 96] = f2act(y3); }
            }
            if (r < NCTX) {
                const int b = r >> 8, t = r & 255; const size_t oo = ((size_t)(b * DEPTH + l) * TC + t) * 256;
#pragma unroll
                for (int q = 0; q < 4; ++q) { KC[(size_t)r * 256 + hh * 128 + i + 32 * q] = f2act(kx[q]); a.out[OUT_CK + oo + hh * 128 + i + 32 * q] = kx[q]; }
                *(u32x2*)(VC + (size_t)r * 256 + 4 * lane) = vv;
                *(f32x4*)(a.out + OUT_CV + oo + 4 * lane) = (f32x4){lo_act(vv[0]), hi_act(vv[0]), lo_act(vv[1]), hi_act(vv[1])};
            } else {
                const int rr = r - NCTX, b = rr >> 10, t = rr & 1023; const float prow = (float)(t >> 6), pcol = (float)(t & 63);
                const float inv = exp2f(-(float)i * 0.41524101186092029f);
                { const float s = __sinf(prow * inv), c = __cosf(prow * inv), x1 = kx[0], x2 = kx[1]; kx[0] = x1 * c - x2 * s; kx[1] = x2 * c + x1 * s; }
                { const float s = __sinf(pcol * inv), c = __cosf(pcol * inv), x1 = kx[2], x2 = kx[3]; kx[2] = x1 * c - x2 * s; kx[3] = x2 * c + x1 * s; }
                const size_t ko = ((size_t)b * 1280 + 256 + t) * 256;
#pragma unroll
                for (int q = 0; q < 4; ++q) KL[ko + hh * 128 + i + 32 * q] = f2act(kx[q]);
                *(u32x2*)(VL + ko + 4 * lane) = vv;
            }
        } else if (it < NTOK + 1024) {
            const int rr = it - NTOK, b = rr >> 8, s = rr & 255; const size_t so = ((size_t)(b * DEPTH + l) * PAST + s) * 256 + 4 * lane, dst_o = ((size_t)b * 1280 + s) * 256 + 4 * lane;
            const f32x4 kk = *(const f32x4*)(a.cache_k + so), vv = *(const f32x4*)(a.cache_v + so);
            u32x2 ko = {pk_act(kk[0], kk[1]), pk_act(kk[2], kk[3])}, vo = {pk_act(vv[0], vv[1]), pk_act(vv[2], vv[3])};
            *(u32x2*)(KL + dst_o) = ko; *(u32x2*)(VL + dst_o) = vo;
        } else {
            const int ti = it - NTOK - 1024, tb = ti >> 4, cb = ti & 15, r0 = tb * 64, c0 = cb * 64;
#pragma unroll
            for (int j = 0; j < 8; ++j) { const int row = (lane >> 3) + 8 * j, cc = (lane & 7) * 8; const u32x4 w = *(const u32x4*)(Z + (size_t)(r0 + row) * NZ + ZF + c0 + cc);
#pragma unroll
                for (int q = 0; q < 4; ++q) *(LAS unsigned*)(tile + row * 66 + cc + 2 * q) = w[q]; }
            LDS_WAIT(); asm volatile("" ::: "memory");
            bf16* XT; int T, b, t0;
            if (r0 < NCTX) { XT = (bf16*)(a.ws + WS_XT); T = TC; b = r0 >> 8; t0 = r0 & 255; } else { XT = (bf16*)(a.ws + WS_XT) + (size_t)16384 * 256; T = TL; b = (r0 - NCTX) >> 10; t0 = (r0 - NCTX) & 1023; }
#pragma unroll
            for (int j = 0; j < 8; ++j) { const int ch = (lane >> 3) + 8 * j, tt = (lane & 7) * 8; unsigned o[4];
#pragma unroll
                for (int q = 0; q < 4; ++q) o[q] = (unsigned)tile[(tt + 2 * q) * 66 + ch] | ((unsigned)tile[(tt + 2 * q + 1) * 66 + ch] << 16);
                *(u32x4*)(XT + ((size_t)b * 1024 + c0 + ch) * T + t0 + tt) = (u32x4){o[0], o[1], o[2], o[3]}; }
            LDS_WAIT(); asm volatile("" ::: "memory");
        }
    }
}

__device__ __forceinline__ void phase_attn(LAS unsigned char* lds_, const Args& a, int l) {
    const Frame F = frame_now(lds_);
    bf16* AM = (bf16*)(a.ws + WS_AM);
    for (int u = F.bid; u < 256; u += F.G) {
        const bool lat = u < 128; const int uu = lat ? u : u - 128;
        const int b = lat ? (uu >> 5) : (uu >> 3), h = lat ? ((uu >> 2) & 7) : (uu & 7), qb = lat ? (uu & 3) : 0;
        const size_t row0 = lat ? (size_t)NCTX + b * 1024 + qb * 256 : (size_t)b * 256;
        const size_t kvo = (lat ? (size_t)b * 1280 * 256 : (size_t)b * 256 * 256) + (h >> 2) * 128;
        const bf16* Kp = (const bf16*)(a.ws + (lat ? WS_KL : WS_KC)) + kvo; const bf16* Vp = (const bf16*)(a.ws + (lat ? WS_VL : WS_VC)) + kvo;
        att::attn_dense_body((const bf16*)(a.ws + WS_QN) + row0 * 1024 + h * 128, Kp, Vp, AM + row0 * KMRG + 2048 + h * 128, lat ? 1280 : 256, (LAS char*)F.lds);
    }
}

__device__ __forceinline__ void phase_gla_g1(LAS unsigned char* lds_, const Args& a, int l) {
    const Frame F = frame_now(lds_);
    const bf16* Z = (const bf16*)(a.ws + WS_Z);
    for (int gi = F.bid; gi < gla::G1_ITEMS; gi += F.G) {
        const int chunk = gi >> 3, h = (gi >> 1) & 3, dir = gi & 1;
        const float* wg = (dir ? a.w_gate_b : a.w_gate_f) + (size_t)l * 16 * 512 + h * 128;
        const float* bg = (dir ? a.b_gate_b : a.b_gate_f) + (size_t)l * 512 + h * 128;
        gla::g1_item(F.lds, Z, wg, bg, (bf16*)(a.ws + WS_GQE) + (size_t)gi * gla::GW_QE_SZ, (bf16*)(a.ws + WS_GATT) + (size_t)gi * gla::GW_ATT_SZ,
                     (bf16*)(a.ws + WS_GKLT) + (size_t)gi * gla::GW_KLT_SZ, (float*)(a.ws + WS_GEB) + (size_t)gi * gla::GW_EB_SZ, chunk * 64, h, dir);
    }
}
__device__ __forceinline__ void phase_gla_g2(LAS unsigned char* lds_, const Args& a, int l) {
    const Frame F = frame_now(lds_);
    const bf16* Z = (const bf16*)(a.ws + WS_Z);
    for (int slot = F.bid; slot < 256; slot += F.G) {
        const int nit = slot < 128 ? 1 : 4;
        for (int k = 0; k < nit; ++k) {
            int path, b, h, dir, dvq;
            if (slot < 128) { path = 1; b = slot >> 5; h = (slot >> 3) & 3; dir = (slot >> 2) & 1; dvq = slot & 3; }
            else { const int it = (slot - 128) * 4 + k; path = 0; b = it >> 5; h = (it >> 3) & 3; dir = (it >> 2) & 1; dvq = it & 3; }
            float* OUT = (float*)(a.ws + (dir ? WS_OB : WS_OF));
            const size_t so = ((size_t)(b * DEPTH + l) * 4 + h) * 128 * 256;
            const float* st_in = path ? (dir ? a.state_b : a.state_f) + so : nullptr;
            float* st_out = path ? nullptr : a.out + (dir ? OUT_SB : OUT_SF) + so;
            gla::g2_item(F.lds, Z, OUT, (const bf16*)(a.ws + WS_GQE), (const bf16*)(a.ws + WS_GATT), (const bf16*)(a.ws + WS_GKLT), (const float*)(a.ws + WS_GEB),
                         st_in, st_out, path ? TL : TC, path ? NCTX + b * 1024 : b * 256, h, dir, dvq);
        }
    }
}
__device__ __forceinline__ void phase_gla_fin(LAS unsigned char* lds_, const Args& a, int l) {
    const Frame F = frame_now(lds_);
    const bf16* Z = (const bf16*)(a.ws + WS_Z); bf16* AM = (bf16*)(a.ws + WS_AM);
    const float* OF = (const float*)(a.ws + WS_OF); const float* OB = (const float*)(a.ws + WS_OB);
    const int gw = F.bid * NWAVES + F.wave, NGW = F.G * NWAVES;
    const f32x4 gn = *(const f32x4*)(a.gla_norm + l * 256 + 4 * F.lane);
    for (int it = gw; it < NTOK * 4; it += NGW) { const int r = it >> 2, h = it & 3; const size_t o = (size_t)r * 1024 + h * 256 + 4 * F.lane;
        const f32x4 v = *(const f32x4*)(OF + o) + *(const f32x4*)(OB + o);
        const float ss = wave_sum((v[0] * v[0] + v[1] * v[1]) + (v[2] * v[2] + v[3] * v[3]));
        const float rstd = rsqrtf(ss * (1.f / 256.f) + EPS);
        const u32x2 g = *(const u32x2*)(Z + (size_t)r * NZ + ZGR + h * 256 + 4 * F.lane);
        const f32x4 y = v * rstd * gn;
        u32x2 w = {pk_act(y[0] * siluf_(lo_act(g[0])), y[1] * siluf_(hi_act(g[0]))), pk_act(y[2] * siluf_(lo_act(g[1])), y[3] * siluf_(hi_act(g[1])))};
        *(u32x2*)(AM + (size_t)r * KMRG + 3072 + h * 256 + 4 * F.lane) = w; }
}
__device__ __forceinline__ void phase_conv(LAS unsigned char* lds_, const Args& a, int l) {
    const Frame F = frame_now(lds_);
    const bf16* U = (const bf16*)(a.ws + WS_Z); bf16* ACT = (bf16*)(a.ws + WS_ACT);
    const float* cw = a.conv_w + (size_t)l * 3 * NUP; const float* cb = a.conv_b + (size_t)l * NUP;
    constexpr int NCG = DFF / 8, STRIP = 32, NS = NTOK / STRIP;
    for (int it = F.bid * 512 + F.tid; it < NCG * NS; it += F.G * 512) {
        const int cg = it % NCG, st = it / NCG, c = cg * 8, r0 = st * STRIP; const int T = r0 < NCTX ? TC : TL;
        float wg[3][8], wv[3][8], bgv[8], bvv[8];
#pragma unroll
        for (int k = 0; k < 3; ++k) { const f32x4 a0 = *(const f32x4*)(cw + k * NUP + c), a1 = *(const f32x4*)(cw + k * NUP + c + 4), b0 = *(const f32x4*)(cw + k * NUP + DFF + c), b1 = *(const f32x4*)(cw + k * NUP + DFF + c + 4);
#pragma unroll
            for (int j = 0; j < 4; ++j) { wg[k][j] = a0[j]; wg[k][4 + j] = a1[j]; wv[k][j] = b0[j]; wv[k][4 + j] = b1[j]; } }
        { const f32x4 a0 = *(const f32x4*)(cb + c), a1 = *(const f32x4*)(cb + c + 4), b0 = *(const f32x4*)(cb + DFF + c), b1 = *(const f32x4*)(cb + DFF + c + 4);
#pragma unroll
          for (int j = 0; j < 4; ++j) { bgv[j] = a0[j]; bgv[4 + j] = a1[j]; bvv[j] = b0[j]; bvv[4 + j] = b1[j]; } }
        const u32x4 zero = {0u, 0u, 0u, 0u};
        u32x4 gp = zero, vp = zero, gc, vc;
        if ((r0 & (T - 1)) != 0) { gp = *(const u32x4*)(U + (size_t)(r0 - 1) * NUP + c); vp = *(const u32x4*)(U + (size_t)(r0 - 1) * NUP + DFF + c); }
        gc = *(const u32x4*)(U + (size_t)r0 * NUP + c); vc = *(const u32x4*)(U + (size_t)r0 * NUP + DFF + c);
        for (int i = 0; i < STRIP; i += 4) {
            u32x4 gnx[4], vnx[4];
#pragma unroll
            for (int e = 0; e < 4; ++e) { const int rn = r0 + i + e + 1;
                if ((rn & (T - 1)) != 0) { gnx[e] = *(const u32x4*)(U + (size_t)rn * NUP + c); vnx[e] = *(const u32x4*)(U + (size_t)rn * NUP + DFF + c); } else { gnx[e] = zero; vnx[e] = zero; } }
#pragma unroll
            for (int e = 0; e < 4; ++e) { const int r = r0 + i + e; const u32x4 gn = gnx[e], vn = vnx[e];
                float o[8];
#pragma unroll
                for (int q = 0; q < 4; ++q) {
                    const float g0 = wg[0][2 * q] * lo_act(gp[q]) + wg[1][2 * q] * lo_act(gc[q]) + wg[2][2 * q] * lo_act(gn[q]) + bgv[2 * q];
                    const float g1 = wg[0][2 * q + 1] * hi_act(gp[q]) + wg[1][2 * q + 1] * hi_act(gc[q]) + wg[2][2 * q + 1] * hi_act(gn[q]) + bgv[2 * q + 1];
                    const float v0 = wv[0][2 * q] * lo_act(vp[q]) + wv[1][2 * q] * lo_act(vc[q]) + wv[2][2 * q] * lo_act(vn[q]) + bvv[2 * q];
                    const float v1 = wv[0][2 * q + 1] * hi_act(vp[q]) + wv[1][2 * q + 1] * hi_act(vc[q]) + wv[2][2 * q + 1] * hi_act(vn[q]) + bvv[2 * q + 1];
                    o[2 * q] = siluf_(g0) * v0; o[2 * q + 1] = siluf_(g1) * v1; }
                *(u32x4*)(ACT + (size_t)r * DFF + c) = (u32x4){pk_act(o[0], o[1]), pk_act(o[2], o[3]), pk_act(o[4], o[5]), pk_act(o[6], o[7])};
                gp = gc; vp = vc; gc = gn; vc = vn; }
        }
    }
}

#ifdef MK_PROBE
constexpr size_t WS_DIAG = WS_END;
__device__ __forceinline__ void diag_max(float* slot, float v) { atomicMax((unsigned*)slot, __builtin_bit_cast(unsigned, fabsf(v))); }
__global__ void k_probe_zero(float* diag) { if (threadIdx.x < 4) diag[threadIdx.x] = 0.f; }
__global__ void k_probe_fill(float* out, const float* diag) {
    for (size_t i = (size_t)blockIdx.x * blockDim.x + threadIdx.x; i < OUT_END; i += (size_t)gridDim.x * blockDim.x) out[i] = 0.f;
    __syncthreads();
    if (blockIdx.x == 0 && threadIdx.x == 0) out[0] = 1e6f * diag[0] / fmaxf(diag[1], 1e-20f);
}
__global__ void k_probe_fill2(float* out, const float* diag) { if (blockIdx.x == 0 && threadIdx.x == 0) out[0] = 1e6f * diag[0] / fmaxf(diag[1], 1e-20f); }
__global__ void k_probe_z(Args a) {
    const bf16* H = (const bf16*)(a.ws + WS_H); const bf16* W = (const bf16*)(a.ws + WS_WIN); const bf16* Z = (const bf16*)(a.ws + WS_Z); float* diag = (float*)(a.ws + WS_DIAG);
    const unsigned id = blockIdx.x * blockDim.x + threadIdx.x; const unsigned hsh = id * 2654435761u + 12345u;
    const int r = (hsh >> 8) % NTOK, c = (hsh * 40503u >> 7) % NZ;
    float s = 0.f; for (int k = 0; k < DM; ++k) s += act2f(H[(size_t)r * DM + k]) * act2f(W[(size_t)c * DM + k]);
    const float z = act2f(Z[(size_t)r * NZ + c]); diag_max(diag, z - s); diag_max(diag + 1, s);
}
__global__ void k_probe_wt(Args a, int l) {
    const bf16* W = (const bf16*)(a.ws + WS_WIN + (size_t)l * SZ_WIN); float* diag = (float*)(a.ws + WS_DIAG);
    for (size_t i = (size_t)blockIdx.x * blockDim.x + threadIdx.x; i < (size_t)N_IN * DM; i += (size_t)gridDim.x * blockDim.x) {
        const int n = (int)(i / DM), k = (int)(i % DM); const int row = n >= ZPAD ? n + (ZGATE - ZPAD) : n;
        const float ref = act2f(f2act(a.w_in[((size_t)l * DM + k) * N_IN + n])); diag_max(diag, act2f(W[(size_t)row * DM + k]) - ref); diag_max(diag + 1, ref); }
}
__global__ void k_probe_gla(Args a) {
    __shared__ float red[4];
    const bf16* Z = (const bf16*)(a.ws + WS_Z); float* diag = (float*)(a.ws + WS_DIAG);
    const int l = 0, blk = blockIdx.x, b = blk & 15, h = (blk >> 4) & 3, dir = (blk >> 6) & 1, dv0 = ((blk >> 7) * 52 + 3) & 252;
    const int d = threadIdx.x & 127, dvi = threadIdx.x >> 7, dv = dv0 + dvi, T = TC, tokbase = b * TC;
    const float* wg = (dir ? a.w_gate_b : a.w_gate_f) + (size_t)l * 16 * 512 + h * 128; const float* bg = (dir ? a.b_gate_b : a.b_gate_f) + (size_t)l * 512 + h * 128;
    const float* OUT = (const float*)(a.ws + (dir ? WS_OB : WS_OF));
    float S = 0.f;
    for (int i = 0; i < T; ++i) { const int t = dir ? T - 1 - i : i; const bf16* zr = Z + (size_t)(tokbase + t) * NZ;
        float x = bg[d]; for (int r = 0; r < 16; ++r) x += act2f(zr[(dir ? ZGAB : ZGAF) + r]) * wg[r * 512 + d];
        const float la = (fminf(x, 0.f) - logf(1.f + expf(-fabsf(x)))) * 0.0625f;
        S = expf(la) * S + act2f(zr[ZGK + h * 128 + d]) * act2f(zr[ZGV + h * 256 + dv]);
        if (threadIdx.x < 4) red[threadIdx.x] = 0.f;
        __syncthreads();
        atomicAdd(&red[dvi], act2f(zr[ZGQ + h * 128 + d]) * 0.088388347648318440f * S);
        __syncthreads();
        if (d == 0) { const float o = OUT[(size_t)(tokbase + t) * 1024 + h * 256 + dv]; diag_max(diag, o - red[dvi]); diag_max(diag + 1, red[dvi]); }
        __syncthreads(); }
    const float sref = S, sgot = a.out[(dir ? OUT_SB : OUT_SF) + (((size_t)(b * DEPTH + l) * 4 + h) * 128 + d) * 256 + dv];
    diag_max(diag + 2, sgot - sref); diag_max(diag + 3, sref);
}

__global__ void k_probe_h(Args a) {
    const bf16* H = (const bf16*)(a.ws + WS_H); float* diag = (float*)(a.ws + WS_DIAG);
    const unsigned id = blockIdx.x * blockDim.x + threadIdx.x; const unsigned hsh = id * 2654435761u + 777u;
    const int r = (hsh >> 8) % NTOK, c = (hsh * 40503u >> 7) % DM, j = mod_row(r);
    const float* xr = r < NCTX ? a.x_prompt + (size_t)r * DM : a.x_sample + (size_t)(r - NCTX) * DM;
    float ss = 0.f, sh = a.b_ada[c], sc = a.b_ada[DM + c];
    for (int k = 0; k < DM; ++k) { ss += xr[k] * xr[k]; const float cv = j == 0 ? a.c_ctx[k] : a.cvec[(j - 1) * DM + k]; const float sl = cv / (1.f + expf(-cv));
        sh += sl * a.w_ada[(size_t)k * NMOD + c]; sc += sl * a.w_ada[(size_t)k * NMOD + DM + c]; }
    const float ref = xr[c] * (1.f / sqrtf(ss / DM + EPS)) * a.norm1[c] * (1.f + sc) + sh;
    diag_max(diag, act2f(H[(size_t)r * DM + c]) - ref); diag_max(diag + 1, ref);
}

__global__ void k_probe_mod(Args a, int l) {
    const float* MOD = (const float*)(a.ws + WS_MOD) + (size_t)l * NMODV * NMOD; float* diag = (float*)(a.ws + WS_DIAG);
    const unsigned id = blockIdx.x * blockDim.x + threadIdx.x; const int j = id % NMODV, n = (int)(((id / NMODV) * 2654435761u >> 8) % NMOD);
    float s = a.b_ada[(size_t)l * NMOD + n];
    for (int k = 0; k < DM; ++k) { const float cv = j == 0 ? a.c_ctx[k] : a.cvec[(j - 1) * DM + k]; s += cv / (1.f + expf(-cv)) * a.w_ada[((size_t)l * DM + k) * NMOD + n]; }
    diag_max(diag, MOD[(size_t)j * NMOD + n] - s); diag_max(diag + 1, s);
}
#endif

constexpr int STEPS_PER_LAYER = 13, STEP_L0 = 2, STEP_FINAL = STEP_L0 + DEPTH * STEPS_PER_LAYER, N_STEPS = STEP_FINAL + 1;
#ifndef MK_PH_MASK
#define MK_PH_MASK 0xFFFFFFFFu
#endif
#define EN(k) (((MK_PH_MASK) >> (k)) & 1u)
#ifndef MK_REP_MASK
#define MK_REP_MASK 0u
#endif
#define REP(k) (((MK_REP_MASK) >> (k)) & 1u)
#ifndef MK_SP2
#define MK_SP2 true
#endif
#ifndef MK_ALIGN
#define MK_ALIGN true
#endif
__global__ void __launch_bounds__(NWAVES * 64, 2) mk_fwd(Args a) {
    extern __shared__ __attribute__((aligned(16))) unsigned char lds_raw[];
    LAS unsigned char* const lds = (LAS unsigned char*)lds_raw;
    volatile LAS unsigned* MISC = (volatile LAS unsigned*)(lds + MISC_OFF);
    if (threadIdx.x < 64) MISC[threadIdx.x] = 0u;
    __syncthreads();
    unsigned* barw = (unsigned*)(a.ws + WS_CTL) + CW_BAR + a.li * XCD_BAR_WORDS;
    XcdBarrier bar = xcd_barrier_post(barw, MISC + 8);
    const int lo = a.s_lo, hi = a.s_hi;
#define IN(s) (lo <= (s) && (s) < hi)
#define SEAM(s) do { if (IN(s) && IN((s) + 1)) xcd_barrier(bar); else __syncthreads(); } while (0)
    unsigned char* ws = a.ws;
    const int G = gridDim.x, bid = blockIdx.x;

    if (EN(13) && IN(0)) { phase_prologue_a(lds, a); if (REP(13)) { xcd_barrier(bar); phase_prologue_a(lds, a); } SEAM(0); }
    if (EN(14) && IN(1)) {
        phase_mod_reduce(lds, a);
        pg8::Gemm g{(const bf16*)(ws + WS_WFT), (const bf16*)(ws + WS_DT), DEPTH * DM, 2048, 1024}; pg8::StaticOrder S; S.init(g.M, g.N, G, bid);
        pg8::EpiStoreBf16 E{(bf16*)(ws + WS_WMRG), KMRG};
        pg8::gemm_phase<pg8::EpiStoreBf16, pg8::StaticOrder, MK_ALIGN, MK_SP2>(lds, g, S, E);
        SEAM(1);
    }
    for (int l = 0; l < DEPTH; ++l) {
        const int sb = STEP_L0 + l * STEPS_PER_LAYER;
        if (hi <= sb || lo >= sb + STEPS_PER_LAYER) continue;
        const float* MODL = (const float*)(ws + WS_MOD) + (size_t)l * NMODV * NMOD;
        if (EN(0) && IN(sb + 0)) { phase_norm(lds, a, l, 0, l == 0); if (REP(0)) { xcd_barrier(bar); phase_norm(lds, a, l, 0, l == 0); } SEAM(sb + 0); }
        if (EN(1) && IN(sb + 1)) {
            pg8::Gemm g{(const bf16*)(ws + WS_H), (const bf16*)(ws + WS_WIN + l * SZ_WIN), NTOK, NZ, DM}; pg8::StaticOrder S; S.init(g.M, g.N, G, bid);
            pg8::EpiStoreBf16 E{(bf16*)(ws + WS_Z), NZ};
            pg8::gemm_phase<pg8::EpiStoreBf16, pg8::StaticOrder, MK_ALIGN, MK_SP2>(lds, g, S, E);
#ifdef MK_REP_Z
            xcd_barrier(bar); pg8::gemm_phase<pg8::EpiStoreBf16, pg8::StaticOrder, MK_ALIGN, MK_SP2>(lds, g, S, E);
#endif
            SEAM(sb + 1);
        }
        if (EN(2) && IN(sb + 2)) { phase_gla_g1(lds, a, l); phase_prep(lds, a, l); if (REP(2)) { xcd_barrier(bar); phase_gla_g1(lds, a, l); phase_prep(lds, a, l); } SEAM(sb + 2); }
        if (EN(3) && IN(sb + 3)) { phase_attn(lds, a, l); if (REP(3)) { xcd_barrier(bar); phase_attn(lds, a, l); } SEAM(sb + 3); }
        if (EN(4) && IN(sb + 4)) {
            { pg8::Gemm g{(const bf16*)(ws + WS_ALAT), (const bf16*)(ws + WS_XT) + (size_t)16384 * 256, 2048, 4096, 1024}; pg8::StaticOrder S; S.init(g.M, g.N, G, bid);
              pg8::EpiDft E{(bf16*)(ws + WS_AM), 10, NCTX};
              pg8::gemm_phase<pg8::EpiDft, pg8::StaticOrder, MK_ALIGN, MK_SP2>(lds, g, S, E); }
            { pg8::Gemm g{(const bf16*)(ws + WS_ACTX), (const bf16*)(ws + WS_XT), 512, 16384, 256}; pg8::StaticOrder S; S.init(g.M, g.N, G, (bid + G / 2) % G);
              pg8::EpiDft E{(bf16*)(ws + WS_AM), 8, 0};
              pg8::gemm_phase<pg8::EpiDft, pg8::StaticOrder, MK_ALIGN, MK_SP2>(lds, g, S, E); }
#if (MK_REP_MASK >> 4) & 1
            xcd_barrier(bar);
            {

            { pg8::Gemm g{(const bf16*)(ws + WS_ALAT), (const bf16*)(ws + WS_XT) + (size_t)16384 * 256, 2048, 4096, 1024}; pg8::StaticOrder S; S.init(g.M, g.N, G, bid);
              pg8::EpiDft E{(bf16*)(ws + WS_AM), 10, NCTX};
              pg8::gemm_phase<pg8::EpiDft, pg8::StaticOrder, MK_ALIGN, MK_SP2>(lds, g, S, E); }
            { pg8::Gemm g{(const bf16*)(ws + WS_ACTX), (const bf16*)(ws + WS_XT), 512, 16384, 256}; pg8::StaticOrder S; S.init(g.M, g.N, G, (bid + G / 2) % G);
              pg8::EpiDft E{(bf16*)(ws + WS_AM), 8, 0};
              pg8::gemm_phase<pg8::EpiDft, pg8::StaticOrder, MK_ALIGN, MK_SP2>(lds, g, S, E); }
            }
#endif
                        SEAM(sb + 4);
        }
        if (EN(5) && IN(sb + 5)) { phase_gla_g2(lds, a, l); if (REP(5)) { xcd_barrier(bar); phase_gla_g2(lds, a, l); } SEAM(sb + 5); }
        if (EN(6) && IN(sb + 6)) { phase_gla_fin(lds, a, l); if (REP(6)) { xcd_barrier(bar); phase_gla_fin(lds, a, l); } SEAM(sb + 6); }
        if (EN(7) && IN(sb + 7)) {
            pg8::Gemm g{(const bf16*)(ws + WS_AM), (const bf16*)(ws + WS_WMRG + l * SZ_WMRG), NTOK, DM, KMRG}; pg8::StaticOrder S; S.init(g.M, g.N, G, bid);
            pg8::EpiMerged E{(bf16*)(ws + WS_MG), (const bf16*)(ws + WS_Z)};
            pg8::gemm_phase<pg8::EpiMerged, pg8::StaticOrder, MK_ALIGN, MK_SP2>(lds, g, S, E);
#if (MK_REP_MASK >> 7) & 1
            xcd_barrier(bar);
            {

            pg8::Gemm g{(const bf16*)(ws + WS_AM), (const bf16*)(ws + WS_WMRG + l * SZ_WMRG), NTOK, DM, KMRG}; pg8::StaticOrder S; S.init(g.M, g.N, G, bid);
            pg8::EpiMerged E{(bf16*)(ws + WS_MG), (const bf16*)(ws + WS_Z)};
            pg8::gemm_phase<pg8::EpiMerged, pg8::StaticOrder, MK_ALIGN, MK_SP2>(lds, g, S, E);
            }
#endif
                        SEAM(sb + 7);
        }
        if (EN(8) && IN(sb + 8)) {
            pg8::Gemm g{(const bf16*)(ws + WS_MG), (const bf16*)(ws + WS_WOUT + l * SZ_WOUT), NTOK, DM, DM}; pg8::StaticOrder S; S.init(g.M, g.N, G, bid);
            pg8::EpiResid E{(float*)(ws + WS_X), MODL + 2 * DM};
            pg8::gemm_phase<pg8::EpiResid, pg8::StaticOrder, MK_ALIGN, MK_SP2>(lds, g, S, E);
#if (MK_REP_MASK >> 8) & 1
            xcd_barrier(bar);
            {

            pg8::Gemm g{(const bf16*)(ws + WS_MG), (const bf16*)(ws + WS_WOUT + l * SZ_WOUT), NTOK, DM, DM}; pg8::StaticOrder S; S.init(g.M, g.N, G, bid);
            pg8::EpiResid E{(float*)(ws + WS_X), (const float*)(ws + WS_CTL + 512 * 1024)};
            pg8::gemm_phase<pg8::EpiResid, pg8::StaticOrder, MK_ALIGN, MK_SP2>(lds, g, S, E);
            }
#endif
            SEAM(sb + 8);
        }
        if (EN(9) && IN(sb + 9)) { phase_norm(lds, a, l, 1, false); if (REP(9)) { xcd_barrier(bar); phase_norm(lds, a, l, 1, false); } SEAM(sb + 9); }
        if (EN(10) && IN(sb + 10)) {
            pg8::Gemm g{(const bf16*)(ws + WS_H), (const bf16*)(ws + WS_WUP + l * SZ_WUP), NTOK, NUP, DM}; pg8::StaticOrder S; S.init(g.M, g.N, G, bid);
            pg8::EpiStoreBf16 E{(bf16*)(ws + WS_Z), NUP};
            pg8::gemm_phase<pg8::EpiStoreBf16, pg8::StaticOrder, MK_ALIGN, MK_SP2>(lds, g, S, E);
#if (MK_REP_MASK >> 10) & 1
            xcd_barrier(bar);
            {

            pg8::Gemm g{(const bf16*)(ws + WS_H), (const bf16*)(ws + WS_WUP + l * SZ_WUP), NTOK, NUP, DM}; pg8::StaticOrder S; S.init(g.M, g.N, G, bid);
            pg8::EpiStoreBf16 E{(bf16*)(ws + WS_Z), NUP};
            pg8::gemm_phase<pg8::EpiStoreBf16, pg8::StaticOrder, MK_ALIGN, MK_SP2>(lds, g, S, E);
            }
#endif
                        SEAM(sb + 10);
        }
        if (EN(11) && IN(sb + 11)) { phase_conv(lds, a, l); if (REP(11)) { xcd_barrier(bar); phase_conv(lds, a, l); } SEAM(sb + 11); }
        if (EN(12) && IN(sb + 12)) {
            pg8::Gemm g{(const bf16*)(ws + WS_ACT), (const bf16*)(ws + WS_WDN + l * SZ_WDN), NTOK, DM, DFF}; pg8::StaticOrder S; S.init(g.M, g.N, G, bid);
            pg8::EpiResid E{(float*)(ws + WS_X), MODL + 5 * DM};
            pg8::gemm_phase<pg8::EpiResid, pg8::StaticOrder, MK_ALIGN, MK_SP2>(lds, g, S, E);
#if (MK_REP_MASK >> 12) & 1
            xcd_barrier(bar);
            {

            pg8::Gemm g{(const bf16*)(ws + WS_ACT), (const bf16*)(ws + WS_WDN + l * SZ_WDN), NTOK, DM, DFF}; pg8::StaticOrder S; S.init(g.M, g.N, G, bid);
            pg8::EpiResid E{(float*)(ws + WS_X), (const float*)(ws + WS_CTL + 512 * 1024)};
            pg8::gemm_phase<pg8::EpiResid, pg8::StaticOrder, MK_ALIGN, MK_SP2>(lds, g, S, E);
            }
#endif
            SEAM(sb + 12);
        }
    }
    if (EN(15) && IN(STEP_FINAL)) phase_final_norm(lds, a);
#undef IN
#undef SEAM
}

#ifndef MK_LAUNCH_MODE
#define MK_LAUNCH_MODE 0
#endif
extern "C" void kernel_launch(void* const* d_in, const int* in_sizes, int n_in, void* d_out, int out_size, void* d_ws, size_t ws_size, hipStream_t stream) {
    static int grid = 0;
    if (grid == 0) {
        if (n_in != 29 || (size_t)out_size != OUT_END || ws_size < WS_END + 4096) { fprintf(stderr, "kernel_launch: unexpected shapes: n_in %d out %d ws %zu (need %zu)\n", n_in, out_size, ws_size, (size_t)WS_END); grid = -1; return; }
        int dev = 0, cus = 0;
        if (hipGetDevice(&dev) != hipSuccess || hipDeviceGetAttribute(&cus, hipDeviceAttributeMultiprocessorCount, dev) != hipSuccess) { grid = -1; return; }
        if (hipFuncSetAttribute((const void*)mk_fwd, hipFuncAttributeMaxDynamicSharedMemorySize, LDS_BYTES) != hipSuccess) { fprintf(stderr, "kernel_launch: hipFuncSetAttribute failed\n"); grid = -1; return; }
        int per_cu = 0;
        if (hipOccupancyMaxActiveBlocksPerMultiprocessor(&per_cu, (const void*)mk_fwd, NWAVES * 64, LDS_BYTES) != hipSuccess || per_cu < 1) { fprintf(stderr, "kernel_launch: occupancy query says %d\n", per_cu); }
        (void)hipGetLastError();
        grid = cus;
    }
    if (grid < 0) return;
    (void)hipMemsetAsync((char*)d_ws + WS_CTL, 0, CTL_ZERO_BYTES, stream);
    Args a{};
    const float** p = (const float**)&a;
    for (int i = 0; i < 29; ++i) p[i] = (const float*)d_in[i];
    a.out = (float*)d_out; a.ws = (unsigned char*)d_ws; a.pad = 0;
#ifdef MK_PROBE
    {
        constexpr int PROBE_STEPS = (MK_PROBE == 2) ? 1 : (MK_PROBE == 1) ? STEP_L0 + 2 : (MK_PROBE == 4) ? STEP_L0 + 1 : (MK_PROBE == 5) ? 2 : STEP_L0 + 6;
        float* diag = (float*)((char*)d_ws + WS_DIAG);
        for (int s = 0; s < PROBE_STEPS; ++s) { a.s_lo = s; a.s_hi = s + 1; a.li = s; hipLaunchKernelGGL(mk_fwd, dim3(grid), dim3(NWAVES * 64), LDS_BYTES, stream, a); }
        hipLaunchKernelGGL(k_probe_zero, dim3(1), dim3(64), 0, stream, diag);
        if (MK_PROBE == 1) hipLaunchKernelGGL(k_probe_z, dim3(128), dim3(512), 0, stream, a);
        if (MK_PROBE == 2) hipLaunchKernelGGL(k_probe_wt, dim3(1024), dim3(256), 0, stream, a, MK_PROBE_L);
        if (MK_PROBE == 4) hipLaunchKernelGGL(k_probe_h, dim3(32), dim3(512), 0, stream, a);
        if (MK_PROBE == 5) hipLaunchKernelGGL(k_probe_mod, dim3(40), dim3(512), 0, stream, a, MK_PROBE_L);
        if (MK_PROBE == 3) hipLaunchKernelGGL(k_probe_gla, dim3(512), dim3(512), 0, stream, a);
        hipLaunchKernelGGL(k_probe_fill, dim3(1024), dim3(256), 0, stream, (float*)d_out, (const float*)(diag + 2 * MK_PROBE_SEL));
        hipLaunchKernelGGL(k_probe_fill2, dim3(1), dim3(64), 0, stream, (float*)d_out, (const float*)(diag + 2 * MK_PROBE_SEL));
        return;
    }
#endif
#if MK_LAUNCH_MODE == 1
    a.s_lo = 0; a.s_hi = N_STEPS; a.li = 0;
    hipLaunchKernelGGL(mk_fwd, dim3(grid), dim3(NWAVES * 64), LDS_BYTES, stream, a);
#else
    for (int s = 0; s < N_STEPS; ++s) { a.s_lo = s; a.s_hi = s + 1; a.li = s;
        hipLaunchKernelGGL(mk_fwd, dim3(grid), dim3(NWAVES * 64), LDS_BYTES, stream, a); }
#endif
}
```

```cpp
#define MK_LAUNCH_MODE 1
#include <hip/hip_runtime.h>
#include <cstdio>
#include <cstdint>

#define GAS __attribute__((address_space(1)))
#define LAS __attribute__((address_space(3)))
typedef unsigned short bf16;
typedef short bf16x8 __attribute__((ext_vector_type(8)));
typedef float f32x4 __attribute__((ext_vector_type(4)));
typedef float f32x2 __attribute__((ext_vector_type(2)));
typedef unsigned u32x4 __attribute__((ext_vector_type(4)));
typedef unsigned u32x2 __attribute__((ext_vector_type(2)));
typedef GAS unsigned gu32;

constexpr int DM = 2048, NTOK = 8192, NCTX = 4096, TC = 256, TL = 1024, BCTX = 16, BLAT = 4, PAST = 256, DEPTH = 4;
constexpr int N_IN = 11808, NZ = 12032;
constexpr int ZF = 0, ZQ = 1024, ZK = 2048, ZV = 2304, ZGQ = 2560, ZGK = 3072, ZGV = 3584, ZGR = 4608, ZGAF = 5632, ZGAB = 5648, ZPAD = 5664, ZGATE = 5888;
constexpr int NUP = 11264, DFF = 5632, NMOD = 12288, KMRG = 4096;
constexpr int NMODV = 5;
constexpr float EPS = 1e-6f;

constexpr size_t MiB = 1u << 20;
constexpr size_t WS_CTL = 0, CTL_ZERO_BYTES = 1 * MiB;
constexpr size_t WS_MOD = 1 * MiB;
constexpr size_t WS_MODP = 2 * MiB;
constexpr size_t WS_DT = 17 * MiB;
constexpr size_t WS_ACTX = 21 * MiB;
constexpr size_t WS_ALAT = 22 * MiB;
constexpr size_t WS_WIN = 26 * MiB;
constexpr size_t WS_WMRG = 214 * MiB;
constexpr size_t WS_WFT = 278 * MiB;
constexpr size_t WS_WOUT = 294 * MiB;
constexpr size_t WS_WUP = 326 * MiB;
constexpr size_t WS_WDN = 502 * MiB;
constexpr size_t WS_X = 590 * MiB;
constexpr size_t WS_H = 654 * MiB;
constexpr size_t WS_Z = 686 * MiB;
constexpr size_t WS_XT = 874 * MiB;
constexpr size_t WS_KC = 890 * MiB, WS_VC = 892 * MiB;
constexpr size_t WS_KL = 894 * MiB, WS_VL = 897 * MiB;
constexpr size_t WS_AM = 900 * MiB;
constexpr size_t WS_OF = 964 * MiB, WS_OB = 996 * MiB;
constexpr size_t WS_MG = 1028 * MiB;
constexpr size_t WS_ACT = 1060 * MiB;
constexpr size_t WS_QN = 1148 * MiB;
constexpr size_t WS_GQE = 1164 * MiB, WS_GKLT = 1180 * MiB, WS_GATT = 1196 * MiB, WS_GEB = 1204 * MiB;
constexpr size_t WS_END = 1205 * MiB;
constexpr size_t SZ_WIN = (size_t)NZ * DM * 2, SZ_WMRG = (size_t)DM * KMRG * 2, SZ_WFT = (size_t)DM * 1024 * 2, SZ_WOUT = (size_t)DM * DM * 2, SZ_WUP = (size_t)NUP * DM * 2, SZ_WDN = (size_t)DM * DFF * 2;
static_assert(WS_WIN + 4 * SZ_WIN <= WS_WMRG && WS_WMRG + 4 * SZ_WMRG <= WS_WFT && WS_WFT + 4 * SZ_WFT <= WS_WOUT && WS_WOUT + 4 * SZ_WOUT <= WS_WUP && WS_WUP + 4 * SZ_WUP <= WS_WDN && WS_WDN + 4 * SZ_WDN <= WS_X, "ws map (weights)");
static_assert(WS_Z + (size_t)NTOK * NZ * 2 <= WS_XT && WS_MODP + (size_t)16 * 4 * 5 * NMOD * 4 <= WS_DT && WS_AM + (size_t)NTOK * KMRG * 2 <= WS_OF && WS_ACT + (size_t)NTOK * DFF * 2 <= WS_END, "ws map (activations)");
constexpr int CW_BAR = 4096;

constexpr int LDS_BYTES = 163840;
constexpr int MISC_OFF = LDS_BYTES - 256;
constexpr int NWAVES = 8;

#define RLX_AGENT __ATOMIC_RELAXED, __HIP_MEMORY_SCOPE_AGENT
#define LDS_WAIT() asm volatile("s_waitcnt lgkmcnt(0)" ::: "memory")
#define VM_WAIT() asm volatile("s_waitcnt vmcnt(0)" ::: "memory")
__device__ __forceinline__ unsigned cvt_pk_bf16(float lo, float hi) { unsigned r; asm volatile("v_cvt_pk_bf16_f32 %0, %1, %2" : "=v"(r) : "v"(lo), "v"(hi)); return r; }
__device__ __forceinline__ float bf_lo(unsigned w) { return __builtin_bit_cast(float, w << 16); }
__device__ __forceinline__ float bf_hi(unsigned w) { return __builtin_bit_cast(float, w & 0xffff0000u); }
__device__ __forceinline__ float bf2f(bf16 h) { return __builtin_bit_cast(float, (unsigned)h << 16); }
__device__ __forceinline__ bf16 f2bf(float f) { return (bf16)(cvt_pk_bf16(f, 0.f) & 0xffffu); }
#ifndef MK_F16
#define MK_F16 1
#endif
typedef _Float16 h16x2 __attribute__((ext_vector_type(2)));
typedef _Float16 h16x8 __attribute__((ext_vector_type(8)));
typedef float f32x16_t __attribute__((ext_vector_type(16)));
#if MK_F16
__device__ __forceinline__ unsigned pk_act(float lo, float hi) { h16x2 v; v[0] = (_Float16)lo; v[1] = (_Float16)hi; return __builtin_bit_cast(unsigned, v); }
__device__ __forceinline__ float lo_act(unsigned w) { return (float)__builtin_bit_cast(h16x2, w)[0]; }
__device__ __forceinline__ float hi_act(unsigned w) { return (float)__builtin_bit_cast(h16x2, w)[1]; }
__device__ __forceinline__ float act2f(bf16 h) { return (float)__builtin_bit_cast(_Float16, h); }
__device__ __forceinline__ bf16 f2act(float f) { return __builtin_bit_cast(bf16, (_Float16)f); }
__device__ __forceinline__ f32x4 mma16_act(bf16x8 a, bf16x8 b, f32x4 c) { return __builtin_amdgcn_mfma_f32_16x16x32_f16(__builtin_bit_cast(h16x8, a), __builtin_bit_cast(h16x8, b), c, 0, 0, 0); }
__device__ __forceinline__ f32x16_t mma32_act(bf16x8 a, bf16x8 b, f32x16_t c) { return __builtin_amdgcn_mfma_f32_32x32x16_f16(__builtin_bit_cast(h16x8, a), __builtin_bit_cast(h16x8, b), c, 0, 0, 0); }
#else
__device__ __forceinline__ unsigned pk_act(float lo, float hi) { return cvt_pk_bf16(lo, hi); }
__device__ __forceinline__ float lo_act(unsigned w) { return bf_lo(w); }
__device__ __forceinline__ float hi_act(unsigned w) { return bf_hi(w); }
__device__ __forceinline__ float act2f(bf16 h) { return bf2f(h); }
__device__ __forceinline__ bf16 f2act(float f) { return f2bf(f); }
__device__ __forceinline__ f32x4 mma16_act(bf16x8 a, bf16x8 b, f32x4 c) { return __builtin_amdgcn_mfma_f32_16x16x32_bf16(a, b, c, 0, 0, 0); }
__device__ __forceinline__ f32x16_t mma32_act(bf16x8 a, bf16x8 b, f32x16_t c) { return __builtin_amdgcn_mfma_f32_32x32x16_bf16(a, b, c, 0, 0, 0); }
#endif
template <int M> __device__ __forceinline__ float swz_xor(float v) { return __builtin_bit_cast(float, __builtin_amdgcn_ds_swizzle(__builtin_bit_cast(int, v), (M << 10) | 0x1f)); }
__device__ __forceinline__ float half_sum(float v) { v += swz_xor<1>(v); v += swz_xor<2>(v); v += swz_xor<4>(v); v += swz_xor<8>(v); v += swz_xor<16>(v); return v; }
__device__ __forceinline__ float wave_sum(float v) { v = half_sum(v);
    auto rr = __builtin_amdgcn_permlane32_swap(__float_as_uint(v), __float_as_uint(v), false, false); return __uint_as_float(rr[0]) + __uint_as_float(rr[1]); }
__device__ __forceinline__ float sigmoidf_(float x) { return __builtin_amdgcn_rcpf(1.f + __expf(-x)); }
__device__ __forceinline__ float siluf_(float x) { return x * sigmoidf_(x); }
__device__ __forceinline__ int opaque_tid() { int t = threadIdx.x; asm volatile("" : "+v"(t)); return t; }
__device__ __forceinline__ int mod_row(int r) { return r < NCTX ? 0 : 1 + ((r - NCTX) >> 10); }

namespace pg8 {
#define PG8_LAS __attribute__((address_space(3)))
typedef unsigned short bf16_t;
constexpr int BM = 256, BK = 64, HALF = 128, HTB = HALF * BK * 2  , STAGE_BYTES = 8 * HTB, NXCD = 8, WGM = 8;

__host__ __device__ __forceinline__ int lds_byte(int r, int c) { const int st = (r >> 4) * 2 + (c >> 5), rr = r & 15, cc = c & 31, ob = rr * 64 + cc * 2; return st * 1024 + (ob ^ (((ob >> 9) & 1) << 5)); }
__host__ __device__ __forceinline__ void stage_rc(int b, int& R, int& C) { const int st = b / 1024, sb = b % 1024, swz = sb ^ (((sb >> 9) & 1) << 5); R = (st >> 1) * 16 + swz / 64; C = (st & 1) * 32 + (swz % 64) / 2; }
__host__ __device__ __forceinline__ int perm32(int rho) { const int n = rho >> 4, i = rho & 15; return 8 * (i >> 2) + 4 * n + (i & 3); }

struct Unit { int pm, pn; };
struct Gemm { const bf16_t* A; const bf16_t* Bt; int M, N, K; };

struct StaticOrder {
    int nM, nN, nwg, G, c;
    __host__ __device__ void init(int M, int N, int G_, int c_) { nM = M / BM; nN = N / BM; nwg = nM * nN; G = G_; c = c_; }
    __host__ __device__ bool next(int i, Unit& u) const {
        const long L = (long)i * G + c; if (L >= nwg) return false;
        int wgid = (int)L; { const int q = nwg / NXCD, r = nwg % NXCD, xcd = wgid % NXCD, off = wgid / NXCD; wgid = (xcd < r ? xcd * (q + 1) : r * (q + 1) + (xcd - r) * q) + off; }
        const int nig = WGM * nN, gid = wgid / nig, fm = gid * WGM, gsz = (nM - fm) < WGM ? (nM - fm) : WGM;
        u.pm = fm + ((wgid % nig) % gsz); u.pn = (wgid % nig) / gsz; return true;
    }
    __device__ __forceinline__ void a_ready(const Unit&) const {}
    __device__ __forceinline__ void done(const Unit&) const {}
};

template <class Epi, class Sched, bool ALIGN_EPI = false, bool SP2 = false>
__device__ __forceinline__ void gemm_phase(PG8_LAS unsigned char* lds, const Gemm g, const Sched& S, const Epi& E) {
    const int tid = opaque_tid(), wid = __builtin_amdgcn_readfirstlane(tid >> 6), lane = tid & 63, wr = wid >> 2, wc = wid & 3, fr = lane & 15, fq = lane >> 4;
    const int K = g.K, nt = K / BK;
    unsigned voffA[2], voffB[2];
#pragma unroll
    for (int i = 0; i < 2; ++i) { int R, C; stage_rc(tid * 16 + i * 8192, R, C); const int Rb = Epi::PERM ? ((R & ~31) + perm32(R & 31)) : R;
        voffA[i] = (unsigned)(R * K + C) * 2u; voffB[i] = (unsigned)(Rb * K + C) * 2u; }
    const size_t kstep = (size_t)(BK * 2);
    const size_t hstep = (size_t)HALF * K * 2;
    const size_t tstep = 2 * hstep;
    const unsigned ldsw = (unsigned)wid * 1024u;
    const int aoff = lds_byte(wr * 64 + fr, fq * 8), boff = lds_byte(wc * 32 + fr, fq * 8);
#define PG8_SA(b, h) (((b) * 2 + (h)) * HTB)
#define PG8_SB(b, h) ((4 + (b) * 2 + (h)) * HTB)
#define PG8_STAGE(bufoff, gbase, voff) do { _Pragma("unroll") for (int _i = 0; _i < 2; ++_i) \
        __builtin_amdgcn_global_load_lds((const unsigned*)((const char*)(gbase) + (voff)[_i]), (PG8_LAS unsigned*)(lds + (bufoff) + ldsw + _i * 8192), 16, 0, 0); } while (0)
#define PG8_LDA(dst, b, h) do { _Pragma("unroll") for (int m = 0; m < 4; ++m) _Pragma("unroll") for (int k = 0; k < 2; ++k) dst[m][k] = *(const PG8_LAS bf16x8*)(lds + PG8_SA(b, h) + aoff + m * 2048 + k * 1024); } while (0)
#define PG8_LDB(dst, b, h) do { _Pragma("unroll") for (int n = 0; n < 2; ++n) _Pragma("unroll") for (int k = 0; k < 2; ++k) dst[n][k] = *(const PG8_LAS bf16x8*)(lds + PG8_SB(b, h) + boff + n * 2048 + k * 1024); } while (0)
#define PG8_MMA(ai, bj, At, Bt) do { __builtin_amdgcn_s_setprio(1); _Pragma("unroll") for (int m = 0; m < 4; ++m) _Pragma("unroll") for (int n = 0; n < 2; ++n) _Pragma("unroll") for (int k = 0; k < 2; ++k) \
        acc[ai][bj][m][n] = mma16_act(Bt[n][k], At[m][k], acc[ai][bj][m][n]); __builtin_amdgcn_s_setprio(0); } while (0)
#define PG8_WAIT_V(n) asm volatile("s_waitcnt vmcnt(" #n ")" ::: "memory")
#define PG8_WAIT_L(n) asm volatile("s_waitcnt lgkmcnt(" #n ")" ::: "memory")
#define PG8_BAR __builtin_amdgcn_s_barrier()
#define PG8_SCHED __builtin_amdgcn_sched_barrier(0)
    Unit cur, nxt; int ui = 0;
    if (!S.next(0, cur)) return;
    f32x4 acc[2][2][4][2];
#pragma unroll
    for (int a = 0; a < 2; ++a)
#pragma unroll
        for (int b = 0; b < 2; ++b)
#pragma unroll
            for (int m = 0; m < 4; ++m)
#pragma unroll
                for (int n = 0; n < 2; ++n) acc[a][b][m][n] = (f32x4){0.f, 0.f, 0.f, 0.f};
    bf16x8 At[4][2], B0[2][2], B1[2][2];
    const char* cA = (const char*)g.A + (size_t)cur.pm * tstep; const char* cB = (const char*)g.Bt + (size_t)cur.pn * tstep;
    S.a_ready(cur);
    if constexpr (SP2) {
        PG8_STAGE(PG8_SB(0, 0), cB, voffB); PG8_STAGE(PG8_SB(0, 1), cB + hstep, voffB); PG8_STAGE(PG8_SA(0, 0), cA, voffA); PG8_STAGE(PG8_SA(0, 1), cA + hstep, voffA);
        if (wr == 1) PG8_BAR;
        PG8_WAIT_V(2); PG8_BAR;
        PG8_STAGE(PG8_SB(1, 0), cB + kstep, voffB); PG8_STAGE(PG8_SA(1, 0), cA + kstep, voffA); PG8_STAGE(PG8_SB(1, 1), cB + hstep + kstep, voffB);
        PG8_WAIT_V(6); PG8_BAR;
    } else {
        PG8_STAGE(PG8_SB(0, 0), cB, voffB); PG8_STAGE(PG8_SA(0, 0), cA, voffA); PG8_STAGE(PG8_SB(0, 1), cB + hstep, voffB); PG8_STAGE(PG8_SA(0, 1), cA + hstep, voffA);
        if (wr == 1) PG8_BAR;
        PG8_WAIT_V(4); PG8_BAR;
        PG8_STAGE(PG8_SB(1, 0), cB + kstep, voffB); PG8_STAGE(PG8_SA(1, 0), cA + kstep, voffA); PG8_STAGE(PG8_SB(1, 1), cB + hstep + kstep, voffB);
        PG8_WAIT_V(6); PG8_BAR;
    }
    for (;;) {
        const bool has_next = S.next(ui + 1, nxt);
        const char* nA = has_next ? (const char*)g.A + (size_t)nxt.pm * tstep : cA; const char* nB = has_next ? (const char*)g.Bt + (size_t)nxt.pn * tstep : cB;
#pragma unroll
        for (int sgi = 0; sgi < Epi::NSEG; ++sgi) {
        const int t_beg = sgi == 0 ? 0 : Epi::seg_end(sgi - 1), t_end = sgi == Epi::NSEG - 1 ? nt : Epi::seg_end(sgi);
        for (int t = t_beg; t < t_end; t += 2) {
            const bool last = (t == nt - 2);
            const char* a1 = cA + (size_t)(t + 1) * kstep;
            const char* a2 = last ? nA : cA + (size_t)(t + 2) * kstep; const char* b2 = last ? nB : cB + (size_t)(t + 2) * kstep;
            const char* a3 = a2 + kstep; const char* b3 = b2 + kstep;
            if (last && has_next) S.a_ready(nxt);
            if constexpr (SP2) {
            PG8_LDB(B0, 0, 0); PG8_LDB(B1, 0, 1); PG8_SCHED; PG8_LDA(At, 0, 0); PG8_STAGE(PG8_SA(1, 1), a1 + hstep, voffA);
            PG8_WAIT_V(8); PG8_WAIT_L(0); PG8_BAR; PG8_MMA(0, 0, At, B0); PG8_MMA(0, 1, At, B1); PG8_BAR; PG8_SCHED;
            PG8_LDA(At, 0, 1); PG8_STAGE(PG8_SB(0, 0), b2, voffB); PG8_STAGE(PG8_SB(0, 1), b2 + hstep, voffB); PG8_STAGE(PG8_SA(0, 0), a2, voffA);
            PG8_WAIT_V(8); PG8_WAIT_L(0); PG8_BAR; PG8_MMA(1, 0, At, B0); PG8_MMA(1, 1, At, B1); PG8_BAR; PG8_SCHED;
            PG8_LDB(B0, 1, 0); PG8_LDB(B1, 1, 1); PG8_SCHED; PG8_LDA(At, 1, 0); PG8_STAGE(PG8_SA(0, 1), a2 + hstep, voffA);
            PG8_WAIT_V(8); PG8_WAIT_L(0); PG8_BAR; PG8_MMA(0, 0, At, B0); PG8_MMA(0, 1, At, B1); PG8_BAR; PG8_SCHED;
            PG8_LDA(At, 1, 1); PG8_STAGE(PG8_SB(1, 0), b3, voffB); PG8_STAGE(PG8_SB(1, 1), b3 + hstep, voffB); PG8_STAGE(PG8_SA(1, 0), a3, voffA);
            PG8_WAIT_V(8); PG8_WAIT_L(0); PG8_BAR; PG8_MMA(1, 0, At, B0); PG8_MMA(1, 1, At, B1); PG8_BAR; PG8_SCHED;
            } else {
            PG8_LDB(B0, 0, 0); PG8_SCHED; PG8_LDA(At, 0, 0); PG8_STAGE(PG8_SA(1, 1), a1 + hstep, voffA);
            PG8_WAIT_L(8); PG8_BAR; PG8_WAIT_L(0); PG8_MMA(0, 0, At, B0); PG8_BAR; PG8_SCHED;
            PG8_LDB(B1, 0, 1); PG8_STAGE(PG8_SB(0, 0), b2, voffB);
            PG8_BAR; PG8_WAIT_L(0); PG8_MMA(0, 1, At, B1); PG8_BAR;
            PG8_LDA(At, 0, 1); PG8_STAGE(PG8_SA(0, 0), a2, voffA);
            PG8_BAR; PG8_WAIT_L(0); PG8_MMA(1, 0, At, B0); PG8_BAR; PG8_SCHED;
            PG8_STAGE(PG8_SB(0, 1), b2 + hstep, voffB);
            PG8_WAIT_V(6); PG8_BAR; PG8_MMA(1, 1, At, B1); PG8_BAR;
            PG8_LDB(B0, 1, 0); PG8_SCHED; PG8_LDA(At, 1, 0); PG8_STAGE(PG8_SA(0, 1), a2 + hstep, voffA);
            PG8_WAIT_L(8); PG8_BAR; PG8_WAIT_L(0); PG8_MMA(0, 0, At, B0); PG8_BAR; PG8_SCHED;
            PG8_LDB(B1, 1, 1); PG8_STAGE(PG8_SB(1, 0), b3, voffB);
            PG8_BAR; PG8_WAIT_L(0); PG8_MMA(0, 1, At, B1); PG8_BAR;
            PG8_LDA(At, 1, 1); PG8_STAGE(PG8_SA(1, 0), a3, voffA);
            PG8_BAR; PG8_WAIT_L(0); PG8_MMA(1, 0, At, B0); PG8_BAR; PG8_SCHED;
            PG8_STAGE(PG8_SB(1, 1), b3 + hstep, voffB);
            PG8_WAIT_V(6); PG8_BAR; PG8_MMA(1, 1, At, B1); PG8_BAR;
            }
        }
        if constexpr (Epi::NSEG > 1) { if (sgi < Epi::NSEG - 1) E.mid(acc, cur, sgi, wr, wc, fr, fq); }
        }
        if constexpr (ALIGN_EPI) { if (wr == 0) PG8_BAR; }
        E(acc, cur, wr, wc, fr, fq); S.done(cur);
        if (!has_next) break;
#pragma unroll
        for (int a = 0; a < 2; ++a)
#pragma unroll
            for (int b = 0; b < 2; ++b)
#pragma unroll
                for (int m = 0; m < 4; ++m)
#pragma unroll
                    for (int n = 0; n < 2; ++n) acc[a][b][m][n] = (f32x4){0.f, 0.f, 0.f, 0.f};
        cur = nxt; cA = nA; cB = nB; ++ui;
        if constexpr (ALIGN_EPI) { if (wr == 1) PG8_BAR; }
    }
    PG8_WAIT_V(0);
    if constexpr (!ALIGN_EPI) { if (wr == 0) PG8_BAR; }
    PG8_BAR;
#undef PG8_SA
#undef PG8_SB
#undef PG8_STAGE
#undef PG8_LDA
#undef PG8_LDB
#undef PG8_MMA
#undef PG8_WAIT_V
#undef PG8_WAIT_L
#undef PG8_BAR
#undef PG8_SCHED
}

struct EpiStoreBf16 {
    static constexpr bool PERM = true; static constexpr int NSEG = 1; static constexpr int seg_end(int) { return 0; }
    bf16_t* O; int ldc;
    __device__ __forceinline__ void operator()(f32x4 (&acc)[2][2][4][2], const Unit& u, int wr, int wc, int fr, int fq) const {
        bf16_t* base = O + (size_t)(u.pm * BM + wr * 64 + fr) * ldc + u.pn * BM + wc * 32 + 8 * fq;
#pragma unroll
        for (int ai = 0; ai < 2; ++ai)
#pragma unroll
            for (int m = 0; m < 4; ++m) { bf16_t* rowp = base + (size_t)(ai * HALF + m * 16) * ldc;
#pragma unroll
                for (int bj = 0; bj < 2; ++bj) { const f32x4 v0 = acc[ai][bj][m][0], v1 = acc[ai][bj][m][1];
                    u32x4 w; w.x = pk_act(v0[0], v0[1]); w.y = pk_act(v0[2], v0[3]); w.z = pk_act(v1[0], v1[1]); w.w = pk_act(v1[2], v1[3]);
                    *(u32x4*)(rowp + bj * HALF) = w; } }
    }
};
struct EpiDft {
    static constexpr bool PERM = true; static constexpr int NSEG = 1; static constexpr int seg_end(int) { return 0; }
    bf16_t* AM; int tshift, tokbase;
    __device__ __forceinline__ void operator()(f32x4 (&acc)[2][2][4][2], const Unit& u, int wr, int wc, int fr, int fq) const {
        const int k0 = u.pm * BM, part = k0 >> tshift, kk0 = k0 & ((1 << tshift) - 1), b = u.pn >> 2, ch0 = (u.pn & 3) * BM;
        bf16_t* base = AM + (size_t)(tokbase + (b << tshift) + kk0 + wr * 64 + fr) * KMRG + part * 1024 + ch0 + wc * 32 + 8 * fq;
#pragma unroll
        for (int ai = 0; ai < 2; ++ai)
#pragma unroll
            for (int m = 0; m < 4; ++m) { bf16_t* rowp = base + (size_t)(ai * HALF + m * 16) * KMRG;
#pragma unroll
                for (int bj = 0; bj < 2; ++bj) { const f32x4 v0 = acc[ai][bj][m][0], v1 = acc[ai][bj][m][1];
                    u32x4 w; w.x = pk_act(v0[0], v0[1]); w.y = pk_act(v0[2], v0[3]); w.z = pk_act(v1[0], v1[1]); w.w = pk_act(v1[2], v1[3]);
                    *(u32x4*)(rowp + bj * HALF) = w; } }
    }
};
struct EpiMerged {
    static constexpr bool PERM = true; static constexpr int NSEG = 3; static constexpr int seg_end(int s) { return s == 0 ? 32 : 48; }
    bf16_t* O; const bf16_t* Z;
    __device__ __forceinline__ void scale_by(f32x4 (&acc)[2][2][4][2], const Unit& u, int wr, int wc, int fr, int fq, int gnum, int gden) const {
        int lo_ = fr * NZ + 8 * fq; asm volatile("" : "+v"(lo_));
        const bf16_t* zb = Z + (size_t)(u.pm * BM + wr * 64) * NZ + ZGATE + u.pn * BM + wc * 32 + lo_;
#pragma unroll
        for (int ai = 0; ai < 2; ++ai) {
            u32x4 gn[4][2], gd[4][2];
#pragma unroll
            for (int m = 0; m < 4; ++m)
#pragma unroll
                for (int bj = 0; bj < 2; ++bj) { const bf16_t* zr = zb + (size_t)(ai * HALF + m * 16) * NZ + bj * HALF;
                    gn[m][bj] = *(const u32x4*)(zr + gnum * DM); if (gden >= 0) gd[m][bj] = *(const u32x4*)(zr + gden * DM); else gd[m][bj] = (u32x4){0u, 0u, 0u, 0u}; }
#pragma unroll
            for (int m = 0; m < 4; ++m)
#pragma unroll
                for (int bj = 0; bj < 2; ++bj) {
                    float s[8];
#pragma unroll
                    for (int q = 0; q < 4; ++q) {
                        const float n0 = 1.f + __expf(-lo_act(gn[m][bj][q])), n1 = 1.f + __expf(-hi_act(gn[m][bj][q]));
                        float d0 = 1.f, d1 = 1.f; if (gden >= 0) { d0 = 1.f + __expf(-lo_act(gd[m][bj][q])); d1 = 1.f + __expf(-hi_act(gd[m][bj][q])); }
                        s[2 * q] = d0 * __builtin_amdgcn_rcpf(n0); s[2 * q + 1] = d1 * __builtin_amdgcn_rcpf(n1); }
                    f32x4 v0 = acc[ai][bj][m][0], v1 = acc[ai][bj][m][1];
                    v0[0] *= s[0]; v0[1] *= s[1]; v0[2] *= s[2]; v0[3] *= s[3]; v1[0] *= s[4]; v1[1] *= s[5]; v1[2] *= s[6]; v1[3] *= s[7];
                    acc[ai][bj][m][0] = v0; acc[ai][bj][m][1] = v1; }
            asm volatile("" ::: "memory"); }
    }
    __device__ __forceinline__ void mid(f32x4 (&acc)[2][2][4][2], const Unit& u, int s, int wr, int wc, int fr, int fq) const {
        if (s == 0) scale_by(acc, u, wr, wc, fr, fq, 0, 1); else scale_by(acc, u, wr, wc, fr, fq, 1, 2);
    }
    __device__ __forceinline__ void operator()(f32x4 (&acc)[2][2][4][2], const Unit& u, int wr, int wc, int fr, int fq) const {
        scale_by(acc, u, wr, wc, fr, fq, 2, -1);
        bf16_t* base = O + (size_t)(u.pm * BM + wr * 64 + fr) * DM + u.pn * BM + wc * 32 + 8 * fq;
#pragma unroll
        for (int ai = 0; ai < 2; ++ai)
#pragma unroll
            for (int m = 0; m < 4; ++m) { bf16_t* rowp = base + (size_t)(ai * HALF + m * 16) * DM;
#pragma unroll
                for (int bj = 0; bj < 2; ++bj) { const f32x4 v0 = acc[ai][bj][m][0], v1 = acc[ai][bj][m][1];
                    u32x4 w; w.x = pk_act(v0[0], v0[1]); w.y = pk_act(v0[2], v0[3]); w.z = pk_act(v1[0], v1[1]); w.w = pk_act(v1[2], v1[3]);
                    *(u32x4*)(rowp + bj * HALF) = w; } }
    }
};
struct EpiResid {
    static constexpr bool PERM = false; static constexpr int NSEG = 1; static constexpr int seg_end(int) { return 0; }
    float* X; const float* gate;
    __device__ __forceinline__ void operator()(f32x4 (&acc)[2][2][4][2], const Unit& u, int wr, int wc, int fr, int fq) const {
        int lo_ = fr * DM + 4 * fq; asm volatile("" : "+v"(lo_));
        const int col0 = u.pn * BM + wc * 32;
        const float* gp = gate + (size_t)mod_row(u.pm * BM) * NMOD + col0 + 4 * fq;
        float* xb = X + (size_t)(u.pm * BM + wr * 64) * DM + col0 + lo_;
        f32x4 gv[2][2];
#pragma unroll
        for (int bj = 0; bj < 2; ++bj)
#pragma unroll
            for (int n = 0; n < 2; ++n) gv[bj][n] = *(const f32x4*)(gp + bj * HALF + n * 16);
#pragma unroll
        for (int ai = 0; ai < 2; ++ai) {
            f32x4 xv[4][2][2];
#pragma unroll
            for (int m = 0; m < 4; ++m)
#pragma unroll
                for (int bj = 0; bj < 2; ++bj)
#pragma unroll
                    for (int n = 0; n < 2; ++n) xv[m][bj][n] = *(const f32x4*)(xb + (size_t)(ai * HALF + m * 16) * DM + bj * HALF + n * 16);
#pragma unroll
            for (int m = 0; m < 4; ++m)
#pragma unroll
                for (int bj = 0; bj < 2; ++bj)
#pragma unroll
                    for (int n = 0; n < 2; ++n) *(f32x4*)(xb + (size_t)(ai * HALF + m * 16) * DM + bj * HALF + n * 16) = xv[m][bj][n] + gv[bj][n] * acc[ai][bj][m][n];
            asm volatile("" ::: "memory"); }
    }
};
}

namespace att {
constexpr int D = 128, NW = 8, QBLK = 32, KVBLK = 64;
constexpr float SCALE = 0.088388347648318440f;
constexpr float THR = 8.f;
constexpr int LDQ = 1024, LDK = 256, LDO = KMRG;
constexpr int SHM_V = KVBLK * D * 2, SHM_K = KVBLK * D * 2, SHM_ATTN = 2 * SHM_V + 2 * SHM_K + NW * 64 * 4;
typedef __attribute__((ext_vector_type(4))) short s16x4;
typedef __attribute__((ext_vector_type(16))) float f32x16;
#define KSWZ(row, colB) ((row) * 256 + ((colB) ^ (((row) & 7) << 4)))
#define SBAR() __builtin_amdgcn_sched_barrier(0)
__device__ __forceinline__ int crow(int r, int hi) { return (r & 3) + 8 * (r >> 2) + 4 * hi; }

__device__ __forceinline__ void partialSM(f32x16& p0, f32x16& p1, float& m_reg, float& mn, float& alpha) {
  constexpr float C = SCALE * 1.4426950408889634f;
  float pmax = p0[0];
#pragma unroll
  for (int r = 1; r < 16; ++r) pmax = fmaxf(pmax, p0[r]);
#pragma unroll
  for (int r = 0; r < 16; ++r) pmax = fmaxf(pmax, p1[r]);
  { auto rr = __builtin_amdgcn_permlane32_swap(__float_as_uint(pmax), __float_as_uint(pmax), false, false);
    pmax = fmaxf(__uint_as_float(rr[0]), __uint_as_float(rr[1])); }
  if (__builtin_expect(__all(pmax - m_reg <= THR / SCALE), 1)) { mn = m_reg; alpha = 1.f; }
  else { mn = fmaxf(m_reg, pmax); alpha = __builtin_amdgcn_exp2f((m_reg - mn) * C); m_reg = mn; }
  float mnC = -mn * C;
#pragma unroll
  for (int r = 0; r < 16; ++r) p0[r] = fmaf(p0[r], C, mnC);
#pragma unroll
  for (int r = 0; r < 16; ++r) p1[r] = fmaf(p1[r], C, mnC);
#pragma unroll
  for (int r = 0; r < 16; ++r) p0[r] = __builtin_amdgcn_exp2f(p0[r]);
}
__device__ __forceinline__ void finishSM(f32x16& p0, f32x16& p1, float alpha, float& l_reg, bf16x8& pa0, bf16x8& pa1, bf16x8& pa2, bf16x8& pa3) {
#pragma unroll
  for (int r = 0; r < 16; ++r) p1[r] = __builtin_amdgcn_exp2f(p1[r]);
  float ps = 0;
#pragma unroll
  for (int r = 0; r < 16; ++r) ps += p0[r];
#pragma unroll
  for (int r = 0; r < 16; ++r) ps += p1[r];
  { auto rr = __builtin_amdgcn_permlane32_swap(__float_as_uint(ps), __float_as_uint(ps), false, false);
    ps = __uint_as_float(rr[0]) + __uint_as_float(rr[1]); }
  l_reg = l_reg * alpha + ps;
#define PK4(P, BASE, OUT) do { unsigned a0 = pk_act(P[BASE + 0], P[BASE + 1]), a1 = pk_act(P[BASE + 2], P[BASE + 3]);   \
    unsigned b0 = pk_act(P[BASE + 4], P[BASE + 5]), b1 = pk_act(P[BASE + 6], P[BASE + 7]);                              \
    auto r0 = __builtin_amdgcn_permlane32_swap(a0, b0, false, false); auto r1 = __builtin_amdgcn_permlane32_swap(a1, b1, false, false); \
    u32x4 w = {r0[0], r1[0], r0[1], r1[1]}; OUT = *reinterpret_cast<bf16x8*>(&w); } while (0)
  PK4(p0, 0, pa0); PK4(p0, 8, pa1); PK4(p1, 0, pa2); PK4(p1, 8, pa3);
#undef PK4
}
__device__ __forceinline__ void qkt(f32x16& p0, f32x16& p1, const LAS char* Ks, const bf16x8* qr, int r32, int hi) {
  p0 = f32x16{}; p1 = f32x16{};
#pragma unroll
  for (int d0 = 0; d0 < 8; ++d0) { int cb = (d0 * 16 + hi * 8) * 2;
    bf16x8 b0 = *reinterpret_cast<const LAS bf16x8*>(Ks + KSWZ(r32, cb));
    bf16x8 b1 = *reinterpret_cast<const LAS bf16x8*>(Ks + KSWZ(32 + r32, cb));
    p0 = mma32_act(b0, qr[d0], p0);
    p1 = mma32_act(b1, qr[d0], p1); }
}
__device__ __forceinline__ int v_st(int k, int c) { const int kk = (k & ~0xC) | ((k & 4) << 1) | ((k & 8) >> 1); return ((kk >> 3) * 4 + (c >> 5)) * 512 + ((kk & 7) * 32 + (c & 31)) * 2; }
__device__ __forceinline__ int v_rd_base(int lane) { return ((lane & 3) << 3) | (((lane >> 2) & 3) << 6) | (((lane >> 4) & 1) << 5) | (((lane >> 5) & 1) << 8); }
constexpr int v_rd_off(int d0, int ks, int half) { return d0 * 512 + ks * 4096 + half * 2048; }
template <int OFF> __device__ __forceinline__ s16x4 tr_read(int vb) {
  s16x4 r; asm volatile("ds_read_b64_tr_b16 %0, %1 offset:%2" : "=&v"(r) : "v"(vb), "i"(OFF) : "memory"); return r;
}
template <int D0> __device__ __forceinline__ void pv_one(f32x16& od, int vb, bf16x8 pa0, bf16x8 pa1, bf16x8 pa2, bf16x8 pa3) {
  const s16x4 l0 = tr_read<v_rd_off(D0, 0, 0)>(vb), h0 = tr_read<v_rd_off(D0, 0, 1)>(vb), l1 = tr_read<v_rd_off(D0, 1, 0)>(vb), h1 = tr_read<v_rd_off(D0, 1, 1)>(vb);
  const s16x4 l2 = tr_read<v_rd_off(D0, 2, 0)>(vb), h2 = tr_read<v_rd_off(D0, 2, 1)>(vb), l3 = tr_read<v_rd_off(D0, 3, 0)>(vb), h3 = tr_read<v_rd_off(D0, 3, 1)>(vb);
  asm volatile("s_waitcnt lgkmcnt(0)" ::: "memory"); SBAR();
#define PK(L, H) (bf16x8){L[0], L[1], L[2], L[3], H[0], H[1], H[2], H[3]}
  od = mma32_act(pa0, PK(l0, h0), od);
  od = mma32_act(pa1, PK(l1, h1), od);
  od = mma32_act(pa2, PK(l2, h2), od);
  od = mma32_act(pa3, PK(l3, h3), od);
#undef PK
}
__device__ __forceinline__ void pv_d0(f32x16* o, int vb, bf16x8 pa0, bf16x8 pa1, bf16x8 pa2, bf16x8 pa3) {
  pv_one<0>(o[0], vb, pa0, pa1, pa2, pa3); pv_one<1>(o[1], vb, pa0, pa1, pa2, pa3); pv_one<2>(o[2], vb, pa0, pa1, pa2, pa3); pv_one<3>(o[3], vb, pa0, pa1, pa2, pa3);
}

__device__ __forceinline__ void attn_dense_body(const bf16* __restrict__ Qb, const bf16* __restrict__ Kh, const bf16* __restrict__ Vh,
                                                bf16* __restrict__ Ob, int seq, LAS char* lds) {
  const int tid = opaque_tid(), wid = tid >> 6, lane = tid & 63, r32 = lane & 31, hi = lane >> 5;
  LAS char* V_lds = lds; LAS char* K_lds = lds + 2 * SHM_V;
  LAS float* ws = (LAS float*)(lds + 2 * SHM_V + 2 * SHM_K) + wid * 64; LAS float* li_l = ws; LAS float* al_l = ws + 32;
  float m_reg = -1e30f, l_reg = 0; f32x16 o[4] = {}; bf16x8 qr[8];
  { const bf16* Qw = Qb + (long)(wid * QBLK + r32) * LDQ + hi * 8;
#pragma unroll
    for (int d0 = 0; d0 < 8; ++d0) qr[d0] = *reinterpret_cast<const bf16x8*>(Qw + d0 * 16); }
  const int sr = tid >> 4, sc = (tid & 15) * 8, vst0 = v_st(sr, sc), vst1 = v_st(32 + sr, sc);
  const int vb0 = (int)(unsigned)(uintptr_t)V_lds + v_rd_base(lane);
  struct { bf16x8 vs0, vs1, ks0, ks1; } sr_[2];
#define SLOAD(i, k0) do { sr_[i].vs0 = *reinterpret_cast<const bf16x8*>(&Vh[(long)((k0) + sr) * LDK + sc]); sr_[i].vs1 = *reinterpret_cast<const bf16x8*>(&Vh[(long)((k0) + 32 + sr) * LDK + sc]); \
    sr_[i].ks0 = *reinterpret_cast<const bf16x8*>(&Kh[(long)((k0) + sr) * LDK + sc]); sr_[i].ks1 = *reinterpret_cast<const bf16x8*>(&Kh[(long)((k0) + 32 + sr) * LDK + sc]); } while (0)
#define SWRITE(b, i) do { *(LAS bf16x8*)(V_lds + (b) * SHM_V + vst0) = sr_[i].vs0;          \
    *(LAS bf16x8*)(V_lds + (b) * SHM_V + vst1) = sr_[i].vs1; int kc = sc * 2;               \
    *(LAS bf16x8*)(K_lds + (b) * SHM_K + KSWZ(sr, kc)) = sr_[i].ks0;                       \
    *(LAS bf16x8*)(K_lds + (b) * SHM_K + KSWZ(32 + sr, kc)) = sr_[i].ks1; } while (0)
#define SWAIT() asm volatile("s_waitcnt vmcnt(4)" ::: "memory")
#define RESC(a) do { if (__any((a) < 1.f)) { if (hi == 0) al_l[r32] = (a); asm volatile("s_waitcnt lgkmcnt(0)" ::: "memory"); \
    _Pragma("unroll") for (int d = 0; d < 4; ++d) _Pragma("unroll") for (int r = 0; r < 16; ++r) o[d][r] *= al_l[crow(r, hi)]; } } while (0)
  f32x16 pA0, pA1, pB0, pB1; float mnA, mnB, alA, alB; bf16x8 pa0, pa1, pa2, pa3; const int NT = seq / KVBLK;
  constexpr int SE = 0, SO = 1;
  SLOAD(SE, 0); asm volatile("s_waitcnt vmcnt(0)" ::: "memory"); SWRITE(0, SE); __syncthreads();
  qkt(pA0, pA1, K_lds, qr, r32, hi); partialSM(pA0, pA1, m_reg, mnA, alA);
  SLOAD(SO, KVBLK); if (2 < NT) SLOAD(SE, 2 * KVBLK);
  SWAIT(); SWRITE(1, SO); __syncthreads();
  for (int j = 1; j + 1 < NT; j += 2) {
    SBAR(); qkt(pB0, pB1, K_lds + SHM_K, qr, r32, hi);
    finishSM(pA0, pA1, alA, l_reg, pa0, pa1, pa2, pa3); SBAR();
    SLOAD(SO, (j + 2) * KVBLK); SBAR();
    pv_d0(o, vb0, pa0, pa1, pa2, pa3); partialSM(pB0, pB1, m_reg, mnB, alB);
    __syncthreads(); SWAIT(); SWRITE(0, SE);
    RESC(alB); __syncthreads();
    SBAR(); qkt(pA0, pA1, K_lds, qr, r32, hi);
    finishSM(pB0, pB1, alB, l_reg, pa0, pa1, pa2, pa3); SBAR();
    if (j + 3 < NT) SLOAD(SE, (j + 3) * KVBLK); SBAR();
    pv_d0(o, vb0 + (int)SHM_V, pa0, pa1, pa2, pa3); partialSM(pA0, pA1, m_reg, mnA, alA);
    __syncthreads(); SWAIT(); SWRITE(1, SO);
    RESC(alA); __syncthreads();
  }
  SBAR(); qkt(pB0, pB1, K_lds + SHM_K, qr, r32, hi);
  finishSM(pA0, pA1, alA, l_reg, pa0, pa1, pa2, pa3); SBAR();
  pv_d0(o, vb0, pa0, pa1, pa2, pa3); partialSM(pB0, pB1, m_reg, mnB, alB);
  __syncthreads(); RESC(alB);
  finishSM(pB0, pB1, alB, l_reg, pa0, pa1, pa2, pa3); SBAR();
  pv_d0(o, vb0 + (int)SHM_V, pa0, pa1, pa2, pa3);
  if (hi == 0) li_l[r32] = l_reg; asm volatile("s_waitcnt lgkmcnt(0)" ::: "memory");
  float rli[16];
#pragma unroll
  for (int r = 0; r < 16; ++r) rli[r] = __builtin_amdgcn_rcpf(li_l[crow(r, hi)]);
  bf16* Ow = Ob + (long)(wid * QBLK) * LDO;
#pragma unroll
  for (int r = 0; r < 16; ++r) { int orow = crow(r, hi);
#pragma unroll
    for (int d0 = 0; d0 < 4; ++d0) Ow[(long)orow * LDO + d0 * 32 + r32] = f2act(o[d0][r] * rli[r]); }
  __syncthreads();
#undef SLOAD
#undef SWRITE
#undef SWAIT
#undef RESC
}
#undef KSWZ
#undef SBAR
}

namespace gla {
constexpr int L_LA = 0;
constexpr int L_TOT = L_LA + 64 * 132 * 4;
constexpr int L_WG = L_TOT + 2048;
constexpr int L_BG = L_WG + 8192;
constexpr int L_QE = L_BG + 512;
constexpr int L_KE = L_QE + 64 * 136 * 2;
constexpr int L_KLT = L_KE + 64 * 136 * 2;
constexpr int L_ATT = L_KLT + 128 * 72 * 2;
constexpr int L_END1 = L_ATT + 64 * 72 * 2;
constexpr int M_QE = 0, M_ATT = M_QE + 64 * 272, M_KLT = M_ATT + 64 * 144, M_VT = M_KLT + 128 * 144, M_SB = M_VT + 64 * 144, M_EB = M_SB + 64 * 272, M_BUF = M_EB + 512;
static_assert(L_END1 <= MISC_OFF && 2 * M_BUF <= MISC_OFF, "GLA LDS map");
constexpr size_t GW_QE_SZ = 64 * 128, GW_ATT_SZ = 64 * 64, GW_KLT_SZ = 128 * 64, GW_EB_SZ = 128;
constexpr int G1_ITEMS = (NTOK / 64) * 4 * 2;

__device__ __forceinline__ float log_sigmoid(float x) { return fminf(x, 0.f) - __logf(1.f + __expf(-fabsf(x))); }
__device__ __forceinline__ f32x4 mma16(bf16x8 a, bf16x8 b, f32x4 c) { return __builtin_amdgcn_mfma_f32_16x16x32_bf16(a, b, c, 0, 0, 0); }

__device__ __forceinline__ void g1_item(LAS unsigned char* lds, const bf16* __restrict__ Z, const float* __restrict__ wg, const float* __restrict__ bg,
                                        bf16* __restrict__ gQE, bf16* __restrict__ gATT, bf16* __restrict__ gKLT, float* __restrict__ gEB, int row0, int h, int dir) {
    const int tid = opaque_tid(), lane = tid & 63, w = __builtin_amdgcn_readfirstlane(tid >> 6), fr = lane & 15, fq = lane >> 4;
    LAS float* LA = (LAS float*)(lds + L_LA); LAS float* TOT = (LAS float*)(lds + L_TOT);
    LAS float* WG = (LAS float*)(lds + L_WG); LAS float* BG = (LAS float*)(lds + L_BG);
    LAS unsigned char* QE = lds + L_QE; LAS unsigned char* KE = lds + L_KE; LAS unsigned char* KLT = lds + L_KLT; LAS unsigned char* ATT = lds + L_ATT;
    for (int idx = tid; idx < 16 * 128; idx += 512) WG[idx] = wg[(idx >> 7) * 512 + (idx & 127)];
    if (tid < 128) BG[tid] = bg[tid];
    const int i0 = tid >> 4, g8 = tid & 15;
    const int gacol = dir ? ZGAB : ZGAF;
    u32x4 rq[2], rk[2], rga[2][2];
#pragma unroll
    for (int e = 0; e < 2; ++e) { const int i = i0 + 32 * e; const bf16* zr = Z + (size_t)(row0 + (dir ? 63 - i : i)) * NZ;
        rq[e] = *(const u32x4*)(zr + ZGQ + h * 128 + g8 * 8); rk[e] = *(const u32x4*)(zr + ZGK + h * 128 + g8 * 8);
        rga[e][0] = *(const u32x4*)(zr + gacol); rga[e][1] = *(const u32x4*)(zr + gacol + 8); }
    __syncthreads();
#pragma unroll
    for (int e = 0; e < 2; ++e) {
        float x[8];
        { const f32x4 b0 = *(const LAS f32x4*)(BG + g8 * 8), b1 = *(const LAS f32x4*)(BG + g8 * 8 + 4);
#pragma unroll
          for (int j = 0; j < 4; ++j) { x[j] = b0[j]; x[4 + j] = b1[j]; } }
#pragma unroll
        for (int r = 0; r < 16; ++r) { const unsigned wd = rga[e][r >> 3][(r & 7) >> 1]; const float gar = (r & 1) ? hi_act(wd) : lo_act(wd);
            const f32x4 w0 = *(const LAS f32x4*)(WG + r * 128 + g8 * 8), w1 = *(const LAS f32x4*)(WG + r * 128 + g8 * 8 + 4);
#pragma unroll
            for (int j = 0; j < 4; ++j) { x[j] = fmaf(gar, w0[j], x[j]); x[4 + j] = fmaf(gar, w1[j], x[4 + j]); }
            if ((r & 3) == 3) asm volatile("" ::: "memory"); }
        f32x4 o0, o1;
#pragma unroll
        for (int j = 0; j < 4; ++j) { o0[j] = log_sigmoid(x[j]) * 0.0625f; o1[j] = log_sigmoid(x[4 + j]) * 0.0625f; }
        *(LAS f32x4*)(LA + (i0 + 32 * e) * 132 + g8 * 8) = o0; *(LAS f32x4*)(LA + (i0 + 32 * e) * 132 + g8 * 8 + 4) = o1;
    }
    __syncthreads();
    { const int d = tid & 127, seg = tid >> 7; float v[16];
#pragma unroll
      for (int ii = 0; ii < 16; ++ii) v[ii] = LA[(seg * 16 + ii) * 132 + d];
      float run = 0.f;
#pragma unroll
      for (int ii = 0; ii < 16; ++ii) { run += v[ii]; LA[(seg * 16 + ii) * 132 + d] = run; }
      TOT[seg * 128 + d] = run; }
    __syncthreads();
    {
        float t0[8], t1[8], t2[8], t3[8];
        { const f32x4 a0 = *(const LAS f32x4*)(TOT + g8 * 8), a1 = *(const LAS f32x4*)(TOT + g8 * 8 + 4), b0 = *(const LAS f32x4*)(TOT + 128 + g8 * 8), b1 = *(const LAS f32x4*)(TOT + 128 + g8 * 8 + 4);
          const f32x4 c0 = *(const LAS f32x4*)(TOT + 256 + g8 * 8), c1 = *(const LAS f32x4*)(TOT + 256 + g8 * 8 + 4), d0 = *(const LAS f32x4*)(TOT + 384 + g8 * 8), d1 = *(const LAS f32x4*)(TOT + 384 + g8 * 8 + 4);
#pragma unroll
          for (int j = 0; j < 4; ++j) { t0[j] = a0[j]; t0[4 + j] = a1[j]; t1[j] = b0[j]; t1[4 + j] = b1[j]; t2[j] = c0[j]; t2[4 + j] = c1[j]; t3[j] = d0[j]; t3[4 + j] = d1[j]; } }
        float blast[8];
#pragma unroll
        for (int j = 0; j < 8; ++j) blast[j] = (t0[j] + t1[j]) + (t2[j] + t3[j]);
        if (tid < 16) { f32x4 e0, e1;
#pragma unroll
            for (int j = 0; j < 4; ++j) { e0[j] = __expf(blast[j]); e1[j] = __expf(blast[4 + j]); }
            *(f32x4*)(gEB + g8 * 8) = e0; *(f32x4*)(gEB + g8 * 8 + 4) = e1; }
#pragma unroll
        for (int e = 0; e < 2; ++e) {
            const int i = i0 + 32 * e, seg = i >> 4;
            const f32x4 l0 = *(const LAS f32x4*)(LA + i * 132 + g8 * 8), l1 = *(const LAS f32x4*)(LA + i * 132 + g8 * 8 + 4);
            float bq[8], kl[8], qe[8], ke[8], qv[8], kv[8];
#pragma unroll
            for (int q = 0; q < 4; ++q) { qv[2 * q] = lo_act(rq[e][q]); qv[2 * q + 1] = hi_act(rq[e][q]); kv[2 * q] = lo_act(rk[e][q]); kv[2 * q + 1] = hi_act(rk[e][q]); }
#pragma unroll
            for (int j = 0; j < 8; ++j) { float off = 0.f; if (seg > 0) off += t0[j]; if (seg > 1) off += t1[j]; if (seg > 2) off += t2[j];
                bq[j] = (j < 4 ? l0[j] : l1[j - 4]) + off;
                qe[j] = qv[j] * 0.088388347648318440f * __expf(bq[j]); ke[j] = kv[j] * __expf(-bq[j]); kl[j] = kv[j] * __expf(blast[j] - bq[j]); }
            const u32x4 wq = {cvt_pk_bf16(qe[0], qe[1]), cvt_pk_bf16(qe[2], qe[3]), cvt_pk_bf16(qe[4], qe[5]), cvt_pk_bf16(qe[6], qe[7])};
            const u32x4 wk = {cvt_pk_bf16(ke[0], ke[1]), cvt_pk_bf16(ke[2], ke[3]), cvt_pk_bf16(ke[4], ke[5]), cvt_pk_bf16(ke[6], ke[7])};
            *(LAS u32x4*)(QE + i * 272 + g8 * 16) = wq; *(LAS u32x4*)(KE + i * 272 + g8 * 16) = wk;
            *(u32x4*)(gQE + i * 128 + g8 * 8) = wq;
#pragma unroll
            for (int j = 0; j < 8; ++j) *(LAS bf16*)(KLT + (g8 * 8 + j) * 144 + i * 2) = f2bf(kl[j]);
        }
    }
    __syncthreads();
    { const int ti = w >> 1;
#pragma unroll
      for (int jj = 0; jj < 2; ++jj) { const int tj = (w & 1) * 2 + jj; f32x4 a = {0.f, 0.f, 0.f, 0.f};
          if (tj <= ti) {
#pragma unroll
              for (int ks = 0; ks < 4; ++ks) { const bf16x8 af = *(const LAS bf16x8*)(QE + (ti * 16 + fr) * 272 + (ks * 32 + fq * 8) * 2), bfr = *(const LAS bf16x8*)(KE + (tj * 16 + fr) * 272 + (ks * 32 + fq * 8) * 2);
                  a = mma16(af, bfr, a); } }
#pragma unroll
          for (int r = 0; r < 4; ++r) { const int i = ti * 16 + 4 * fq + r, j = tj * 16 + fr; *(LAS bf16*)(ATT + i * 144 + j * 2) = f2bf(j <= i ? a[r] : 0.f); } } }
#pragma unroll
    for (int e = 0; e < 2; ++e) { const int p = tid + 512 * e, row = p >> 3, c8 = p & 7; *(u32x4*)(gKLT + row * 64 + c8 * 8) = *(const LAS u32x4*)(KLT + row * 144 + c8 * 16); }
    __syncthreads();
    { const int row = tid >> 3, c8 = tid & 7; *(u32x4*)(gATT + row * 64 + c8 * 8) = *(const LAS u32x4*)(ATT + row * 144 + c8 * 16); }
    __syncthreads();
}

__device__ __forceinline__ void g2_item(LAS unsigned char* lds, const bf16* __restrict__ Z, float* __restrict__ OUT, const bf16* __restrict__ gQE, const bf16* __restrict__ gATT,
                                        const bf16* __restrict__ gKLT, const float* __restrict__ gEB, const float* __restrict__ st_in, float* __restrict__ st_out,
                                        int T, int tokbase, int h, int dir, int dvq) {
    const int tid = opaque_tid(), lane = tid & 63, w = __builtin_amdgcn_readfirstlane(tid >> 6), fr = lane & 15, fq = lane >> 4;
    const int NC = T >> 6;
    f32x4 S[4];
    const int soff = (16 * w + 4 * fq) * 256 + dvq * 64 + fr;
#pragma unroll
    for (int n = 0; n < 4; ++n) S[n] = (f32x4){0.f, 0.f, 0.f, 0.f};
    if (st_in) {
#pragma unroll
        for (int n = 0; n < 4; ++n)
#pragma unroll
            for (int r = 0; r < 4; ++r) S[n][r] = st_in[soff + r * 256 + n * 16];
    }
    const int iv = tid >> 3, vg = tid & 7;
    u32x4 pq[2], pk[2], pa, pv; float peb = 0.f;
#define G2_LOAD(cs) do { const int cf_ = dir ? NC - 1 - (cs) : (cs); const size_t gi_ = ((size_t)((tokbase >> 6) + cf_) * 4 + h) * 2 + dir; \
        const bf16* q_ = gQE + gi_ * GW_QE_SZ; const bf16* k_ = gKLT + gi_ * GW_KLT_SZ; \
        pq[0] = *(const u32x4*)(q_ + tid * 8); pq[1] = *(const u32x4*)(q_ + (tid + 512) * 8); pk[0] = *(const u32x4*)(k_ + tid * 8); pk[1] = *(const u32x4*)(k_ + (tid + 512) * 8); \
        pa = *(const u32x4*)(gATT + gi_ * GW_ATT_SZ + tid * 8); if (tid < 128) peb = gEB[gi_ * GW_EB_SZ + tid]; \
        pv = *(const u32x4*)(Z + (size_t)(tokbase + cf_ * 64 + (dir ? 63 - iv : iv)) * NZ + ZGV + h * 256 + dvq * 64 + vg * 8); } while (0)
    G2_LOAD(0);
    for (int cs = 0; cs < NC; ++cs) {
        LAS unsigned char* B = lds + (cs & 1) * M_BUF;
#pragma unroll
        for (int e = 0; e < 2; ++e) { const int p = tid + 512 * e; *(LAS u32x4*)(B + M_QE + (p >> 4) * 272 + (p & 15) * 16) = pq[e]; *(LAS u32x4*)(B + M_KLT + (p >> 3) * 144 + (p & 7) * 16) = pk[e]; }
        *(LAS u32x4*)(B + M_ATT + iv * 144 + vg * 16) = pa;
        if (tid < 128) *(LAS float*)(B + M_EB + tid * 4) = peb;
#pragma unroll
        for (int q = 0; q < 4; ++q) { *(LAS bf16*)(B + M_VT + (vg * 8 + 2 * q) * 144 + iv * 2) = f2bf(lo_act(pv[q])); *(LAS bf16*)(B + M_VT + (vg * 8 + 2 * q + 1) * 144 + iv * 2) = f2bf(hi_act(pv[q])); }
#pragma unroll
        for (int n = 0; n < 4; ++n) { const u32x2 ws2 = {cvt_pk_bf16(S[n][0], S[n][1]), cvt_pk_bf16(S[n][2], S[n][3])}; *(LAS u32x2*)(B + M_SB + (n * 16 + fr) * 272 + (16 * w + 4 * fq) * 2) = ws2; }
        if (cs + 1 < NC) G2_LOAD(cs + 1);
        __syncthreads();
        { const int ti = w >> 1; const int cf = dir ? NC - 1 - cs : cs;
#pragma unroll
          for (int jj = 0; jj < 2; ++jj) { const int tn = (w & 1) * 2 + jj; f32x4 a = {0.f, 0.f, 0.f, 0.f};
#pragma unroll
              for (int ks = 0; ks < 4; ++ks) { const bf16x8 af = *(const LAS bf16x8*)(B + M_QE + (ti * 16 + fr) * 272 + (ks * 32 + fq * 8) * 2), bfr = *(const LAS bf16x8*)(B + M_SB + (tn * 16 + fr) * 272 + (ks * 32 + fq * 8) * 2);
                  a = mma16(af, bfr, a); }
#pragma unroll
              for (int ks = 0; ks < 2; ++ks) { const bf16x8 af = *(const LAS bf16x8*)(B + M_ATT + (ti * 16 + fr) * 144 + (ks * 32 + fq * 8) * 2), bfr = *(const LAS bf16x8*)(B + M_VT + (tn * 16 + fr) * 144 + (ks * 32 + fq * 8) * 2);
                  a = mma16(af, bfr, a); }
#pragma unroll
              for (int r = 0; r < 4; ++r) { const int i = ti * 16 + 4 * fq + r; OUT[(size_t)(tokbase + cf * 64 + (dir ? 63 - i : i)) * 1024 + h * 256 + dvq * 64 + tn * 16 + fr] = a[r]; } } }
        { const f32x4 eb = *(const LAS f32x4*)(B + M_EB + (16 * w + 4 * fq) * 4);
#pragma unroll
          for (int n = 0; n < 4; ++n) { S[n] = S[n] * eb;
#pragma unroll
              for (int ks = 0; ks < 2; ++ks) { const bf16x8 af = *(const LAS bf16x8*)(B + M_KLT + (16 * w + fr) * 144 + (ks * 32 + fq * 8) * 2), bfr = *(const LAS bf16x8*)(B + M_VT + (n * 16 + fr) * 144 + (ks * 32 + fq * 8) * 2);
                  S[n] = mma16(af, bfr, S[n]); } } }
    }
    if (st_out) {
        int fr2 = fr; asm volatile("" : "+v"(fr2));
        const int soff2 = (16 * w + 4 * fq) * 256 + dvq * 64 + fr2;
#pragma unroll
        for (int n = 0; n < 4; ++n)
#pragma unroll
            for (int r = 0; r < 4; ++r) st_out[soff2 + r * 256 + n * 16] = S[n][r];
    }
    __syncthreads();
#undef G2_LOAD
}
}

#define XB_TMO      128
#define XB_XCNT(j)  (256  + 64 * (j))
#define XB_XSUB(j)  (1280 + 64 * (j))
#define XB_XGEN(j)  (2304 + 64 * (j))
#define XB_TOP      3328
#define XB_TOPGEN   3392
#define XCD_BAR_WORDS 3456
#define XB_SPIN_CAP (1u << 18)
__device__ __forceinline__ unsigned xb_ld(unsigned* p)              { return __hip_atomic_load(p, __ATOMIC_RELAXED, __HIP_MEMORY_SCOPE_AGENT); }
__device__ __forceinline__ unsigned xb_add(unsigned* p, unsigned v) { return __hip_atomic_fetch_add(p, v, __ATOMIC_RELAXED, __HIP_MEMORY_SCOPE_AGENT); }
__device__ __forceinline__ unsigned xb_xcc_id() { return (unsigned)__builtin_amdgcn_s_getreg((3 << 11) | 20) & 0xFu; }
#define XB_SPIN(cond, bar) do { unsigned _sp = 0; while (cond) { __builtin_amdgcn_s_sleep(1); \
    if ((++_sp & 255u) == 0u) { if (xb_ld(&(bar)[XB_TMO])) break; if (_sp > XB_SPIN_CAP) { atomicAdd(&(bar)[XB_TMO], 1u); break; } } } } while (0)
struct XcdBarrier { unsigned* bar; unsigned x; volatile LAS unsigned* st; };
__device__ __forceinline__ XcdBarrier xcd_barrier_post(unsigned* bar, volatile LAS unsigned* st) {
    XcdBarrier b; b.bar = bar; b.x = xb_xcc_id(); b.st = st;
    if (threadIdx.x == 0) (void)xb_add(&bar[XB_XCNT(b.x)], 1u);
    return b;
}
__device__ __forceinline__ void xcd_barrier_complete(unsigned* bar, unsigned x, unsigned& nloc, unsigned& nx) {
    const unsigned G = gridDim.x * gridDim.y * gridDim.z;
    unsigned sum, cnt, mine, sp = 0u;
    for (;;) {
        sum = 0u; cnt = 0u; mine = 0u;
#pragma unroll
        for (unsigned j = 0; j < 16; ++j) { const unsigned c = xb_ld(&bar[XB_XCNT(j)]); sum += c; cnt += (c > 0u) ? 1u : 0u; mine = (j == x) ? c : mine; }
        if (sum == G) break;
        __builtin_amdgcn_s_sleep(1);
        if ((++sp & 255u) == 0u) { if (xb_ld(&bar[XB_TMO])) break; if (sp > XB_SPIN_CAP) { atomicAdd(&bar[XB_TMO], 1u); break; } }
    }
    nloc = mine > 0u ? mine : 1u; nx = cnt > 0u ? cnt : 1u;
}
__device__ __forceinline__ void xcd_barrier(const XcdBarrier& b) {
    asm volatile("s_waitcnt vmcnt(0)" ::: "memory");
    __syncthreads();
    if (threadIdx.x == 0) {
        unsigned* bar = b.bar;
        __builtin_amdgcn_s_waitcnt(0);
        unsigned nloc = b.st[0], nx = b.st[1];
        if (nloc == 0u) { xcd_barrier_complete(bar, b.x, nloc, nx); b.st[0] = nloc; b.st[1] = nx; }
        const unsigned old = xb_add(&bar[XB_XSUB(b.x)], 1u);
        const unsigned gen = old / nloc;
        if (old + 1u == (gen + 1u) * nloc) {
            __builtin_amdgcn_fence(__ATOMIC_RELEASE, "agent");
            asm volatile("s_waitcnt vmcnt(0)" ::: "memory");
            const unsigned og = xb_add(&bar[XB_TOP], 1u);
            const unsigned tg = og / nx;
            if (og + 1u == (tg + 1u) * nx) xb_add(&bar[XB_TOPGEN], 1u);
            else XB_SPIN(xb_ld(&bar[XB_TOPGEN]) == tg, bar);
            __builtin_amdgcn_fence(__ATOMIC_ACQUIRE, "agent");
            xb_add(&bar[XB_XGEN(b.x)], 1u);
            asm volatile("s_waitcnt vmcnt(0)" ::: "memory");
        } else {
            XB_SPIN(xb_ld(&bar[XB_XGEN(b.x)]) == gen, bar);
            __builtin_amdgcn_fence(__ATOMIC_ACQUIRE, "agent");
            asm volatile("s_waitcnt vmcnt(0)" ::: "memory");
        }
    }
    __syncthreads();
}

struct Args {
    const float *x_prompt, *x_sample, *cache_k, *cache_v, *state_f, *state_b, *cvec, *c_ctx, *w_ada, *b_ada, *norm1, *w_in, *q_norm, *k_norm, *w_fourier, *w_attn,
                *w_gate_f, *b_gate_f, *w_gate_b, *b_gate_b, *gla_norm, *w_gla, *w_out, *norm2, *w_up, *conv_w, *conv_b, *w_down, *final_norm;
    float* out; unsigned char* ws;
    int s_lo, s_hi, li, pad;
};
constexpr size_t OUT_YP = 0, OUT_YS = (size_t)NCTX * DM, OUT_CK = (size_t)NTOK * DM, OUT_CV = OUT_CK + (size_t)BCTX * DEPTH * TC * 256,
                 OUT_SF = OUT_CV + (size_t)BCTX * DEPTH * TC * 256, OUT_SB = OUT_SF + (size_t)BCTX * DEPTH * 4 * 128 * 256, OUT_END = OUT_SB + (size_t)BCTX * DEPTH * 4 * 128 * 256;

struct Frame { LAS unsigned char* lds; int tid, lane, wave, G, bid; };
__device__ __forceinline__ Frame frame_now(LAS unsigned char* lds) {
    Frame F; F.lds = lds; F.tid = opaque_tid(); F.lane = F.tid & 63; F.wave = __builtin_amdgcn_readfirstlane(F.tid >> 6); F.G = gridDim.x; F.bid = blockIdx.x; return F; }

__device__ __forceinline__ void transpose_item(const float* __restrict__ W, int N, bf16* __restrict__ WT, int ldd, int koff, int kb, int nb, int row_shift_from, int row_shift, LAS unsigned char* scr, int lane) {
    const int k0 = kb * 128, n0 = nb * 32, c4 = lane & 7, kr = lane >> 3;
#pragma unroll 4
    for (int i = 0; i < 16; ++i) { const int k = 8 * i + kr; const f32x4 v = *(const f32x4*)(W + (size_t)(k0 + k) * N + n0 + 4 * c4);
#pragma unroll
        for (int j = 0; j < 4; ++j) *(LAS bf16*)(scr + (4 * c4 + j) * 272 + k * 2) = f2act(v[j]); }
    LDS_WAIT(); asm volatile("" ::: "memory");
    const int kc = lane & 15;
#pragma unroll
    for (int j = 0; j < 8; ++j) { const int n = (lane >> 4) + 4 * j; const u32x4 o = *(const LAS u32x4*)(scr + n * 272 + kc * 16);
        int row = n0 + n; if (row >= row_shift_from) row += row_shift;
        *(u32x4*)(WT + (size_t)row * ldd + koff + k0 + kc * 8) = o; }
    LDS_WAIT(); asm volatile("" ::: "memory");
}
constexpr int TI_IN = 16 * 369, TI_F = 8 * 64, TI_AT = 8 * 64, TI_GL = 8 * 64, TI_OUT = 16 * 64, TI_UP = 16 * 352, TI_DN = 44 * 64;
constexpr int TI_LAYER = TI_IN + TI_F + TI_AT + TI_GL + TI_OUT + TI_UP + TI_DN;

__device__ __forceinline__ void phase_prologue_a(LAS unsigned char* lds_, const Args& a) {
    const Frame F = frame_now(lds_);
    unsigned char* ws = a.ws;
    {
        LAS unsigned char* scr = F.lds + F.wave * 8704;
        const int gw = F.bid * NWAVES + F.wave, NGW = F.G * NWAVES;
        for (int it = gw; it < DEPTH * TI_LAYER; it += NGW) {
            const int l = it / TI_LAYER; int r = it - l * TI_LAYER;
            if (r < TI_IN) { transpose_item(a.w_in + (size_t)l * DM * N_IN, N_IN, (bf16*)(ws + WS_WIN + l * SZ_WIN), DM, 0, r / 369, r % 369, ZPAD, ZGATE - ZPAD, scr, F.lane); continue; } r -= TI_IN;
            if (r < TI_F) { transpose_item(a.w_fourier + (size_t)l * 1024 * DM, DM, (bf16*)(ws + WS_WFT + l * SZ_WFT), 1024, 0, r / 64, r % 64, 1 << 30, 0, scr, F.lane); continue; } r -= TI_F;
            if (r < TI_AT) { transpose_item(a.w_attn + (size_t)l * 1024 * DM, DM, (bf16*)(ws + WS_WMRG + l * SZ_WMRG), KMRG, 2048, r / 64, r % 64, 1 << 30, 0, scr, F.lane); continue; } r -= TI_AT;
            if (r < TI_GL) { transpose_item(a.w_gla + (size_t)l * 1024 * DM, DM, (bf16*)(ws + WS_WMRG + l * SZ_WMRG), KMRG, 3072, r / 64, r % 64, 1 << 30, 0, scr, F.lane); continue; } r -= TI_GL;
            if (r < TI_OUT) { transpose_item(a.w_out + (size_t)l * DM * DM, DM, (bf16*)(ws + WS_WOUT + l * SZ_WOUT), DM, 0, r / 64, r % 64, 1 << 30, 0, scr, F.lane); continue; } r -= TI_OUT;
            if (r < TI_UP) { transpose_item(a.w_up + (size_t)l * DM * NUP, NUP, (bf16*)(ws + WS_WUP + l * SZ_WUP), DM, 0, r / 352, r % 352, 1 << 30, 0, scr, F.lane); continue; } r -= TI_UP;
            transpose_item(a.w_down + (size_t)l * DFF * DM, DM, (bf16*)(ws + WS_WDN + l * SZ_WDN), DFF, 0, r / 64, r % 64, 1 << 30, 0, scr, F.lane);
        }
    }
    const size_t gt = (size_t)F.bid * 512 + F.tid, NGT = (size_t)F.G * 512;
    for (size_t i = gt; i < (size_t)DEPTH * (ZGATE - ZPAD) * DM / 8; i += NGT) { const size_t l = i / ((ZGATE - ZPAD) * DM / 8), r = i % ((ZGATE - ZPAD) * DM / 8);
        *(u32x4*)(ws + WS_WIN + l * SZ_WIN + (size_t)ZPAD * DM * 2 + r * 16) = (u32x4){0u, 0u, 0u, 0u}; }
    for (size_t i = gt; i < (size_t)2048 * 1024; i += NGT) {
        const int kp = (int)(i >> 10), j = (int)(i & 1023), cs = kp >> 10, g = (kp >> 7) & 7, c = kp & 127, g2 = j >> 7, jj = j & 127; float v = 0.f;
        if (g == g2) { const int m = (c * jj) & 127; const float ang = (float)m * (1.f / 128.f); v = (cs ? -sinpif(2.f * ang) : cospif(2.f * ang)) * 0.088388347648318440f; }
        ((bf16*)(ws + WS_DT))[i] = f2act(v); }
    for (size_t i = gt; i < (size_t)512 * 256; i += NGT) { const int kp = (int)(i >> 8), t = (int)(i & 255), cs = kp >> 8, k = kp & 255, m = (k * t) & 255; const float ang = (float)m * (1.f / 256.f);
        ((bf16*)(ws + WS_ACTX))[i] = f2act((cs ? sinpif(2.f * ang) : cospif(2.f * ang)) * 0.0625f); }
    for (size_t i = gt; i < (size_t)2048 * 1024; i += NGT) { const int kp = (int)(i >> 10), t = (int)(i & 1023), cs = kp >> 10, k = kp & 1023, m = (k * t) & 1023; const float ang = (float)m * (1.f / 1024.f);
        ((bf16*)(ws + WS_ALAT))[i] = f2act((cs ? sinpif(2.f * ang) : cospif(2.f * ang)) * 0.03125f); }
    __syncthreads();
    {
        LAS float* SC = (LAS float*)F.lds;
        for (int i = F.tid; i < NMODV * DM; i += 512) { const int j = i >> 11, k = i & 2047; const float cv = j == 0 ? a.c_ctx[k] : a.cvec[(j - 1) * DM + k]; SC[i] = siluf_(cv); }
        __syncthreads();
        float* MP = (float*)(ws + WS_MODP);
        for (int u = F.bid; u < DEPTH * 16 * 6; u += F.G) {
            const int l = u / 96, kc = (u % 96) / 6, nb = u % 6, n = nb * 2048 + F.tid * 4;
            f32x4 acc[NMODV];
#pragma unroll
            for (int j = 0; j < NMODV; ++j) acc[j] = (f32x4){0.f, 0.f, 0.f, 0.f};
            const float* wp = a.w_ada + ((size_t)l * DM + kc * 128) * NMOD + n;
#pragma unroll 8
            for (int k = 0; k < 128; ++k) { const f32x4 wv = *(const f32x4*)(wp + (size_t)k * NMOD);
#pragma unroll
                for (int j = 0; j < NMODV; ++j) acc[j] = acc[j] + wv * SC[j * DM + kc * 128 + k]; }
#pragma unroll
            for (int j = 0; j < NMODV; ++j) *(f32x4*)(MP + (((size_t)kc * DEPTH + l) * NMODV + j) * NMOD + n) = acc[j];
        }
        __syncthreads();
    }
}
__device__ __forceinline__ void phase_mod_reduce(LAS unsigned char* lds_, const Args& a) {
    const Frame F = frame_now(lds_);
    const float* MP = (const float*)(a.ws + WS_MODP); float* MOD = (float*)(a.ws + WS_MOD);
    for (size_t i = (size_t)F.bid * 512 + F.tid; i < (size_t)DEPTH * NMODV * NMOD / 4; i += (size_t)F.G * 512) {
        const size_t e = i * 4; const int n = (int)(e % NMOD), l = (int)(e / ((size_t)NMODV * NMOD));
        f32x4 s = *(const f32x4*)(a.b_ada + (size_t)l * NMOD + n);
#pragma unroll
        for (int kc = 0; kc < 16; ++kc) s = s + *(const f32x4*)(MP + (size_t)kc * DEPTH * NMODV * NMOD + e);
        *(f32x4*)(MOD + e) = s; }
}

__device__ __forceinline__ void phase_norm(LAS unsigned char* lds_, const Args& a, int l, int which, bool first) {
    const Frame F = frame_now(lds_);
    const float* MOD = (const float*)(a.ws + WS_MOD) + (size_t)l * NMODV * NMOD + (which ? 3 * DM : 0);
    const float* wn = (which ? a.norm2 : a.norm1) + (size_t)l * DM;
    float* X = (float*)(a.ws + WS_X); bf16* H = (bf16*)(a.ws + WS_H);
    const int gw = F.bid * NWAVES + F.wave, NGW = F.G * NWAVES;
    for (int r = gw; r < NTOK; r += NGW) {
        const float* src = first ? (r < NCTX ? a.x_prompt + (size_t)r * DM : a.x_sample + (size_t)(r - NCTX) * DM) : X + (size_t)r * DM;
        f32x4 v[8]; float ss = 0.f;
#pragma unroll
        for (int j = 0; j < 8; ++j) { v[j] = *(const f32x4*)(src + 4 * F.lane + 256 * j); ss += (v[j][0] * v[j][0] + v[j][1] * v[j][1]) + (v[j][2] * v[j][2] + v[j][3] * v[j][3]); }
        if (first) {
#pragma unroll
            for (int j = 0; j < 8; ++j) *(f32x4*)(X + (size_t)r * DM + 4 * F.lane + 256 * j) = v[j]; }
        const float rstd = rsqrtf(wave_sum(ss) * (1.f / DM) + EPS);
        const float* mr = MOD + (size_t)mod_row(r) * NMOD;
#pragma unroll
        for (int j = 0; j < 8; ++j) { const int c = 4 * F.lane + 256 * j; const f32x4 w4 = *(const f32x4*)(wn + c), sh = *(const f32x4*)(mr + c), sc = *(const f32x4*)(mr + DM + c);
            const f32x4 hval = v[j] * rstd * w4 * (sc + 1.f) + sh;
            u32x2 o = {pk_act(hval[0], hval[1]), pk_act(hval[2], hval[3])}; *(u32x2*)(H + (size_t)r * DM + c) = o; }
    }
}
__device__ __forceinline__ void phase_final_norm(LAS unsigned char* lds_, const Args& a) {
    const Frame F = frame_now(lds_);
    const float* X = (const float*)(a.ws + WS_X);
    const int gw = F.bid * NWAVES + F.wave, NGW = F.G * NWAVES;
    for (int r = gw; r < NTOK; r += NGW) {
        f32x4 v[8]; float ss = 0.f;
#pragma unroll
        for (int j = 0; j < 8; ++j) { v[j] = *(const f32x4*)(X + (size_t)r * DM + 4 * F.lane + 256 * j); ss += (v[j][0] * v[j][0] + v[j][1] * v[j][1]) + (v[j][2] * v[j][2] + v[j][3] * v[j][3]); }
        const float rstd = rsqrtf(wave_sum(ss) * (1.f / DM) + EPS);
#pragma unroll
        for (int j = 0; j < 8; ++j) { const int c = 4 * F.lane + 256 * j; f32x4 yv = v[j] * rstd * *(const f32x4*)(a.final_norm + c);
#ifdef MK_PROBE_NOISE
            { const unsigned hsh = ((unsigned)r * 2654435761u) ^ ((unsigned)c * 40503u); const float dn = 0.03f;
              yv[0] += (hsh & 1u) ? dn : -dn; yv[1] += (hsh & 2u) ? dn : -dn; yv[2] += (hsh & 4u) ? dn : -dn; yv[3] += (hsh & 8u) ? dn : -dn; }
#endif
            *(f32x4*)(a.out + OUT_YP + (size_t)r * DM + c) = yv; }
    }
}

__device__ __forceinline__ void phase_prep(LAS unsigned char* lds_, const Args& a, int l) {
    const Frame F = frame_now(lds_);
    const bf16* Z = (const bf16*)(a.ws + WS_Z);
    bf16* KC = (bf16*)(a.ws + WS_KC); bf16* VC = (bf16*)(a.ws + WS_VC); bf16* KL = (bf16*)(a.ws + WS_KL); bf16* VL = (bf16*)(a.ws + WS_VL);
    const int gw = F.bid * NWAVES + F.wave, NGW = F.G * NWAVES, lane = F.lane;
    LAS bf16* tile = (LAS bf16*)(F.lds + F.wave * 8448);
    for (int it = gw; it < NTOK + 1024 + 2048; it += NGW) {
        if (it < NTOK) {
            const int r = it, hh = lane >> 5, i = lane & 31; const bf16* zr = Z + (size_t)r * NZ;
            float kx[4]; float ss = 0.f;
#pragma unroll
            for (int q = 0; q < 4; ++q) { kx[q] = act2f(zr[ZK + hh * 128 + i + 32 * q]); ss += kx[q] * kx[q]; }
            ss = half_sum(ss);
            const float rstd = rsqrtf(ss * (1.f / 128.f) + EPS);
#pragma unroll
            for (int q = 0; q < 4; ++q) kx[q] *= rstd * a.k_norm[l * 128 + i + 32 * q];
            const u32x2 vv = *(const u32x2*)(zr + ZV + 4 * lane);
            {
                bf16* qo = (bf16*)(a.ws + WS_QN) + (size_t)r * 1024;
                const bool lat = r >= NCTX; const int tq = (r - NCTX) & 1023; const float prow = (float)(tq >> 6), pcol = (float)(tq & 63);
                const float inv = exp2f(-(float)i * 0.41524101186092029f);
                float sr = 0.f, cr = 1.f, sc2 = 0.f, cc2 = 1.f;
                if (lat) { sr = __sinf(prow * inv); cr = __cosf(prow * inv); sc2 = __sinf(pcol * inv); cc2 = __cosf(pcol * inv); }
                float qg[4];
#pragma unroll
                for (int q = 0; q < 4; ++q) qg[q] = a.q_norm[l * 128 + i + 32 * q];
#pragma unroll
                for (int hp = 0; hp < 4; ++hp) { const int hd = 2 * hp + hh; float qx[4]; float s2 = 0.f;
#pragma unroll
                    for (int q = 0; q < 4; ++q) { qx[q] = act2f(zr[ZQ + hd * 128 + i + 32 * q]); s2 += qx[q] * qx[q]; }
                    s2 = half_sum(s2);
                    const float rs = rsqrtf(s2 * (1.f / 128.f) + EPS);
#pragma unroll
                    for (int q = 0; q < 4; ++q) qx[q] *= rs * qg[q];
                    const float y0 = qx[0] * cr - qx[1] * sr, y1 = qx[1] * cr + qx[0] * sr, y2 = qx[2] * cc2 - qx[3] * sc2, y3 = qx[3] * cc2 + qx[2] * sc2;
                    qo[hd * 128 + i] = f2act(y0); qo[hd * 128 + i + 32] = f2act(y1); qo[hd * 128 + i + 64] = f2act(y2); qo[hd * 128 + i + 96] = f2act(y3); }
            }
            if (r < NCTX) {
                const int b = r >> 8, t = r & 255; const size_t oo = ((size_t)(b * DEPTH + l) * TC + t) * 256;
#pragma unroll
                for (int q = 0; q < 4; ++q) { KC[(size_t)r * 256 + hh * 128 + i + 32 * q] = f2act(kx[q]); a.out[OUT_CK + oo + hh * 128 + i + 32 * q] = kx[q]; }
                *(u32x2*)(VC + (size_t)r * 256 + 4 * lane) = vv;
                *(f32x4*)(a.out + OUT_CV + oo + 4 * lane) = (f32x4){lo_act(vv[0]), hi_act(vv[0]), lo_act(vv[1]), hi_act(vv[1])};
            } else {
                const int rr = r - NCTX, b = rr >> 10, t = rr & 1023; const float prow = (float)(t >> 6), pcol = (float)(t & 63);
                const float inv = exp2f(-(float)i * 0.41524101186092029f);
                { const float s = __sinf(prow * inv), c = __cosf(prow * inv), x1 = kx[0], x2 = kx[1]; kx[0] = x1 * c - x2 * s; kx[1] = x2 * c + x1 * s; }
                { const float s = __sinf(pcol * inv), c = __cosf(pcol * inv), x1 = kx[2], x2 = kx[3]; kx[2] = x1 * c - x2 * s; kx[3] = x2 * c + x1 * s; }
                const size_t ko = ((size_t)b * 1280 + 256 + t) * 256;
#pragma unroll
                for (int q = 0; q < 4; ++q) KL[ko + hh * 128 + i + 32 * q] = f2act(kx[q]);
                *(u32x2*)(VL + ko + 4 * lane) = vv;
            }
        } else if (it < NTOK + 1024) {
            const int rr = it - NTOK, b = rr >> 8, s = rr & 255; const size_t so = ((size_t)(b * DEPTH + l) * PAST + s) * 256 + 4 * lane, dst_o = ((size_t)b * 1280 + s) * 256 + 4 * lane;
            const f32x4 kk = *(const f32x4*)(a.cache_k + so), vv = *(const f32x4*)(a.cache_v + so);
            u32x2 ko = {pk_act(kk[0], kk[1]), pk_act(kk[2], kk[3])}, vo = {pk_act(vv[0], vv[1]), pk_act(vv[2], vv[3])};
            *(u32x2*)(KL + dst_o) = ko; *(u32x2*)(VL + dst_o) = vo;
        } else {
            const int ti = it - NTOK - 1024, tb = ti >> 4, cb = ti & 15, r0 = tb * 64, c0 = cb * 64;
#pragma unroll
            for (int j = 0; j < 8; ++j) { const int row = (lane >> 3) + 8 * j, cc = (lane & 7) * 8; const u32x4 w = *(const u32x4*)(Z + (size_t)(r0 + row) * NZ + ZF + c0 + cc);
#pragma unroll
                for (int q = 0; q < 4; ++q) *(LAS unsigned*)(tile + row * 66 + cc + 2 * q) = w[q]; }
            LDS_WAIT(); asm volatile("" ::: "memory");
            bf16* XT; int T, b, t0;
            if (r0 < NCTX) { XT = (bf16*)(a.ws + WS_XT); T = TC; b = r0 >> 8; t0 = r0 & 255; } else { XT = (bf16*)(a.ws + WS_XT) + (size_t)16384 * 256; T = TL; b = (r0 - NCTX) >> 10; t0 = (r0 - NCTX) & 1023; }
#pragma unroll
            for (int j = 0; j < 8; ++j) { const int ch = (lane >> 3) + 8 * j, tt = (lane & 7) * 8; unsigned o[4];
#pragma unroll
                for (int q = 0; q < 4; ++q) o[q] = (unsigned)tile[(tt + 2 * q) * 66 + ch] | ((unsigned)tile[(tt + 2 * q + 1) * 66 + ch] << 16);
                *(u32x4*)(XT + ((size_t)b * 1024 + c0 + ch) * T + t0 + tt) = (u32x4){o[0], o[1], o[2], o[3]}; }
            LDS_WAIT(); asm volatile("" ::: "memory");
        }
    }
}

__device__ __forceinline__ void phase_attn(LAS unsigned char* lds_, const Args& a, int l) {
    const Frame F = frame_now(lds_);
    bf16* AM = (bf16*)(a.ws + WS_AM);
    for (int u = F.bid; u < 256; u += F.G) {
        const bool lat = u < 128; const int uu = lat ? u : u - 128;
        const int b = lat ? (uu >> 5) : (uu >> 3), h = lat ? ((uu >> 2) & 7) : (uu & 7), qb = lat ? (uu & 3) : 0;
        const size_t row0 = lat ? (size_t)NCTX + b * 1024 + qb * 256 : (size_t)b * 256;
        const size_t kvo = (lat ? (size_t)b * 1280 * 256 : (size_t)b * 256 * 256) + (h >> 2) * 128;
        const bf16* Kp = (const bf16*)(a.ws + (lat ? WS_KL : WS_KC)) + kvo; const bf16* Vp = (const bf16*)(a.ws + (lat ? WS_VL : WS_VC)) + kvo;
        att::attn_dense_body((const bf16*)(a.ws + WS_QN) + row0 * 1024 + h * 128, Kp, Vp, AM + row0 * KMRG + 2048 + h * 128, lat ? 1280 : 256, (LAS char*)F.lds);
    }
}

__device__ __forceinline__ void phase_gla_g1(LAS unsigned char* lds_, const Args& a, int l) {
    const Frame F = frame_now(lds_);
    const bf16* Z = (const bf16*)(a.ws + WS_Z);
    for (int gi = F.bid; gi < gla::G1_ITEMS; gi += F.G) {
        const int chunk = gi >> 3, h = (gi >> 1) & 3, dir = gi & 1;
        const float* wg = (dir ? a.w_gate_b : a.w_gate_f) + (size_t)l * 16 * 512 + h * 128;
        const float* bg = (dir ? a.b_gate_b : a.b_gate_f) + (size_t)l * 512 + h * 128;
        gla::g1_item(F.lds, Z, wg, bg, (bf16*)(a.ws + WS_GQE) + (size_t)gi * gla::GW_QE_SZ, (bf16*)(a.ws + WS_GATT) + (size_t)gi * gla::GW_ATT_SZ,
                     (bf16*)(a.ws + WS_GKLT) + (size_t)gi * gla::GW_KLT_SZ, (float*)(a.ws + WS_GEB) + (size_t)gi * gla::GW_EB_SZ, chunk * 64, h, dir);
    }
}
__device__ __forceinline__ void phase_gla_g2(LAS unsigned char* lds_, const Args& a, int l) {
    const Frame F = frame_now(lds_);
    const bf16* Z = (const bf16*)(a.ws + WS_Z);
    const int first = F.G >= 256 ? F.bid - F.G / 2 : F.bid, stride = F.G >= 256 ? F.G / 2 : F.G;
    for (int slot = first; slot >= 0 && slot < 128; slot += stride) {
        for (int k = 0; k < 5; ++k) {
            int path, b, h, dir, dvq;
            if (k == 0) { path = 1; b = slot >> 5; h = (slot >> 3) & 3; dir = (slot >> 2) & 1; dvq = slot & 3; }
            else { const int it = slot * 4 + k - 1; path = 0; b = it >> 5; h = (it >> 3) & 3; dir = (it >> 2) & 1; dvq = it & 3; }
            float* OUT = (float*)(a.ws + (dir ? WS_OB : WS_OF));
            const size_t so = ((size_t)(b * DEPTH + l) * 4 + h) * 128 * 256;
            const float* st_in = path ? (dir ? a.state_b : a.state_f) + so : nullptr;
            float* st_out = path ? nullptr : a.out + (dir ? OUT_SB : OUT_SF) + so;
            gla::g2_item(F.lds, Z, OUT, (const bf16*)(a.ws + WS_GQE), (const bf16*)(a.ws + WS_GATT), (const bf16*)(a.ws + WS_GKLT), (const float*)(a.ws + WS_GEB),
                         st_in, st_out, path ? TL : TC, path ? NCTX + b * 1024 : b * 256, h, dir, dvq);
        }
    }
}
__device__ __forceinline__ void phase_gla_fin(LAS unsigned char* lds_, const Args& a, int l) {
    const Frame F = frame_now(lds_);
    const bf16* Z = (const bf16*)(a.ws + WS_Z); bf16* AM = (bf16*)(a.ws + WS_AM);
    const float* OF = (const float*)(a.ws + WS_OF); const float* OB = (const float*)(a.ws + WS_OB);
    const int gw = F.bid * NWAVES + F.wave, NGW = F.G * NWAVES;
    const f32x4 gn = *(const f32x4*)(a.gla_norm + l * 256 + 4 * F.lane);
    for (int it = gw; it < NTOK * 4; it += NGW) { const int r = it >> 2, h = it & 3; const size_t o = (size_t)r * 1024 + h * 256 + 4 * F.lane;
        const f32x4 v = *(const f32x4*)(OF + o) + *(const f32x4*)(OB + o);
        const float ss = wave_sum((v[0] * v[0] + v[1] * v[1]) + (v[2] * v[2] + v[3] * v[3]));
        const float rstd = rsqrtf(ss * (1.f / 256.f) + EPS);
        const u32x2 g = *(const u32x2*)(Z + (size_t)r * NZ + ZGR + h * 256 + 4 * F.lane);
        const f32x4 y = v * rstd * gn;
        u32x2 w = {pk_act(y[0] * siluf_(lo_act(g[0])), y[1] * siluf_(hi_act(g[0]))), pk_act(y[2] * siluf_(lo_act(g[1])), y[3] * siluf_(hi_act(g[1])))};
        *(u32x2*)(AM + (size_t)r * KMRG + 3072 + h * 256 + 4 * F.lane) = w; }
}
__device__ __forceinline__ void phase_conv(LAS unsigned char* lds_, const Args& a, int l) {
    const Frame F = frame_now(lds_);
    const bf16* U = (const bf16*)(a.ws + WS_Z); bf16* ACT = (bf16*)(a.ws + WS_ACT);
    const float* cw = a.conv_w + (size_t)l * 3 * NUP; const float* cb = a.conv_b + (size_t)l * NUP;
    constexpr int NCG = DFF / 8, STRIP = 32, NS = NTOK / STRIP;
    for (int it = F.bid * 512 + F.tid; it < NCG * NS; it += F.G * 512) {
        const int cg = it % NCG, st = it / NCG, c = cg * 8, r0 = st * STRIP; const int T = r0 < NCTX ? TC : TL;
        float wg[3][8], wv[3][8], bgv[8], bvv[8];
#pragma unroll
        for (int k = 0; k < 3; ++k) { const f32x4 a0 = *(const f32x4*)(cw + k * NUP + c), a1 = *(const f32x4*)(cw + k * NUP + c + 4), b0 = *(const f32x4*)(cw + k * NUP + DFF + c), b1 = *(const f32x4*)(cw + k * NUP + DFF + c + 4);
#pragma unroll
            for (int j = 0; j < 4; ++j) { wg[k][j] = a0[j]; wg[k][4 + j] = a1[j]; wv[k][j] = b0[j]; wv[k][4 + j] = b1[j]; } }
        { const f32x4 a0 = *(const f32x4*)(cb + c), a1 = *(const f32x4*)(cb + c + 4), b0 = *(const f32x4*)(cb + DFF + c), b1 = *(const f32x4*)(cb + DFF + c + 4);
#pragma unroll
          for (int j = 0; j < 4; ++j) { bgv[j] = a0[j]; bgv[4 + j] = a1[j]; bvv[j] = b0[j]; bvv[4 + j] = b1[j]; } }
        const u32x4 zero = {0u, 0u, 0u, 0u};
        u32x4 gp = zero, vp = zero, gc, vc;
        if ((r0 & (T - 1)) != 0) { gp = *(const u32x4*)(U + (size_t)(r0 - 1) * NUP + c); vp = *(const u32x4*)(U + (size_t)(r0 - 1) * NUP + DFF + c); }
        gc = *(const u32x4*)(U + (size_t)r0 * NUP + c); vc = *(const u32x4*)(U + (size_t)r0 * NUP + DFF + c);
        for (int i = 0; i < STRIP; i += 4) {
            u32x4 gnx[4], vnx[4];
#pragma unroll
            for (int e = 0; e < 4; ++e) { const int rn = r0 + i + e + 1;
                if ((rn & (T - 1)) != 0) { gnx[e] = *(const u32x4*)(U + (size_t)rn * NUP + c); vnx[e] = *(const u32x4*)(U + (size_t)rn * NUP + DFF + c); } else { gnx[e] = zero; vnx[e] = zero; } }
#pragma unroll
            for (int e = 0; e < 4; ++e) { const int r = r0 + i + e; const u32x4 gn = gnx[e], vn = vnx[e];
                float o[8];
#pragma unroll
                for (int q = 0; q < 4; ++q) {
                    const float g0 = wg[0][2 * q] * lo_act(gp[q]) + wg[1][2 * q] * lo_act(gc[q]) + wg[2][2 * q] * lo_act(gn[q]) + bgv[2 * q];
                    const float g1 = wg[0][2 * q + 1] * hi_act(gp[q]) + wg[1][2 * q + 1] * hi_act(gc[q]) + wg[2][2 * q + 1] * hi_act(gn[q]) + bgv[2 * q + 1];
                    const float v0 = wv[0][2 * q] * lo_act(vp[q]) + wv[1][2 * q] * lo_act(vc[q]) + wv[2][2 * q] * lo_act(vn[q]) + bvv[2 * q];
                    const float v1 = wv[0][2 * q + 1] * hi_act(vp[q]) + wv[1][2 * q + 1] * hi_act(vc[q]) + wv[2][2 * q + 1] * hi_act(vn[q]) + bvv[2 * q + 1];
                    o[2 * q] = siluf_(g0) * v0; o[2 * q + 1] = siluf_(g1) * v1; }
                *(u32x4*)(ACT + (size_t)r * DFF + c) = (u32x4){pk_act(o[0], o[1]), pk_act(o[2], o[3]), pk_act(o[4], o[5]), pk_act(o[6], o[7])};
                gp = gc; vp = vc; gc = gn; vc = vn; }
        }
    }
}

#ifdef MK_PROBE
constexpr size_t WS_DIAG = WS_END;
__device__ __forceinline__ void diag_max(float* slot, float v) { atomicMax((unsigned*)slot, __builtin_bit_cast(unsigned, fabsf(v))); }
__global__ void k_probe_zero(float* diag) { if (threadIdx.x < 4) diag[threadIdx.x] = 0.f; }
__global__ void k_probe_fill(float* out, const float* diag) {
    for (size_t i = (size_t)blockIdx.x * blockDim.x + threadIdx.x; i < OUT_END; i += (size_t)gridDim.x * blockDim.x) out[i] = 0.f;
    __syncthreads();
    if (blockIdx.x == 0 && threadIdx.x == 0) out[0] = 1e6f * diag[0] / fmaxf(diag[1], 1e-20f);
}
__global__ void k_probe_fill2(float* out, const float* diag) { if (blockIdx.x == 0 && threadIdx.x == 0) out[0] = 1e6f * diag[0] / fmaxf(diag[1], 1e-20f); }
__global__ void k_probe_z(Args a) {
    const bf16* H = (const bf16*)(a.ws + WS_H); const bf16* W = (const bf16*)(a.ws + WS_WIN); const bf16* Z = (const bf16*)(a.ws + WS_Z); float* diag = (float*)(a.ws + WS_DIAG);
    const unsigned id = blockIdx.x * blockDim.x + threadIdx.x; const unsigned hsh = id * 2654435761u + 12345u;
    const int r = (hsh >> 8) % NTOK, c = (hsh * 40503u >> 7) % NZ;
    float s = 0.f; for (int k = 0; k < DM; ++k) s += act2f(H[(size_t)r * DM + k]) * act2f(W[(size_t)c * DM + k]);
    const float z = act2f(Z[(size_t)r * NZ + c]); diag_max(diag, z - s); diag_max(diag + 1, s);
}
__global__ void k_probe_wt(Args a, int l) {
    const bf16* W = (const bf16*)(a.ws + WS_WIN + (size_t)l * SZ_WIN); float* diag = (float*)(a.ws + WS_DIAG);
    for (size_t i = (size_t)blockIdx.x * blockDim.x + threadIdx.x; i < (size_t)N_IN * DM; i += (size_t)gridDim.x * blockDim.x) {
        const int n = (int)(i / DM), k = (int)(i % DM); const int row = n >= ZPAD ? n + (ZGATE - ZPAD) : n;
        const float ref = act2f(f2act(a.w_in[((size_t)l * DM + k) * N_IN + n])); diag_max(diag, act2f(W[(size_t)row * DM + k]) - ref); diag_max(diag + 1, ref); }
}
__global__ void k_probe_gla(Args a) {
    __shared__ float red[4];
    const bf16* Z = (const bf16*)(a.ws + WS_Z); float* diag = (float*)(a.ws + WS_DIAG);
    const int l = 0, blk = blockIdx.x, b = blk & 15, h = (blk >> 4) & 3, dir = (blk >> 6) & 1, dv0 = ((blk >> 7) * 52 + 3) & 252;
    const int d = threadIdx.x & 127, dvi = threadIdx.x >> 7, dv = dv0 + dvi, T = TC, tokbase = b * TC;
    const float* wg = (dir ? a.w_gate_b : a.w_gate_f) + (size_t)l * 16 * 512 + h * 128; const float* bg = (dir ? a.b_gate_b : a.b_gate_f) + (size_t)l * 512 + h * 128;
    const float* OUT = (const float*)(a.ws + (dir ? WS_OB : WS_OF));
    float S = 0.f;
    for (int i = 0; i < T; ++i) { const int t = dir ? T - 1 - i : i; const bf16* zr = Z + (size_t)(tokbase + t) * NZ;
        float x = bg[d]; for (int r = 0; r < 16; ++r) x += act2f(zr[(dir ? ZGAB : ZGAF) + r]) * wg[r * 512 + d];
        const float la = (fminf(x, 0.f) - logf(1.f + expf(-fabsf(x)))) * 0.0625f;
        S = expf(la) * S + act2f(zr[ZGK + h * 128 + d]) * act2f(zr[ZGV + h * 256 + dv]);
        if (threadIdx.x < 4) red[threadIdx.x] = 0.f;
        __syncthreads();
        atomicAdd(&red[dvi], act2f(zr[ZGQ + h * 128 + d]) * 0.088388347648318440f * S);
        __syncthreads();
        if (d == 0) { const float o = OUT[(size_t)(tokbase + t) * 1024 + h * 256 + dv]; diag_max(diag, o - red[dvi]); diag_max(diag + 1, red[dvi]); }
        __syncthreads(); }
    const float sref = S, sgot = a.out[(dir ? OUT_SB : OUT_SF) + (((size_t)(b * DEPTH + l) * 4 + h) * 128 + d) * 256 + dv];
    diag_max(diag + 2, sgot - sref); diag_max(diag + 3, sref);
}

__global__ void k_probe_h(Args a) {
    const bf16* H = (const bf16*)(a.ws + WS_H); float* diag = (float*)(a.ws + WS_DIAG);
    const unsigned id = blockIdx.x * blockDim.x + threadIdx.x; const unsigned hsh = id * 2654435761u + 777u;
    const int r = (hsh >> 8) % NTOK, c = (hsh * 40503u >> 7) % DM, j = mod_row(r);
    const float* xr = r < NCTX ? a.x_prompt + (size_t)r * DM : a.x_sample + (size_t)(r - NCTX) * DM;
    float ss = 0.f, sh = a.b_ada[c], sc = a.b_ada[DM + c];
    for (int k = 0; k < DM; ++k) { ss += xr[k] * xr[k]; const float cv = j == 0 ? a.c_ctx[k] : a.cvec[(j - 1) * DM + k]; const float sl = cv / (1.f + expf(-cv));
        sh += sl * a.w_ada[(size_t)k * NMOD + c]; sc += sl * a.w_ada[(size_t)k * NMOD + DM + c]; }
    const float ref = xr[c] * (1.f / sqrtf(ss / DM + EPS)) * a.norm1[c] * (1.f + sc) + sh;
    diag_max(diag, act2f(H[(size_t)r * DM + c]) - ref); diag_max(diag + 1, ref);
}

__global__ void k_probe_mod(Args a, int l) {
    const float* MOD = (const float*)(a.ws + WS_MOD) + (size_t)l * NMODV * NMOD; float* diag = (float*)(a.ws + WS_DIAG);
    const unsigned id = blockIdx.x * blockDim.x + threadIdx.x; const int j = id % NMODV, n = (int)(((id / NMODV) * 2654435761u >> 8) % NMOD);
    float s = a.b_ada[(size_t)l * NMOD + n];
    for (int k = 0; k < DM; ++k) { const float cv = j == 0 ? a.c_ctx[k] : a.cvec[(j - 1) * DM + k]; s += cv / (1.f + expf(-cv)) * a.w_ada[((size_t)l * DM + k) * NMOD + n]; }
    diag_max(diag, MOD[(size_t)j * NMOD + n] - s); diag_max(diag + 1, s);
}
#endif

constexpr int STEPS_PER_LAYER = 11, STEP_L0 = 2, STEP_FINAL = STEP_L0 + DEPTH * STEPS_PER_LAYER, N_STEPS = STEP_FINAL + 1;
#ifndef MK_PH_MASK
#define MK_PH_MASK 0xFFFFFFFFu
#endif
#define EN(k) (((MK_PH_MASK) >> (k)) & 1u)
#ifndef MK_REP_MASK
#define MK_REP_MASK 0u
#endif
#define REP(k) (((MK_REP_MASK) >> (k)) & 1u)
#ifndef MK_SP2
#define MK_SP2 true
#endif
#ifndef MK_ALIGN
#define MK_ALIGN true
#endif
__global__ void __launch_bounds__(NWAVES * 64, 2) mk_fwd(Args a) {
    extern __shared__ __attribute__((aligned(16))) unsigned char lds_raw[];
    LAS unsigned char* const lds = (LAS unsigned char*)lds_raw;
    volatile LAS unsigned* MISC = (volatile LAS unsigned*)(lds + MISC_OFF);
    if (threadIdx.x < 64) MISC[threadIdx.x] = 0u;
    __syncthreads();
    unsigned* barw = (unsigned*)(a.ws + WS_CTL) + CW_BAR + a.li * XCD_BAR_WORDS;
    XcdBarrier bar = xcd_barrier_post(barw, MISC + 8);
    const int lo = a.s_lo, hi = a.s_hi;
#define IN(s) (lo <= (s) && (s) < hi)
#define SEAM(s) do { if (IN(s) && IN((s) + 1)) xcd_barrier(bar); else __syncthreads(); } while (0)
    unsigned char* ws = a.ws;
    const int G = gridDim.x, bid = blockIdx.x;

    if (EN(13) && IN(0)) { phase_prologue_a(lds, a); if (REP(13)) { xcd_barrier(bar); phase_prologue_a(lds, a); } SEAM(0); }
    if (EN(14) && IN(1)) {
        phase_mod_reduce(lds, a);
        pg8::Gemm g{(const bf16*)(ws + WS_WFT), (const bf16*)(ws + WS_DT), DEPTH * DM, 2048, 1024}; pg8::StaticOrder S; S.init(g.M, g.N, G, bid);
        pg8::EpiStoreBf16 E{(bf16*)(ws + WS_WMRG), KMRG};
        pg8::gemm_phase<pg8::EpiStoreBf16, pg8::StaticOrder, MK_ALIGN, MK_SP2>(lds, g, S, E);
        SEAM(1);
    }
    for (int l = 0; l < DEPTH; ++l) {
        const int sb = STEP_L0 + l * STEPS_PER_LAYER;
        if (hi <= sb || lo >= sb + STEPS_PER_LAYER) continue;
        const float* MODL = (const float*)(ws + WS_MOD) + (size_t)l * NMODV * NMOD;
        if (EN(0) && IN(sb + 0)) { phase_norm(lds, a, l, 0, l == 0); if (REP(0)) { xcd_barrier(bar); phase_norm(lds, a, l, 0, l == 0); } SEAM(sb + 0); }
        if (EN(1) && IN(sb + 1)) {
            pg8::Gemm g{(const bf16*)(ws + WS_H), (const bf16*)(ws + WS_WIN + l * SZ_WIN), NTOK, NZ, DM}; pg8::StaticOrder S; S.init(g.M, g.N, G, bid);
            pg8::EpiStoreBf16 E{(bf16*)(ws + WS_Z), NZ};
            pg8::gemm_phase<pg8::EpiStoreBf16, pg8::StaticOrder, MK_ALIGN, MK_SP2>(lds, g, S, E);
#ifdef MK_REP_Z
            xcd_barrier(bar); pg8::gemm_phase<pg8::EpiStoreBf16, pg8::StaticOrder, MK_ALIGN, MK_SP2>(lds, g, S, E);
#endif
            SEAM(sb + 1);
        }
        if (EN(2) && IN(sb + 2)) { phase_gla_g1(lds, a, l); phase_prep(lds, a, l); if (REP(2)) { xcd_barrier(bar); phase_gla_g1(lds, a, l); phase_prep(lds, a, l); } SEAM(sb + 2); }
        if (EN(3) && IN(sb + 3)) {
            if (G >= 256 && bid >= G / 2) phase_gla_g2(lds, a, l);
            phase_attn(lds, a, l);
            { pg8::Gemm g{(const bf16*)(ws + WS_ALAT), (const bf16*)(ws + WS_XT) + (size_t)16384 * 256, 2048, 4096, 1024}; pg8::StaticOrder S; S.init(g.M, g.N, G, bid);
              pg8::EpiDft E{(bf16*)(ws + WS_AM), 10, NCTX};
              pg8::gemm_phase<pg8::EpiDft, pg8::StaticOrder, MK_ALIGN, MK_SP2>(lds, g, S, E); }
            { pg8::Gemm g{(const bf16*)(ws + WS_ACTX), (const bf16*)(ws + WS_XT), 512, 16384, 256}; pg8::StaticOrder S; S.init(g.M, g.N, G, bid);
              pg8::EpiDft E{(bf16*)(ws + WS_AM), 8, 0};
              pg8::gemm_phase<pg8::EpiDft, pg8::StaticOrder, MK_ALIGN, MK_SP2>(lds, g, S, E); }
            if (G < 256) phase_gla_g2(lds, a, l);
            SEAM(sb + 3);
        }
        if (EN(6) && IN(sb + 4)) { phase_gla_fin(lds, a, l); if (REP(6)) { xcd_barrier(bar); phase_gla_fin(lds, a, l); } SEAM(sb + 4); }
        if (EN(7) && IN(sb + 5)) {
            pg8::Gemm g{(const bf16*)(ws + WS_AM), (const bf16*)(ws + WS_WMRG + l * SZ_WMRG), NTOK, DM, KMRG}; pg8::StaticOrder S; S.init(g.M, g.N, G, bid);
            pg8::EpiMerged E{(bf16*)(ws + WS_MG), (const bf16*)(ws + WS_Z)};
            pg8::gemm_phase<pg8::EpiMerged, pg8::StaticOrder, MK_ALIGN, MK_SP2>(lds, g, S, E);
#if (MK_REP_MASK >> 7) & 1
            xcd_barrier(bar);
            {

            pg8::Gemm g{(const bf16*)(ws + WS_AM), (const bf16*)(ws + WS_WMRG + l * SZ_WMRG), NTOK, DM, KMRG}; pg8::StaticOrder S; S.init(g.M, g.N, G, bid);
            pg8::EpiMerged E{(bf16*)(ws + WS_MG), (const bf16*)(ws + WS_Z)};
            pg8::gemm_phase<pg8::EpiMerged, pg8::StaticOrder, MK_ALIGN, MK_SP2>(lds, g, S, E);
            }
#endif
                        SEAM(sb + 5);
        }
        if (EN(8) && IN(sb + 6)) {
            pg8::Gemm g{(const bf16*)(ws + WS_MG), (const bf16*)(ws + WS_WOUT + l * SZ_WOUT), NTOK, DM, DM}; pg8::StaticOrder S; S.init(g.M, g.N, G, bid);
            pg8::EpiResid E{(float*)(ws + WS_X), MODL + 2 * DM};
            pg8::gemm_phase<pg8::EpiResid, pg8::StaticOrder, MK_ALIGN, MK_SP2>(lds, g, S, E);
#if (MK_REP_MASK >> 8) & 1
            xcd_barrier(bar);
            {

            pg8::Gemm g{(const bf16*)(ws + WS_MG), (const bf16*)(ws + WS_WOUT + l * SZ_WOUT), NTOK, DM, DM}; pg8::StaticOrder S; S.init(g.M, g.N, G, bid);
            pg8::EpiResid E{(float*)(ws + WS_X), (const float*)(ws + WS_CTL + 512 * 1024)};
            pg8::gemm_phase<pg8::EpiResid, pg8::StaticOrder, MK_ALIGN, MK_SP2>(lds, g, S, E);
            }
#endif
            SEAM(sb + 6);
        }
        if (EN(9) && IN(sb + 7)) { phase_norm(lds, a, l, 1, false); if (REP(9)) { xcd_barrier(bar); phase_norm(lds, a, l, 1, false); } SEAM(sb + 7); }
        if (EN(10) && IN(sb + 8)) {
            pg8::Gemm g{(const bf16*)(ws + WS_H), (const bf16*)(ws + WS_WUP + l * SZ_WUP), NTOK, NUP, DM}; pg8::StaticOrder S; S.init(g.M, g.N, G, bid);
            pg8::EpiStoreBf16 E{(bf16*)(ws + WS_Z), NUP};
            pg8::gemm_phase<pg8::EpiStoreBf16, pg8::StaticOrder, MK_ALIGN, MK_SP2>(lds, g, S, E);
#if (MK_REP_MASK >> 10) & 1
            xcd_barrier(bar);
            {

            pg8::Gemm g{(const bf16*)(ws + WS_H), (const bf16*)(ws + WS_WUP + l * SZ_WUP), NTOK, NUP, DM}; pg8::StaticOrder S; S.init(g.M, g.N, G, bid);
            pg8::EpiStoreBf16 E{(bf16*)(ws + WS_Z), NUP};
            pg8::gemm_phase<pg8::EpiStoreBf16, pg8::StaticOrder, MK_ALIGN, MK_SP2>(lds, g, S, E);
            }
#endif
                        SEAM(sb + 8);
        }
        if (EN(11) && IN(sb + 9)) { phase_conv(lds, a, l); if (REP(11)) { xcd_barrier(bar); phase_conv(lds, a, l); } SEAM(sb + 9); }
        if (EN(12) && IN(sb + 10)) {
            pg8::Gemm g{(const bf16*)(ws + WS_ACT), (const bf16*)(ws + WS_WDN + l * SZ_WDN), NTOK, DM, DFF}; pg8::StaticOrder S; S.init(g.M, g.N, G, bid);
            pg8::EpiResid E{(float*)(ws + WS_X), MODL + 5 * DM};
            pg8::gemm_phase<pg8::EpiResid, pg8::StaticOrder, MK_ALIGN, MK_SP2>(lds, g, S, E);
#if (MK_REP_MASK >> 12) & 1
            xcd_barrier(bar);
            {

            pg8::Gemm g{(const bf16*)(ws + WS_ACT), (const bf16*)(ws + WS_WDN + l * SZ_WDN), NTOK, DM, DFF}; pg8::StaticOrder S; S.init(g.M, g.N, G, bid);
            pg8::EpiResid E{(float*)(ws + WS_X), (const float*)(ws + WS_CTL + 512 * 1024)};
            pg8::gemm_phase<pg8::EpiResid, pg8::StaticOrder, MK_ALIGN, MK_SP2>(lds, g, S, E);
            }
#endif
            SEAM(sb + 10);
        }
    }
    if (EN(15) && IN(STEP_FINAL)) phase_final_norm(lds, a);
#undef IN
#undef SEAM
}

#ifndef MK_LAUNCH_MODE
#define MK_LAUNCH_MODE 0
#endif
extern "C" void kernel_launch(void* const* d_in, const int* in_sizes, int n_in, void* d_out, int out_size, void* d_ws, size_t ws_size, hipStream_t stream) {
    static int grid = 0;
    if (grid == 0) {
        if (n_in != 29 || (size_t)out_size != OUT_END || ws_size < WS_END + 4096) { fprintf(stderr, "kernel_launch: unexpected shapes: n_in %d out %d ws %zu (need %zu)\n", n_in, out_size, ws_size, (size_t)WS_END); grid = -1; return; }
        int dev = 0, cus = 0;
        if (hipGetDevice(&dev) != hipSuccess || hipDeviceGetAttribute(&cus, hipDeviceAttributeMultiprocessorCount, dev) != hipSuccess) { grid = -1; return; }
        if (hipFuncSetAttribute((const void*)mk_fwd, hipFuncAttributeMaxDynamicSharedMemorySize, LDS_BYTES) != hipSuccess) { fprintf(stderr, "kernel_launch: hipFuncSetAttribute failed\n"); grid = -1; return; }
        int per_cu = 0;
        if (hipOccupancyMaxActiveBlocksPerMultiprocessor(&per_cu, (const void*)mk_fwd, NWAVES * 64, LDS_BYTES) != hipSuccess || per_cu < 1) { fprintf(stderr, "kernel_launch: occupancy query says %d\n", per_cu); }
        (void)hipGetLastError();
        grid = cus;
    }
    if (grid < 0) return;
    (void)hipMemsetAsync((char*)d_ws + WS_CTL, 0, CTL_ZERO_BYTES, stream);
    Args a{};
    const float** p = (const float**)&a;
    for (int i = 0; i < 29; ++i) p[i] = (const float*)d_in[i];
    a.out = (float*)d_out; a.ws = (unsigned char*)d_ws; a.pad = 0;
#ifdef MK_PROBE
    {
        constexpr int PROBE_STEPS = (MK_PROBE == 2) ? 1 : (MK_PROBE == 1) ? STEP_L0 + 2 : (MK_PROBE == 4) ? STEP_L0 + 1 : (MK_PROBE == 5) ? 2 : STEP_L0 + 6;
        float* diag = (float*)((char*)d_ws + WS_DIAG);
        for (int s = 0; s < PROBE_STEPS; ++s) { a.s_lo = s; a.s_hi = s + 1; a.li = s; hipLaunchKernelGGL(mk_fwd, dim3(grid), dim3(NWAVES * 64), LDS_BYTES, stream, a); }
        hipLaunchKernelGGL(k_probe_zero, dim3(1), dim3(64), 0, stream, diag);
        if (MK_PROBE == 1) hipLaunchKernelGGL(k_probe_z, dim3(128), dim3(512), 0, stream, a);
        if (MK_PROBE == 2) hipLaunchKernelGGL(k_probe_wt, dim3(1024), dim3(256), 0, stream, a, MK_PROBE_L);
        if (MK_PROBE == 4) hipLaunchKernelGGL(k_probe_h, dim3(32), dim3(512), 0, stream, a);
        if (MK_PROBE == 5) hipLaunchKernelGGL(k_probe_mod, dim3(40), dim3(512), 0, stream, a, MK_PROBE_L);
        if (MK_PROBE == 3) hipLaunchKernelGGL(k_probe_gla, dim3(512), dim3(512), 0, stream, a);
        hipLaunchKernelGGL(k_probe_fill, dim3(1024), dim3(256), 0, stream, (float*)d_out, (const float*)(diag + 2 * MK_PROBE_SEL));
        hipLaunchKernelGGL(k_probe_fill2, dim3(1), dim3(64), 0, stream, (float*)d_out, (const float*)(diag + 2 * MK_PROBE_SEL));
        return;
    }
#endif
#if MK_LAUNCH_MODE == 1
    a.s_lo = 0; a.s_hi = N_STEPS; a.li = 0;
    hipLaunchKernelGGL(mk_fwd, dim3(grid), dim3(NWAVES * 64), LDS_BYTES, stream, a);
#else
    for (int s = 0; s < N_STEPS; ++s) { a.s_lo = s; a.s_hi = s + 1; a.li = s;
        hipLaunchKernelGGL(mk_fwd, dim3(grid), dim3(NWAVES * 64), LDS_BYTES, stream, a); }
#endif
}
```

```cpp
#define MK_LAUNCH_MODE 1
#include <hip/hip_runtime.h>
#include <cstdio>
#include <cstdint>

#define GAS __attribute__((address_space(1)))
#define LAS __attribute__((address_space(3)))
typedef unsigned short bf16;
typedef short bf16x8 __attribute__((ext_vector_type(8)));
typedef float f32x4 __attribute__((ext_vector_type(4)));
typedef float f32x2 __attribute__((ext_vector_type(2)));
typedef unsigned u32x4 __attribute__((ext_vector_type(4)));
typedef unsigned u32x2 __attribute__((ext_vector_type(2)));
typedef GAS unsigned gu32;

constexpr int DM = 2048, NTOK = 8192, NCTX = 4096, TC = 256, TL = 1024, BCTX = 16, BLAT = 4, PAST = 256, DEPTH = 4;
constexpr int N_IN = 11808, NZ = 12032;
constexpr int ZF = 0, ZQ = 1024, ZK = 2048, ZV = 2304, ZGQ = 2560, ZGK = 3072, ZGV = 3584, ZGR = 4608, ZGAF = 5632, ZGAB = 5648, ZPAD = 5664, ZGATE = 5888;
constexpr int NUP = 11264, DFF = 5632, NMOD = 12288, KMRG = 4096;
constexpr int NMODV = 5;
constexpr float EPS = 1e-6f;

constexpr size_t MiB = 1u << 20;
constexpr size_t WS_CTL = 0, CTL_ZERO_BYTES = 1 * MiB;
constexpr size_t WS_MOD = 1 * MiB;
constexpr size_t WS_MODP = 2 * MiB;
constexpr size_t WS_DT = 17 * MiB;
constexpr size_t WS_ACTX = 21 * MiB;
constexpr size_t WS_ALAT = 22 * MiB;
constexpr size_t WS_WIN = 26 * MiB;
constexpr size_t WS_WMRG = 214 * MiB;
constexpr size_t WS_WFT = 278 * MiB;
constexpr size_t WS_WOUT = 294 * MiB;
constexpr size_t WS_WUP = 326 * MiB;
constexpr size_t WS_WDN = 502 * MiB;
constexpr size_t WS_X = 590 * MiB;
constexpr size_t WS_H = 654 * MiB;
constexpr size_t WS_Z = 686 * MiB;
constexpr size_t WS_XT = 874 * MiB;
constexpr size_t WS_KC = 890 * MiB, WS_VC = 892 * MiB;
constexpr size_t WS_KL = 894 * MiB, WS_VL = 897 * MiB;
constexpr size_t WS_AM = 900 * MiB;
constexpr size_t WS_OF = 964 * MiB, WS_OB = 996 * MiB;
constexpr size_t WS_MG = 1028 * MiB;
constexpr size_t WS_ACT = 1060 * MiB;
constexpr size_t WS_QN = 1148 * MiB;
constexpr size_t WS_GQE = 1164 * MiB, WS_GKLT = 1180 * MiB, WS_GATT = 1196 * MiB, WS_GEB = 1204 * MiB;
constexpr size_t WS_END = 1205 * MiB;
constexpr size_t SZ_WIN = (size_t)NZ * DM * 2, SZ_WMRG = (size_t)DM * KMRG * 2, SZ_WFT = (size_t)DM * 1024 * 2, SZ_WOUT = (size_t)DM * DM * 2, SZ_WUP = (size_t)NUP * DM * 2, SZ_WDN = (size_t)DM * DFF * 2;
static_assert(WS_WIN + 4 * SZ_WIN <= WS_WMRG && WS_WMRG + 4 * SZ_WMRG <= WS_WFT && WS_WFT + 4 * SZ_WFT <= WS_WOUT && WS_WOUT + 4 * SZ_WOUT <= WS_WUP && WS_WUP + 4 * SZ_WUP <= WS_WDN && WS_WDN + 4 * SZ_WDN <= WS_X, "ws map (weights)");
static_assert(WS_Z + (size_t)NTOK * NZ * 2 <= WS_XT && WS_MODP + (size_t)16 * 4 * 5 * NMOD * 4 <= WS_DT && WS_AM + (size_t)NTOK * KMRG * 2 <= WS_OF && WS_ACT + (size_t)NTOK * DFF * 2 <= WS_END, "ws map (activations)");
constexpr int CW_BAR = 4096;

constexpr int LDS_BYTES = 163840;
constexpr int MISC_OFF = LDS_BYTES - 256;
constexpr int NWAVES = 8;

#define RLX_AGENT __ATOMIC_RELAXED, __HIP_MEMORY_SCOPE_AGENT
#define LDS_WAIT() asm volatile("s_waitcnt lgkmcnt(0)" ::: "memory")
#define VM_WAIT() asm volatile("s_waitcnt vmcnt(0)" ::: "memory")
__device__ __forceinline__ unsigned cvt_pk_bf16(float lo, float hi) { unsigned r; asm volatile("v_cvt_pk_bf16_f32 %0, %1, %2" : "=v"(r) : "v"(lo), "v"(hi)); return r; }
__device__ __forceinline__ float bf_lo(unsigned w) { return __builtin_bit_cast(float, w << 16); }
__device__ __forceinline__ float bf_hi(unsigned w) { return __builtin_bit_cast(float, w & 0xffff0000u); }
__device__ __forceinline__ float bf2f(bf16 h) { return __builtin_bit_cast(float, (unsigned)h << 16); }
__device__ __forceinline__ bf16 f2bf(float f) { return (bf16)(cvt_pk_bf16(f, 0.f) & 0xffffu); }
#ifndef MK_F16
#define MK_F16 1
#endif
typedef _Float16 h16x2 __attribute__((ext_vector_type(2)));
typedef _Float16 h16x8 __attribute__((ext_vector_type(8)));
typedef float f32x16_t __attribute__((ext_vector_type(16)));
#if MK_F16
__device__ __forceinline__ unsigned pk_act(float lo, float hi) { h16x2 v; v[0] = (_Float16)lo; v[1] = (_Float16)hi; return __builtin_bit_cast(unsigned, v); }
__device__ __forceinline__ float lo_act(unsigned w) { return (float)__builtin_bit_cast(h16x2, w)[0]; }
__device__ __forceinline__ float hi_act(unsigned w) { return (float)__builtin_bit_cast(h16x2, w)[1]; }
__device__ __forceinline__ float act2f(bf16 h) { return (float)__builtin_bit_cast(_Float16, h); }
__device__ __forceinline__ bf16 f2act(float f) { return __builtin_bit_cast(bf16, (_Float16)f); }
__device__ __forceinline__ f32x4 mma16_act(bf16x8 a, bf16x8 b, f32x4 c) { return __builtin_amdgcn_mfma_f32_16x16x32_f16(__builtin_bit_cast(h16x8, a), __builtin_bit_cast(h16x8, b), c, 0, 0, 0); }
__device__ __forceinline__ f32x16_t mma32_act(bf16x8 a, bf16x8 b, f32x16_t c) { return __builtin_amdgcn_mfma_f32_32x32x16_f16(__builtin_bit_cast(h16x8, a), __builtin_bit_cast(h16x8, b), c, 0, 0, 0); }
#else
__device__ __forceinline__ unsigned pk_act(float lo, float hi) { return cvt_pk_bf16(lo, hi); }
__device__ __forceinline__ float lo_act(unsigned w) { return bf_lo(w); }
__device__ __forceinline__ float hi_act(unsigned w) { return bf_hi(w); }
__device__ __forceinline__ float act2f(bf16 h) { return bf2f(h); }
__device__ __forceinline__ bf16 f2act(float f) { return f2bf(f); }
__device__ __forceinline__ f32x4 mma16_act(bf16x8 a, bf16x8 b, f32x4 c) { return __builtin_amdgcn_mfma_f32_16x16x32_bf16(a, b, c, 0, 0, 0); }
__device__ __forceinline__ f32x16_t mma32_act(bf16x8 a, bf16x8 b, f32x16_t c) { return __builtin_amdgcn_mfma_f32_32x32x16_bf16(a, b, c, 0, 0, 0); }
#endif
template <int M> __device__ __forceinline__ float swz_xor(float v) { return __builtin_bit_cast(float, __builtin_amdgcn_ds_swizzle(__builtin_bit_cast(int, v), (M << 10) | 0x1f)); }
__device__ __forceinline__ float half_sum(float v) { v += swz_xor<1>(v); v += swz_xor<2>(v); v += swz_xor<4>(v); v += swz_xor<8>(v); v += swz_xor<16>(v); return v; }
__device__ __forceinline__ float wave_sum(float v) { v = half_sum(v);
    auto rr = __builtin_amdgcn_permlane32_swap(__float_as_uint(v), __float_as_uint(v), false, false); return __uint_as_float(rr[0]) + __uint_as_float(rr[1]); }
__device__ __forceinline__ float sigmoidf_(float x) { return __builtin_amdgcn_rcpf(1.f + __expf(-x)); }
__device__ __forceinline__ float siluf_(float x) { return x * sigmoidf_(x); }
__device__ __forceinline__ int opaque_tid() { int t = threadIdx.x; asm volatile("" : "+v"(t)); return t; }
__device__ __forceinline__ int mod_row(int r) { return r < NCTX ? 0 : 1 + ((r - NCTX) >> 10); }

namespace pg8 {
#define PG8_LAS __attribute__((address_space(3)))
typedef unsigned short bf16_t;
constexpr int BM = 256, BK = 64, HALF = 128, HTB = HALF * BK * 2  , STAGE_BYTES = 8 * HTB, NXCD = 8, WGM = 8;

__host__ __device__ __forceinline__ int lds_byte(int r, int c) { const int st = (r >> 4) * 2 + (c >> 5), rr = r & 15, cc = c & 31, ob = rr * 64 + cc * 2; return st * 1024 + (ob ^ (((ob >> 9) & 1) << 5)); }
__host__ __device__ __forceinline__ void stage_rc(int b, int& R, int& C) { const int st = b / 1024, sb = b % 1024, swz = sb ^ (((sb >> 9) & 1) << 5); R = (st >> 1) * 16 + swz / 64; C = (st & 1) * 32 + (swz % 64) / 2; }
__host__ __device__ __forceinline__ int perm32(int rho) { const int n = rho >> 4, i = rho & 15; return 8 * (i >> 2) + 4 * n + (i & 3); }

struct Unit { int pm, pn; };
struct Gemm { const bf16_t* A; const bf16_t* Bt; int M, N, K; };

struct StaticOrder {
    int nM, nN, nwg, G, c;
    __host__ __device__ void init(int M, int N, int G_, int c_) { nM = M / BM; nN = N / BM; nwg = nM * nN; G = G_; c = c_; }
    __host__ __device__ bool next(int i, Unit& u) const {
        const long L = (long)i * G + c; if (L >= nwg) return false;
        int wgid = (int)L; { const int q = nwg / NXCD, r = nwg % NXCD, xcd = wgid % NXCD, off = wgid / NXCD; wgid = (xcd < r ? xcd * (q + 1) : r * (q + 1) + (xcd - r) * q) + off; }
        const int nig = WGM * nN, gid = wgid / nig, fm = gid * WGM, gsz = (nM - fm) < WGM ? (nM - fm) : WGM;
        u.pm = fm + ((wgid % nig) % gsz); u.pn = (wgid % nig) / gsz; return true;
    }
    __device__ __forceinline__ void a_ready(const Unit&) const {}
    __device__ __forceinline__ void done(const Unit&) const {}
};

template <class Epi, class Sched, bool ALIGN_EPI = false, bool SP2 = false>
__device__ __forceinline__ void gemm_phase(PG8_LAS unsigned char* lds, const Gemm g, const Sched& S, const Epi& E) {
    const int tid = opaque_tid(), wid = __builtin_amdgcn_readfirstlane(tid >> 6), lane = tid & 63, wr = wid >> 2, wc = wid & 3, fr = lane & 15, fq = lane >> 4;
    const int K = g.K, nt = K / BK;
    unsigned voffA[2], voffB[2];
#pragma unroll
    for (int i = 0; i < 2; ++i) { int R, C; stage_rc(tid * 16 + i * 8192, R, C); const int Rb = Epi::PERM ? ((R & ~31) + perm32(R & 31)) : R;
        voffA[i] = (unsigned)(R * K + C) * 2u; voffB[i] = (unsigned)(Rb * K + C) * 2u; }
    const size_t kstep = (size_t)(BK * 2);
    const size_t hstep = (size_t)HALF * K * 2;
    const size_t tstep = 2 * hstep;
    const unsigned ldsw = (unsigned)wid * 1024u;
    const int aoff = lds_byte(wr * 64 + fr, fq * 8), boff = lds_byte(wc * 32 + fr, fq * 8);
#define PG8_SA(b, h) (((b) * 2 + (h)) * HTB)
#define PG8_SB(b, h) ((4 + (b) * 2 + (h)) * HTB)
#define PG8_STAGE(bufoff, gbase, voff) do { _Pragma("unroll") for (int _i = 0; _i < 2; ++_i) \
        __builtin_amdgcn_global_load_lds((const unsigned*)((const char*)(gbase) + (voff)[_i]), (PG8_LAS unsigned*)(lds + (bufoff) + ldsw + _i * 8192), 16, 0, 0); } while (0)
#define PG8_LDA(dst, b, h) do { _Pragma("unroll") for (int m = 0; m < 4; ++m) _Pragma("unroll") for (int k = 0; k < 2; ++k) dst[m][k] = *(const PG8_LAS bf16x8*)(lds + PG8_SA(b, h) + aoff + m * 2048 + k * 1024); } while (0)
#define PG8_LDB(dst, b, h) do { _Pragma("unroll") for (int n = 0; n < 2; ++n) _Pragma("unroll") for (int k = 0; k < 2; ++k) dst[n][k] = *(const PG8_LAS bf16x8*)(lds + PG8_SB(b, h) + boff + n * 2048 + k * 1024); } while (0)
#define PG8_MMA(ai, bj, At, Bt) do { __builtin_amdgcn_s_setprio(1); _Pragma("unroll") for (int m = 0; m < 4; ++m) _Pragma("unroll") for (int n = 0; n < 2; ++n) _Pragma("unroll") for (int k = 0; k < 2; ++k) \
        acc[ai][bj][m][n] = mma16_act(Bt[n][k], At[m][k], acc[ai][bj][m][n]); __builtin_amdgcn_s_setprio(0); } while (0)
#define PG8_WAIT_V(n) asm volatile("s_waitcnt vmcnt(" #n ")" ::: "memory")
#define PG8_WAIT_L(n) asm volatile("s_waitcnt lgkmcnt(" #n ")" ::: "memory")
#define PG8_BAR __builtin_amdgcn_s_barrier()
#define PG8_SCHED __builtin_amdgcn_sched_barrier(0)
    Unit cur, nxt; int ui = 0;
    if (!S.next(0, cur)) return;
    f32x4 acc[2][2][4][2];
#pragma unroll
    for (int a = 0; a < 2; ++a)
#pragma unroll
        for (int b = 0; b < 2; ++b)
#pragma unroll
            for (int m = 0; m < 4; ++m)
#pragma unroll
                for (int n = 0; n < 2; ++n) acc[a][b][m][n] = (f32x4){0.f, 0.f, 0.f, 0.f};
    bf16x8 At[4][2], B0[2][2], B1[2][2];
    const char* cA = (const char*)g.A + (size_t)cur.pm * tstep; const char* cB = (const char*)g.Bt + (size_t)cur.pn * tstep;
    S.a_ready(cur);
    if constexpr (SP2) {
        PG8_STAGE(PG8_SB(0, 0), cB, voffB); PG8_STAGE(PG8_SB(0, 1), cB + hstep, voffB); PG8_STAGE(PG8_SA(0, 0), cA, voffA); PG8_STAGE(PG8_SA(0, 1), cA + hstep, voffA);
        if (wr == 1) PG8_BAR;
        PG8_WAIT_V(2); PG8_BAR;
        PG8_STAGE(PG8_SB(1, 0), cB + kstep, voffB); PG8_STAGE(PG8_SA(1, 0), cA + kstep, voffA); PG8_STAGE(PG8_SB(1, 1), cB + hstep + kstep, voffB);
        PG8_WAIT_V(6); PG8_BAR;
    } else {
        PG8_STAGE(PG8_SB(0, 0), cB, voffB); PG8_STAGE(PG8_SA(0, 0), cA, voffA); PG8_STAGE(PG8_SB(0, 1), cB + hstep, voffB); PG8_STAGE(PG8_SA(0, 1), cA + hstep, voffA);
        if (wr == 1) PG8_BAR;
        PG8_WAIT_V(4); PG8_BAR;
        PG8_STAGE(PG8_SB(1, 0), cB + kstep, voffB); PG8_STAGE(PG8_SA(1, 0), cA + kstep, voffA); PG8_STAGE(PG8_SB(1, 1), cB + hstep + kstep, voffB);
        PG8_WAIT_V(6); PG8_BAR;
    }
    for (;;) {
        const bool has_next = S.next(ui + 1, nxt);
        const char* nA = has_next ? (const char*)g.A + (size_t)nxt.pm * tstep : cA; const char* nB = has_next ? (const char*)g.Bt + (size_t)nxt.pn * tstep : cB;
#pragma unroll
        for (int sgi = 0; sgi < Epi::NSEG; ++sgi) {
        const int t_beg = sgi == 0 ? 0 : Epi::seg_end(sgi - 1), t_end = sgi == Epi::NSEG - 1 ? nt : Epi::seg_end(sgi);
        for (int t = t_beg; t < t_end; t += 2) {
            const bool last = (t == nt - 2);
            const char* a1 = cA + (size_t)(t + 1) * kstep;
            const char* a2 = last ? nA : cA + (size_t)(t + 2) * kstep; const char* b2 = last ? nB : cB + (size_t)(t + 2) * kstep;
            const char* a3 = a2 + kstep; const char* b3 = b2 + kstep;
            if (last && has_next) S.a_ready(nxt);
            if constexpr (SP2) {
            PG8_LDB(B0, 0, 0); PG8_LDB(B1, 0, 1); PG8_SCHED; PG8_LDA(At, 0, 0); PG8_STAGE(PG8_SA(1, 1), a1 + hstep, voffA);
            PG8_WAIT_V(8); PG8_WAIT_L(0); PG8_BAR; PG8_MMA(0, 0, At, B0); PG8_MMA(0, 1, At, B1); PG8_BAR; PG8_SCHED;
            PG8_LDA(At, 0, 1); PG8_STAGE(PG8_SB(0, 0), b2, voffB); PG8_STAGE(PG8_SB(0, 1), b2 + hstep, voffB); PG8_STAGE(PG8_SA(0, 0), a2, voffA);
            PG8_WAIT_V(8); PG8_WAIT_L(0); PG8_BAR; PG8_MMA(1, 0, At, B0); PG8_MMA(1, 1, At, B1); PG8_BAR; PG8_SCHED;
            PG8_LDB(B0, 1, 0); PG8_LDB(B1, 1, 1); PG8_SCHED; PG8_LDA(At, 1, 0); PG8_STAGE(PG8_SA(0, 1), a2 + hstep, voffA);
            PG8_WAIT_V(8); PG8_WAIT_L(0); PG8_BAR; PG8_MMA(0, 0, At, B0); PG8_MMA(0, 1, At, B1); PG8_BAR; PG8_SCHED;
            PG8_LDA(At, 1, 1); PG8_STAGE(PG8_SB(1, 0), b3, voffB); PG8_STAGE(PG8_SB(1, 1), b3 + hstep, voffB); PG8_STAGE(PG8_SA(1, 0), a3, voffA);
            PG8_WAIT_V(8); PG8_WAIT_L(0); PG8_BAR; PG8_MMA(1, 0, At, B0); PG8_MMA(1, 1, At, B1); PG8_BAR; PG8_SCHED;
            } else {
            PG8_LDB(B0, 0, 0); PG8_SCHED; PG8_LDA(At, 0, 0); PG8_STAGE(PG8_SA(1, 1), a1 + hstep, voffA);
            PG8_WAIT_L(8); PG8_BAR; PG8_WAIT_L(0); PG8_MMA(0, 0, At, B0); PG8_BAR; PG8_SCHED;
            PG8_LDB(B1, 0, 1); PG8_STAGE(PG8_SB(0, 0), b2, voffB);
            PG8_BAR; PG8_WAIT_L(0); PG8_MMA(0, 1, At, B1); PG8_BAR;
            PG8_LDA(At, 0, 1); PG8_STAGE(PG8_SA(0, 0), a2, voffA);
            PG8_BAR; PG8_WAIT_L(0); PG8_MMA(1, 0, At, B0); PG8_BAR; PG8_SCHED;
            PG8_STAGE(PG8_SB(0, 1), b2 + hstep, voffB);
            PG8_WAIT_V(6); PG8_BAR; PG8_MMA(1, 1, At, B1); PG8_BAR;
            PG8_LDB(B0, 1, 0); PG8_SCHED; PG8_LDA(At, 1, 0); PG8_STAGE(PG8_SA(0, 1), a2 + hstep, voffA);
            PG8_WAIT_L(8); PG8_BAR; PG8_WAIT_L(0); PG8_MMA(0, 0, At, B0); PG8_BAR; PG8_SCHED;
            PG8_LDB(B1, 1, 1); PG8_STAGE(PG8_SB(1, 0), b3, voffB);
            PG8_BAR; PG8_WAIT_L(0); PG8_MMA(0, 1, At, B1); PG8_BAR;
            PG8_LDA(At, 1, 1); PG8_STAGE(PG8_SA(1, 0), a3, voffA);
            PG8_BAR; PG8_WAIT_L(0); PG8_MMA(1, 0, At, B0); PG8_BAR; PG8_SCHED;
            PG8_STAGE(PG8_SB(1, 1), b3 + hstep, voffB);
            PG8_WAIT_V(6); PG8_BAR; PG8_MMA(1, 1, At, B1); PG8_BAR;
            }
        }
        if constexpr (Epi::NSEG > 1) { if (sgi < Epi::NSEG - 1) E.mid(acc, cur, sgi, wr, wc, fr, fq); }
        }
        if constexpr (ALIGN_EPI) { if (wr == 0) PG8_BAR; }
        E(acc, cur, wr, wc, fr, fq); S.done(cur);
        if (!has_next) break;
#pragma unroll
        for (int a = 0; a < 2; ++a)
#pragma unroll
            for (int b = 0; b < 2; ++b)
#pragma unroll
                for (int m = 0; m < 4; ++m)
#pragma unroll
                    for (int n = 0; n < 2; ++n) acc[a][b][m][n] = (f32x4){0.f, 0.f, 0.f, 0.f};
        cur = nxt; cA = nA; cB = nB; ++ui;
        if constexpr (ALIGN_EPI) { if (wr == 1) PG8_BAR; }
    }
    PG8_WAIT_V(0);
    if constexpr (!ALIGN_EPI) { if (wr == 0) PG8_BAR; }
    PG8_BAR;
#undef PG8_SA
#undef PG8_SB
#undef PG8_STAGE
#undef PG8_LDA
#undef PG8_LDB
#undef PG8_MMA
#undef PG8_WAIT_V
#undef PG8_WAIT_L
#undef PG8_BAR
#undef PG8_SCHED
}

struct EpiStoreBf16 {
    static constexpr bool PERM = true; static constexpr int NSEG = 1; static constexpr int seg_end(int) { return 0; }
    bf16_t* O; int ldc;
    __device__ __forceinline__ void operator()(f32x4 (&acc)[2][2][4][2], const Unit& u, int wr, int wc, int fr, int fq) const {
        bf16_t* base = O + (size_t)(u.pm * BM + wr * 64 + fr) * ldc + u.pn * BM + wc * 32 + 8 * fq;
#pragma unroll
        for (int ai = 0; ai < 2; ++ai)
#pragma unroll
            for (int m = 0; m < 4; ++m) { bf16_t* rowp = base + (size_t)(ai * HALF + m * 16) * ldc;
#pragma unroll
                for (int bj = 0; bj < 2; ++bj) { const f32x4 v0 = acc[ai][bj][m][0], v1 = acc[ai][bj][m][1];
                    u32x4 w; w.x = pk_act(v0[0], v0[1]); w.y = pk_act(v0[2], v0[3]); w.z = pk_act(v1[0], v1[1]); w.w = pk_act(v1[2], v1[3]);
                    *(u32x4*)(rowp + bj * HALF) = w; } }
    }
};
struct EpiStoreZ {
    static constexpr bool PERM = true; static constexpr int NSEG = 1; static constexpr int seg_end(int) { return 0; }
    bf16_t* O; int ldc, gate_tile0;
    __device__ __forceinline__ void operator()(f32x4 (&acc)[2][2][4][2], const Unit& u, int wr, int wc, int fr, int fq) const {
        bf16_t* base = O + (size_t)(u.pm * BM + wr * 64 + fr) * ldc + u.pn * BM + wc * 32 + 8 * fq;
        const bool gate = u.pn >= gate_tile0;
#pragma unroll
        for (int ai = 0; ai < 2; ++ai)
#pragma unroll
            for (int m = 0; m < 4; ++m) { bf16_t* rowp = base + (size_t)(ai * HALF + m * 16) * ldc;
#pragma unroll
                for (int bj = 0; bj < 2; ++bj) { f32x4 v0 = acc[ai][bj][m][0], v1 = acc[ai][bj][m][1];
                    if (gate) {
#pragma unroll
                        for (int j = 0; j < 4; ++j) { v0[j] = __expf(-fminf(fmaxf(v0[j], -10.f), 10.f)); v1[j] = __expf(-fminf(fmaxf(v1[j], -10.f), 10.f)); } }
                    u32x4 w; w.x = pk_act(v0[0], v0[1]); w.y = pk_act(v0[2], v0[3]); w.z = pk_act(v1[0], v1[1]); w.w = pk_act(v1[2], v1[3]);
                    *(u32x4*)(rowp + bj * HALF) = w; } }
    }
};
struct EpiDft {
    static constexpr bool PERM = true; static constexpr int NSEG = 1; static constexpr int seg_end(int) { return 0; }
    bf16_t* AM; int tshift, tokbase;
    __device__ __forceinline__ void operator()(f32x4 (&acc)[2][2][4][2], const Unit& u, int wr, int wc, int fr, int fq) const {
        const int k0 = u.pm * BM, part = k0 >> tshift, kk0 = k0 & ((1 << tshift) - 1), b = u.pn >> 2, ch0 = (u.pn & 3) * BM;
        bf16_t* base = AM + (size_t)(tokbase + (b << tshift) + kk0 + wr * 64 + fr) * KMRG + part * 1024 + ch0 + wc * 32 + 8 * fq;
#pragma unroll
        for (int ai = 0; ai < 2; ++ai)
#pragma unroll
            for (int m = 0; m < 4; ++m) { bf16_t* rowp = base + (size_t)(ai * HALF + m * 16) * KMRG;
#pragma unroll
                for (int bj = 0; bj < 2; ++bj) { const f32x4 v0 = acc[ai][bj][m][0], v1 = acc[ai][bj][m][1];
                    u32x4 w; w.x = pk_act(v0[0], v0[1]); w.y = pk_act(v0[2], v0[3]); w.z = pk_act(v1[0], v1[1]); w.w = pk_act(v1[2], v1[3]);
                    *(u32x4*)(rowp + bj * HALF) = w; } }
    }
};
struct EpiMerged {
    static constexpr bool PERM = true; static constexpr int NSEG = 3; static constexpr int seg_end(int s) { return s == 0 ? 32 : 48; }
    bf16_t* O; const bf16_t* Z;
    __device__ __forceinline__ void scale_by(f32x4 (&acc)[2][2][4][2], const Unit& u, int wr, int wc, int fr, int fq, int gnum, int gden) const {
        int lo_ = fr * NZ + 8 * fq; asm volatile("" : "+v"(lo_));
        const bf16_t* zb = Z + (size_t)(u.pm * BM + wr * 64) * NZ + ZGATE + u.pn * BM + wc * 32 + lo_;
#pragma unroll
        for (int ai = 0; ai < 2; ++ai) {
            u32x4 gn[4][2], gd[4][2];
#pragma unroll
            for (int m = 0; m < 4; ++m)
#pragma unroll
                for (int bj = 0; bj < 2; ++bj) { const bf16_t* zr = zb + (size_t)(ai * HALF + m * 16) * NZ + bj * HALF;
                    gn[m][bj] = *(const u32x4*)(zr + gnum * DM); if (gden >= 0) gd[m][bj] = *(const u32x4*)(zr + gden * DM); else gd[m][bj] = (u32x4){0u, 0u, 0u, 0u}; }
#pragma unroll
            for (int m = 0; m < 4; ++m)
#pragma unroll
                for (int bj = 0; bj < 2; ++bj) {
                    float s[8];
#pragma unroll
                    for (int q = 0; q < 4; ++q) {
                        const float n0 = 1.f + lo_act(gn[m][bj][q]), n1 = 1.f + hi_act(gn[m][bj][q]);
                        float d0 = 1.f, d1 = 1.f; if (gden >= 0) { d0 = 1.f + lo_act(gd[m][bj][q]); d1 = 1.f + hi_act(gd[m][bj][q]); }
                        s[2 * q] = d0 * __builtin_amdgcn_rcpf(n0); s[2 * q + 1] = d1 * __builtin_amdgcn_rcpf(n1); }
                    f32x4 v0 = acc[ai][bj][m][0], v1 = acc[ai][bj][m][1];
                    v0[0] *= s[0]; v0[1] *= s[1]; v0[2] *= s[2]; v0[3] *= s[3]; v1[0] *= s[4]; v1[1] *= s[5]; v1[2] *= s[6]; v1[3] *= s[7];
                    acc[ai][bj][m][0] = v0; acc[ai][bj][m][1] = v1; }
            asm volatile("" ::: "memory"); }
    }
    __device__ __forceinline__ void mid(f32x4 (&acc)[2][2][4][2], const Unit& u, int s, int wr, int wc, int fr, int fq) const {
        if (s == 0) scale_by(acc, u, wr, wc, fr, fq, 0, 1); else scale_by(acc, u, wr, wc, fr, fq, 1, 2);
    }
    __device__ __forceinline__ void operator()(f32x4 (&acc)[2][2][4][2], const Unit& u, int wr, int wc, int fr, int fq) const {
        scale_by(acc, u, wr, wc, fr, fq, 2, -1);
        bf16_t* base = O + (size_t)(u.pm * BM + wr * 64 + fr) * DM + u.pn * BM + wc * 32 + 8 * fq;
#pragma unroll
        for (int ai = 0; ai < 2; ++ai)
#pragma unroll
            for (int m = 0; m < 4; ++m) { bf16_t* rowp = base + (size_t)(ai * HALF + m * 16) * DM;
#pragma unroll
                for (int bj = 0; bj < 2; ++bj) { const f32x4 v0 = acc[ai][bj][m][0], v1 = acc[ai][bj][m][1];
                    u32x4 w; w.x = pk_act(v0[0], v0[1]); w.y = pk_act(v0[2], v0[3]); w.z = pk_act(v1[0], v1[1]); w.w = pk_act(v1[2], v1[3]);
                    *(u32x4*)(rowp + bj * HALF) = w; } }
    }
};
struct EpiResid {
    static constexpr bool PERM = false; static constexpr int NSEG = 1; static constexpr int seg_end(int) { return 0; }
    float* X; const float* gate;
    __device__ __forceinline__ void operator()(f32x4 (&acc)[2][2][4][2], const Unit& u, int wr, int wc, int fr, int fq) const {
        int lo_ = fr * DM + 4 * fq; asm volatile("" : "+v"(lo_));
        const int col0 = u.pn * BM + wc * 32;
        const float* gp = gate + (size_t)mod_row(u.pm * BM) * NMOD + col0 + 4 * fq;
        float* xb = X + (size_t)(u.pm * BM + wr * 64) * DM + col0 + lo_;
        f32x4 gv[2][2];
#pragma unroll
        for (int bj = 0; bj < 2; ++bj)
#pragma unroll
            for (int n = 0; n < 2; ++n) gv[bj][n] = *(const f32x4*)(gp + bj * HALF + n * 16);
#pragma unroll
        for (int ai = 0; ai < 2; ++ai) {
            f32x4 xv[4][2][2];
#pragma unroll
            for (int m = 0; m < 4; ++m)
#pragma unroll
                for (int bj = 0; bj < 2; ++bj)
#pragma unroll
                    for (int n = 0; n < 2; ++n) xv[m][bj][n] = *(const f32x4*)(xb + (size_t)(ai * HALF + m * 16) * DM + bj * HALF + n * 16);
#pragma unroll
            for (int m = 0; m < 4; ++m)
#pragma unroll
                for (int bj = 0; bj < 2; ++bj)
#pragma unroll
                    for (int n = 0; n < 2; ++n) *(f32x4*)(xb + (size_t)(ai * HALF + m * 16) * DM + bj * HALF + n * 16) = xv[m][bj][n] + gv[bj][n] * acc[ai][bj][m][n];
            asm volatile("" ::: "memory"); }
    }
};
}

namespace att {
constexpr int D = 128, NW = 8, QBLK = 32, KVBLK = 64;
constexpr float SCALE = 0.088388347648318440f;
constexpr float THR = 8.f;
constexpr int LDQ = 1024, LDK = 256, LDO = KMRG;
constexpr int SHM_V = KVBLK * D * 2, SHM_K = KVBLK * D * 2, SHM_ATTN = 2 * SHM_V + 2 * SHM_K + NW * 64 * 4;
typedef __attribute__((ext_vector_type(4))) short s16x4;
typedef __attribute__((ext_vector_type(16))) float f32x16;
#define KSWZ(row, colB) ((row) * 256 + ((colB) ^ (((row) & 7) << 4)))
#define SBAR() __builtin_amdgcn_sched_barrier(0)
__device__ __forceinline__ int crow(int r, int hi) { return (r & 3) + 8 * (r >> 2) + 4 * hi; }

__device__ __forceinline__ void partialSM(f32x16& p0, f32x16& p1, float& m_reg, float& mn, float& alpha) {
  constexpr float C = SCALE * 1.4426950408889634f;
  float pmax = p0[0];
#pragma unroll
  for (int r = 1; r < 16; ++r) pmax = fmaxf(pmax, p0[r]);
#pragma unroll
  for (int r = 0; r < 16; ++r) pmax = fmaxf(pmax, p1[r]);
  { auto rr = __builtin_amdgcn_permlane32_swap(__float_as_uint(pmax), __float_as_uint(pmax), false, false);
    pmax = fmaxf(__uint_as_float(rr[0]), __uint_as_float(rr[1])); }
  if (__builtin_expect(__all(pmax - m_reg <= THR / SCALE), 1)) { mn = m_reg; alpha = 1.f; }
  else { mn = fmaxf(m_reg, pmax); alpha = __builtin_amdgcn_exp2f((m_reg - mn) * C); m_reg = mn; }
  float mnC = -mn * C;
#pragma unroll
  for (int r = 0; r < 16; ++r) p0[r] = fmaf(p0[r], C, mnC);
#pragma unroll
  for (int r = 0; r < 16; ++r) p1[r] = fmaf(p1[r], C, mnC);
#pragma unroll
  for (int r = 0; r < 16; ++r) p0[r] = __builtin_amdgcn_exp2f(p0[r]);
}
__device__ __forceinline__ void finishSM(f32x16& p0, f32x16& p1, float alpha, float& l_reg, bf16x8& pa0, bf16x8& pa1, bf16x8& pa2, bf16x8& pa3) {
#pragma unroll
  for (int r = 0; r < 16; ++r) p1[r] = __builtin_amdgcn_exp2f(p1[r]);
  float ps = 0;
#pragma unroll
  for (int r = 0; r < 16; ++r) ps += p0[r];
#pragma unroll
  for (int r = 0; r < 16; ++r) ps += p1[r];
  { auto rr = __builtin_amdgcn_permlane32_swap(__float_as_uint(ps), __float_as_uint(ps), false, false);
    ps = __uint_as_float(rr[0]) + __uint_as_float(rr[1]); }
  l_reg = l_reg * alpha + ps;
#define PK4(P, BASE, OUT) do { unsigned a0 = pk_act(P[BASE + 0], P[BASE + 1]), a1 = pk_act(P[BASE + 2], P[BASE + 3]);   \
    unsigned b0 = pk_act(P[BASE + 4], P[BASE + 5]), b1 = pk_act(P[BASE + 6], P[BASE + 7]);                              \
    auto r0 = __builtin_amdgcn_permlane32_swap(a0, b0, false, false); auto r1 = __builtin_amdgcn_permlane32_swap(a1, b1, false, false); \
    u32x4 w = {r0[0], r1[0], r0[1], r1[1]}; OUT = *reinterpret_cast<bf16x8*>(&w); } while (0)
  PK4(p0, 0, pa0); PK4(p0, 8, pa1); PK4(p1, 0, pa2); PK4(p1, 8, pa3);
#undef PK4
}
__device__ __forceinline__ void qkt(f32x16& p0, f32x16& p1, const LAS char* Ks, const bf16x8* qr, int r32, int hi) {
  p0 = f32x16{}; p1 = f32x16{};
#pragma unroll
  for (int d0 = 0; d0 < 8; ++d0) { int cb = (d0 * 16 + hi * 8) * 2;
    bf16x8 b0 = *reinterpret_cast<const LAS bf16x8*>(Ks + KSWZ(r32, cb));
    bf16x8 b1 = *reinterpret_cast<const LAS bf16x8*>(Ks + KSWZ(32 + r32, cb));
    p0 = mma32_act(b0, qr[d0], p0);
    p1 = mma32_act(b1, qr[d0], p1); }
}
__device__ __forceinline__ int v_st(int k, int c) { const int kk = (k & ~0xC) | ((k & 4) << 1) | ((k & 8) >> 1); return ((kk >> 3) * 4 + (c >> 5)) * 512 + ((kk & 7) * 32 + (c & 31)) * 2; }
__device__ __forceinline__ int v_rd_base(int lane) { return ((lane & 3) << 3) | (((lane >> 2) & 3) << 6) | (((lane >> 4) & 1) << 5) | (((lane >> 5) & 1) << 8); }
constexpr int v_rd_off(int d0, int ks, int half) { return d0 * 512 + ks * 4096 + half * 2048; }
template <int OFF> __device__ __forceinline__ s16x4 tr_read(int vb) {
  s16x4 r; asm volatile("ds_read_b64_tr_b16 %0, %1 offset:%2" : "=&v"(r) : "v"(vb), "i"(OFF) : "memory"); return r;
}
template <int D0> __device__ __forceinline__ void pv_one(f32x16& od, int vb, bf16x8 pa0, bf16x8 pa1, bf16x8 pa2, bf16x8 pa3) {
  const s16x4 l0 = tr_read<v_rd_off(D0, 0, 0)>(vb), h0 = tr_read<v_rd_off(D0, 0, 1)>(vb), l1 = tr_read<v_rd_off(D0, 1, 0)>(vb), h1 = tr_read<v_rd_off(D0, 1, 1)>(vb);
  const s16x4 l2 = tr_read<v_rd_off(D0, 2, 0)>(vb), h2 = tr_read<v_rd_off(D0, 2, 1)>(vb), l3 = tr_read<v_rd_off(D0, 3, 0)>(vb), h3 = tr_read<v_rd_off(D0, 3, 1)>(vb);
  asm volatile("s_waitcnt lgkmcnt(0)" ::: "memory"); SBAR();
#define PK(L, H) (bf16x8){L[0], L[1], L[2], L[3], H[0], H[1], H[2], H[3]}
  od = mma32_act(pa0, PK(l0, h0), od);
  od = mma32_act(pa1, PK(l1, h1), od);
  od = mma32_act(pa2, PK(l2, h2), od);
  od = mma32_act(pa3, PK(l3, h3), od);
#undef PK
}
__device__ __forceinline__ void pv_d0(f32x16* o, int vb, bf16x8 pa0, bf16x8 pa1, bf16x8 pa2, bf16x8 pa3) {
  pv_one<0>(o[0], vb, pa0, pa1, pa2, pa3); pv_one<1>(o[1], vb, pa0, pa1, pa2, pa3); pv_one<2>(o[2], vb, pa0, pa1, pa2, pa3); pv_one<3>(o[3], vb, pa0, pa1, pa2, pa3);
}

__device__ __forceinline__ void attn_dense_body(const bf16* __restrict__ Qb, const bf16* __restrict__ Kh, const bf16* __restrict__ Vh,
                                                bf16* __restrict__ Ob, int seq, LAS char* lds) {
  const int tid = opaque_tid(), wid = tid >> 6, lane = tid & 63, r32 = lane & 31, hi = lane >> 5;
  LAS char* V_lds = lds; LAS char* K_lds = lds + 2 * SHM_V;
  LAS float* ws = (LAS float*)(lds + 2 * SHM_V + 2 * SHM_K) + wid * 64; LAS float* li_l = ws; LAS float* al_l = ws + 32;
  float m_reg = -1e30f, l_reg = 0; f32x16 o[4] = {}; bf16x8 qr[8];
  { const bf16* Qw = Qb + (long)(wid * QBLK + r32) * LDQ + hi * 8;
#pragma unroll
    for (int d0 = 0; d0 < 8; ++d0) qr[d0] = *reinterpret_cast<const bf16x8*>(Qw + d0 * 16); }
  const int sr = tid >> 4, sc = (tid & 15) * 8, vst0 = v_st(sr, sc), vst1 = v_st(32 + sr, sc);
  const int vb0 = (int)(unsigned)(uintptr_t)V_lds + v_rd_base(lane);
  struct { bf16x8 vs0, vs1, ks0, ks1; } sr_[2];
#define SLOAD(i, k0) do { sr_[i].vs0 = *reinterpret_cast<const bf16x8*>(&Vh[(long)((k0) + sr) * LDK + sc]); sr_[i].vs1 = *reinterpret_cast<const bf16x8*>(&Vh[(long)((k0) + 32 + sr) * LDK + sc]); \
    sr_[i].ks0 = *reinterpret_cast<const bf16x8*>(&Kh[(long)((k0) + sr) * LDK + sc]); sr_[i].ks1 = *reinterpret_cast<const bf16x8*>(&Kh[(long)((k0) + 32 + sr) * LDK + sc]); } while (0)
#define SWRITE(b, i) do { *(LAS bf16x8*)(V_lds + (b) * SHM_V + vst0) = sr_[i].vs0;          \
    *(LAS bf16x8*)(V_lds + (b) * SHM_V + vst1) = sr_[i].vs1; int kc = sc * 2;               \
    *(LAS bf16x8*)(K_lds + (b) * SHM_K + KSWZ(sr, kc)) = sr_[i].ks0;                       \
    *(LAS bf16x8*)(K_lds + (b) * SHM_K + KSWZ(32 + sr, kc)) = sr_[i].ks1; } while (0)
#define SWAIT() asm volatile("s_waitcnt vmcnt(4)" ::: "memory")
#define RESC(a) do { if (__any((a) < 1.f)) { if (hi == 0) al_l[r32] = (a); asm volatile("s_waitcnt lgkmcnt(0)" ::: "memory"); \
    _Pragma("unroll") for (int d = 0; d < 4; ++d) _Pragma("unroll") for (int r = 0; r < 16; ++r) o[d][r] *= al_l[crow(r, hi)]; } } while (0)
  f32x16 pA0, pA1, pB0, pB1; float mnA, mnB, alA, alB; bf16x8 pa0, pa1, pa2, pa3; const int NT = seq / KVBLK;
  constexpr int SE = 0, SO = 1;
  SLOAD(SE, 0); asm volatile("s_waitcnt vmcnt(0)" ::: "memory"); SWRITE(0, SE); __syncthreads();
  qkt(pA0, pA1, K_lds, qr, r32, hi); partialSM(pA0, pA1, m_reg, mnA, alA);
  SLOAD(SO, KVBLK); if (2 < NT) SLOAD(SE, 2 * KVBLK);
  SWAIT(); SWRITE(1, SO); __syncthreads();
  for (int j = 1; j + 1 < NT; j += 2) {
    SBAR(); qkt(pB0, pB1, K_lds + SHM_K, qr, r32, hi);
    finishSM(pA0, pA1, alA, l_reg, pa0, pa1, pa2, pa3); SBAR();
    SLOAD(SO, (j + 2) * KVBLK); SBAR();
    pv_d0(o, vb0, pa0, pa1, pa2, pa3); partialSM(pB0, pB1, m_reg, mnB, alB);
    __syncthreads(); SWAIT(); SWRITE(0, SE);
    RESC(alB); __syncthreads();
    SBAR(); qkt(pA0, pA1, K_lds, qr, r32, hi);
    finishSM(pB0, pB1, alB, l_reg, pa0, pa1, pa2, pa3); SBAR();
    if (j + 3 < NT) SLOAD(SE, (j + 3) * KVBLK); SBAR();
    pv_d0(o, vb0 + (int)SHM_V, pa0, pa1, pa2, pa3); partialSM(pA0, pA1, m_reg, mnA, alA);
    __syncthreads(); SWAIT(); SWRITE(1, SO);
    RESC(alA); __syncthreads();
  }
  SBAR(); qkt(pB0, pB1, K_lds + SHM_K, qr, r32, hi);
  finishSM(pA0, pA1, alA, l_reg, pa0, pa1, pa2, pa3); SBAR();
  pv_d0(o, vb0, pa0, pa1, pa2, pa3); partialSM(pB0, pB1, m_reg, mnB, alB);
  __syncthreads(); RESC(alB);
  finishSM(pB0, pB1, alB, l_reg, pa0, pa1, pa2, pa3); SBAR();
  pv_d0(o, vb0 + (int)SHM_V, pa0, pa1, pa2, pa3);
  if (hi == 0) li_l[r32] = l_reg; asm volatile("s_waitcnt lgkmcnt(0)" ::: "memory");
  float rli[16];
#pragma unroll
  for (int r = 0; r < 16; ++r) rli[r] = __builtin_amdgcn_rcpf(li_l[crow(r, hi)]);
  bf16* Ow = Ob + (long)(wid * QBLK) * LDO;
#pragma unroll
  for (int r = 0; r < 16; ++r) { int orow = crow(r, hi);
#pragma unroll
    for (int d0 = 0; d0 < 4; ++d0) Ow[(long)orow * LDO + d0 * 32 + r32] = f2act(o[d0][r] * rli[r]); }
  __syncthreads();
#undef SLOAD
#undef SWRITE
#undef SWAIT
#undef RESC
}
#undef KSWZ
#undef SBAR
}

namespace gla {
constexpr int L_LA = 0;
constexpr int L_TOT = L_LA + 64 * 132 * 4;
constexpr int L_WG = L_TOT + 2048;
constexpr int L_BG = L_WG + 8192;
constexpr int L_QE = L_BG + 512;
constexpr int L_KE = L_QE + 64 * 136 * 2;
constexpr int L_KLT = L_KE + 64 * 136 * 2;
constexpr int L_ATT = L_KLT + 128 * 72 * 2;
constexpr int L_END1 = L_ATT + 64 * 72 * 2;
constexpr int M_QE = 0, M_ATT = M_QE + 64 * 272, M_KLT = M_ATT + 64 * 144, M_VT = M_KLT + 128 * 144, M_SB = M_VT + 64 * 144, M_EB = M_SB + 64 * 272, M_BUF = M_EB + 512;
static_assert(L_END1 <= MISC_OFF && 2 * M_BUF <= MISC_OFF, "GLA LDS map");
constexpr size_t GW_QE_SZ = 64 * 128, GW_ATT_SZ = 64 * 64, GW_KLT_SZ = 128 * 64, GW_EB_SZ = 128;
constexpr int G1_ITEMS = (NTOK / 64) * 4 * 2;

__device__ __forceinline__ float log_sigmoid(float x) { return fminf(x, 0.f) - __logf(1.f + __expf(-fabsf(x))); }
__device__ __forceinline__ f32x4 mma16(bf16x8 a, bf16x8 b, f32x4 c) { return __builtin_amdgcn_mfma_f32_16x16x32_bf16(a, b, c, 0, 0, 0); }

__device__ __forceinline__ void g1_item(LAS unsigned char* lds, const bf16* __restrict__ Z, const float* __restrict__ wg, const float* __restrict__ bg,
                                        bf16* __restrict__ gQE, bf16* __restrict__ gATT, bf16* __restrict__ gKLT, float* __restrict__ gEB, int row0, int h, int dir) {
    const int tid = opaque_tid(), lane = tid & 63, w = __builtin_amdgcn_readfirstlane(tid >> 6), fr = lane & 15, fq = lane >> 4;
    LAS float* LA = (LAS float*)(lds + L_LA); LAS float* TOT = (LAS float*)(lds + L_TOT);
    LAS float* WG = (LAS float*)(lds + L_WG); LAS float* BG = (LAS float*)(lds + L_BG);
    LAS unsigned char* QE = lds + L_QE; LAS unsigned char* KE = lds + L_KE; LAS unsigned char* KLT = lds + L_KLT; LAS unsigned char* ATT = lds + L_ATT;
    for (int idx = tid; idx < 16 * 128; idx += 512) WG[idx] = wg[(idx >> 7) * 512 + (idx & 127)];
    if (tid < 128) BG[tid] = bg[tid];
    const int i0 = tid >> 4, g8 = tid & 15;
    const int gacol = dir ? ZGAB : ZGAF;
    u32x4 rq[2], rk[2], rga[2][2];
#pragma unroll
    for (int e = 0; e < 2; ++e) { const int i = i0 + 32 * e; const bf16* zr = Z + (size_t)(row0 + (dir ? 63 - i : i)) * NZ;
        rq[e] = *(const u32x4*)(zr + ZGQ + h * 128 + g8 * 8); rk[e] = *(const u32x4*)(zr + ZGK + h * 128 + g8 * 8);
        rga[e][0] = *(const u32x4*)(zr + gacol); rga[e][1] = *(const u32x4*)(zr + gacol + 8); }
    __syncthreads();
#pragma unroll
    for (int e = 0; e < 2; ++e) {
        float x[8];
        { const f32x4 b0 = *(const LAS f32x4*)(BG + g8 * 8), b1 = *(const LAS f32x4*)(BG + g8 * 8 + 4);
#pragma unroll
          for (int j = 0; j < 4; ++j) { x[j] = b0[j]; x[4 + j] = b1[j]; } }
#pragma unroll
        for (int r = 0; r < 16; ++r) { const unsigned wd = rga[e][r >> 3][(r & 7) >> 1]; const float gar = (r & 1) ? hi_act(wd) : lo_act(wd);
            const f32x4 w0 = *(const LAS f32x4*)(WG + r * 128 + g8 * 8), w1 = *(const LAS f32x4*)(WG + r * 128 + g8 * 8 + 4);
#pragma unroll
            for (int j = 0; j < 4; ++j) { x[j] = fmaf(gar, w0[j], x[j]); x[4 + j] = fmaf(gar, w1[j], x[4 + j]); }
            if ((r & 3) == 3) asm volatile("" ::: "memory"); }
        f32x4 o0, o1;
#pragma unroll
        for (int j = 0; j < 4; ++j) { o0[j] = log_sigmoid(x[j]) * 0.0625f; o1[j] = log_sigmoid(x[4 + j]) * 0.0625f; }
        *(LAS f32x4*)(LA + (i0 + 32 * e) * 132 + g8 * 8) = o0; *(LAS f32x4*)(LA + (i0 + 32 * e) * 132 + g8 * 8 + 4) = o1;
    }
    __syncthreads();
    { const int d = tid & 127, seg = tid >> 7; float v[16];
#pragma unroll
      for (int ii = 0; ii < 16; ++ii) v[ii] = LA[(seg * 16 + ii) * 132 + d];
      float run = 0.f;
#pragma unroll
      for (int ii = 0; ii < 16; ++ii) { run += v[ii]; LA[(seg * 16 + ii) * 132 + d] = run; }
      TOT[seg * 128 + d] = run; }
    __syncthreads();
    {
        float t0[8], t1[8], t2[8], t3[8];
        { const f32x4 a0 = *(const LAS f32x4*)(TOT + g8 * 8), a1 = *(const LAS f32x4*)(TOT + g8 * 8 + 4), b0 = *(const LAS f32x4*)(TOT + 128 + g8 * 8), b1 = *(const LAS f32x4*)(TOT + 128 + g8 * 8 + 4);
          const f32x4 c0 = *(const LAS f32x4*)(TOT + 256 + g8 * 8), c1 = *(const LAS f32x4*)(TOT + 256 + g8 * 8 + 4), d0 = *(const LAS f32x4*)(TOT + 384 + g8 * 8), d1 = *(const LAS f32x4*)(TOT + 384 + g8 * 8 + 4);
#pragma unroll
          for (int j = 0; j < 4; ++j) { t0[j] = a0[j]; t0[4 + j] = a1[j]; t1[j] = b0[j]; t1[4 + j] = b1[j]; t2[j] = c0[j]; t2[4 + j] = c1[j]; t3[j] = d0[j]; t3[4 + j] = d1[j]; } }
        float blast[8];
#pragma unroll
        for (int j = 0; j < 8; ++j) blast[j] = (t0[j] + t1[j]) + (t2[j] + t3[j]);
        if (tid < 16) { f32x4 e0, e1;
#pragma unroll
            for (int j = 0; j < 4; ++j) { e0[j] = __expf(blast[j]); e1[j] = __expf(blast[4 + j]); }
            *(f32x4*)(gEB + g8 * 8) = e0; *(f32x4*)(gEB + g8 * 8 + 4) = e1; }
#pragma unroll
        for (int e = 0; e < 2; ++e) {
            const int i = i0 + 32 * e, seg = i >> 4;
            const f32x4 l0 = *(const LAS f32x4*)(LA + i * 132 + g8 * 8), l1 = *(const LAS f32x4*)(LA + i * 132 + g8 * 8 + 4);
            float bq[8], kl[8], qe[8], ke[8], qv[8], kv[8];
#pragma unroll
            for (int q = 0; q < 4; ++q) { qv[2 * q] = lo_act(rq[e][q]); qv[2 * q + 1] = hi_act(rq[e][q]); kv[2 * q] = lo_act(rk[e][q]); kv[2 * q + 1] = hi_act(rk[e][q]); }
#pragma unroll
            for (int j = 0; j < 8; ++j) { float off = 0.f; if (seg > 0) off += t0[j]; if (seg > 1) off += t1[j]; if (seg > 2) off += t2[j];
                bq[j] = (j < 4 ? l0[j] : l1[j - 4]) + off;
                qe[j] = qv[j] * 0.088388347648318440f * __expf(bq[j]); ke[j] = kv[j] * __expf(-bq[j]); kl[j] = kv[j] * __expf(blast[j] - bq[j]); }
            const u32x4 wq = {cvt_pk_bf16(qe[0], qe[1]), cvt_pk_bf16(qe[2], qe[3]), cvt_pk_bf16(qe[4], qe[5]), cvt_pk_bf16(qe[6], qe[7])};
            const u32x4 wk = {cvt_pk_bf16(ke[0], ke[1]), cvt_pk_bf16(ke[2], ke[3]), cvt_pk_bf16(ke[4], ke[5]), cvt_pk_bf16(ke[6], ke[7])};
            *(LAS u32x4*)(QE + i * 272 + g8 * 16) = wq; *(LAS u32x4*)(KE + i * 272 + g8 * 16) = wk;
            *(u32x4*)(gQE + i * 128 + g8 * 8) = wq;
#pragma unroll
            for (int j = 0; j < 8; ++j) *(LAS bf16*)(KLT + (g8 * 8 + j) * 144 + i * 2) = f2bf(kl[j]);
        }
    }
    __syncthreads();
    { const int ti = w >> 1;
#pragma unroll
      for (int jj = 0; jj < 2; ++jj) { const int tj = (w & 1) * 2 + jj; f32x4 a = {0.f, 0.f, 0.f, 0.f};
          if (tj <= ti) {
#pragma unroll
              for (int ks = 0; ks < 4; ++ks) { const bf16x8 af = *(const LAS bf16x8*)(QE + (ti * 16 + fr) * 272 + (ks * 32 + fq * 8) * 2), bfr = *(const LAS bf16x8*)(KE + (tj * 16 + fr) * 272 + (ks * 32 + fq * 8) * 2);
                  a = mma16(af, bfr, a); } }
#pragma unroll
          for (int r = 0; r < 4; ++r) { const int i = ti * 16 + 4 * fq + r, j = tj * 16 + fr; *(LAS bf16*)(ATT + i * 144 + j * 2) = f2bf(j <= i ? a[r] : 0.f); } } }
#pragma unroll
    for (int e = 0; e < 2; ++e) { const int p = tid + 512 * e, row = p >> 3, c8 = p & 7; *(u32x4*)(gKLT + row * 64 + c8 * 8) = *(const LAS u32x4*)(KLT + row * 144 + c8 * 16); }
    __syncthreads();
    { const int row = tid >> 3, c8 = tid & 7; *(u32x4*)(gATT + row * 64 + c8 * 8) = *(const LAS u32x4*)(ATT + row * 144 + c8 * 16); }
    __syncthreads();
}

__device__ __forceinline__ void g2_item(LAS unsigned char* lds, const bf16* __restrict__ Z, float* __restrict__ OUT, const bf16* __restrict__ gQE, const bf16* __restrict__ gATT,
                                        const bf16* __restrict__ gKLT, const float* __restrict__ gEB, const float* __restrict__ st_in, float* __restrict__ st_out,
                                        int T, int tokbase, int h, int dir, int dvq) {
    const int tid = opaque_tid(), lane = tid & 63, w = __builtin_amdgcn_readfirstlane(tid >> 6), fr = lane & 15, fq = lane >> 4;
    const int NC = T >> 6;
    f32x4 S[4];
    const int soff = (16 * w + 4 * fq) * 256 + dvq * 64 + fr;
#pragma unroll
    for (int n = 0; n < 4; ++n) S[n] = (f32x4){0.f, 0.f, 0.f, 0.f};
    if (st_in) {
#pragma unroll
        for (int n = 0; n < 4; ++n)
#pragma unroll
            for (int r = 0; r < 4; ++r) S[n][r] = st_in[soff + r * 256 + n * 16];
    }
    const int iv = tid >> 3, vg = tid & 7;
    u32x4 pq[2], pk[2], pa, pv; float peb = 0.f;
#define G2_LOAD(cs) do { const int cf_ = dir ? NC - 1 - (cs) : (cs); const size_t gi_ = ((size_t)((tokbase >> 6) + cf_) * 4 + h) * 2 + dir; \
        const bf16* q_ = gQE + gi_ * GW_QE_SZ; const bf16* k_ = gKLT + gi_ * GW_KLT_SZ; \
        pq[0] = *(const u32x4*)(q_ + tid * 8); pq[1] = *(const u32x4*)(q_ + (tid + 512) * 8); pk[0] = *(const u32x4*)(k_ + tid * 8); pk[1] = *(const u32x4*)(k_ + (tid + 512) * 8); \
        pa = *(const u32x4*)(gATT + gi_ * GW_ATT_SZ + tid * 8); if (tid < 128) peb = gEB[gi_ * GW_EB_SZ + tid]; \
        pv = *(const u32x4*)(Z + (size_t)(tokbase + cf_ * 64 + (dir ? 63 - iv : iv)) * NZ + ZGV + h * 256 + dvq * 64 + vg * 8); } while (0)
    G2_LOAD(0);
    for (int cs = 0; cs < NC; ++cs) {
        LAS unsigned char* B = lds + (cs & 1) * M_BUF;
#pragma unroll
        for (int e = 0; e < 2; ++e) { const int p = tid + 512 * e; *(LAS u32x4*)(B + M_QE + (p >> 4) * 272 + (p & 15) * 16) = pq[e]; *(LAS u32x4*)(B + M_KLT + (p >> 3) * 144 + (p & 7) * 16) = pk[e]; }
        *(LAS u32x4*)(B + M_ATT + iv * 144 + vg * 16) = pa;
        if (tid < 128) *(LAS float*)(B + M_EB + tid * 4) = peb;
#pragma unroll
        for (int q = 0; q < 4; ++q) { *(LAS bf16*)(B + M_VT + (vg * 8 + 2 * q) * 144 + iv * 2) = f2bf(lo_act(pv[q])); *(LAS bf16*)(B + M_VT + (vg * 8 + 2 * q + 1) * 144 + iv * 2) = f2bf(hi_act(pv[q])); }
#pragma unroll
        for (int n = 0; n < 4; ++n) { const u32x2 ws2 = {cvt_pk_bf16(S[n][0], S[n][1]), cvt_pk_bf16(S[n][2], S[n][3])}; *(LAS u32x2*)(B + M_SB + (n * 16 + fr) * 272 + (16 * w + 4 * fq) * 2) = ws2; }
        if (cs + 1 < NC) G2_LOAD(cs + 1);
        __syncthreads();
        { const int ti = w >> 1; const int cf = dir ? NC - 1 - cs : cs;
#pragma unroll
          for (int jj = 0; jj < 2; ++jj) { const int tn = (w & 1) * 2 + jj; f32x4 a = {0.f, 0.f, 0.f, 0.f};
#pragma unroll
              for (int ks = 0; ks < 4; ++ks) { const bf16x8 af = *(const LAS bf16x8*)(B + M_QE + (ti * 16 + fr) * 272 + (ks * 32 + fq * 8) * 2), bfr = *(const LAS bf16x8*)(B + M_SB + (tn * 16 + fr) * 272 + (ks * 32 + fq * 8) * 2);
                  a = mma16(af, bfr, a); }
#pragma unroll
              for (int ks = 0; ks < 2; ++ks) { const bf16x8 af = *(const LAS bf16x8*)(B + M_ATT + (ti * 16 + fr) * 144 + (ks * 32 + fq * 8) * 2), bfr = *(const LAS bf16x8*)(B + M_VT + (tn * 16 + fr) * 144 + (ks * 32 + fq * 8) * 2);
                  a = mma16(af, bfr, a); }
#pragma unroll
              for (int r = 0; r < 4; ++r) { const int i = ti * 16 + 4 * fq + r; OUT[(size_t)(tokbase + cf * 64 + (dir ? 63 - i : i)) * 1024 + h * 256 + dvq * 64 + tn * 16 + fr] = a[r]; } } }
        { const f32x4 eb = *(const LAS f32x4*)(B + M_EB + (16 * w + 4 * fq) * 4);
#pragma unroll
          for (int n = 0; n < 4; ++n) { S[n] = S[n] * eb;
#pragma unroll
              for (int ks = 0; ks < 2; ++ks) { const bf16x8 af = *(const LAS bf16x8*)(B + M_KLT + (16 * w + fr) * 144 + (ks * 32 + fq * 8) * 2), bfr = *(const LAS bf16x8*)(B + M_VT + (n * 16 + fr) * 144 + (ks * 32 + fq * 8) * 2);
                  S[n] = mma16(af, bfr, S[n]); } } }
    }
    if (st_out) {
        int fr2 = fr; asm volatile("" : "+v"(fr2));
        const int soff2 = (16 * w + 4 * fq) * 256 + dvq * 64 + fr2;
#pragma unroll
        for (int n = 0; n < 4; ++n)
#pragma unroll
            for (int r = 0; r < 4; ++r) st_out[soff2 + r * 256 + n * 16] = S[n][r];
    }
    __syncthreads();
#undef G2_LOAD
}
}

#define XB_TMO      128
#define XB_XCNT(j)  (256  + 64 * (j))
#define XB_XSUB(j)  (1280 + 64 * (j))
#define XB_XGEN(j)  (2304 + 64 * (j))
#define XB_TOP      3328
#define XB_TOPGEN   3392
#define XCD_BAR_WORDS 3456
#define XB_SPIN_CAP (1u << 18)
__device__ __forceinline__ unsigned xb_ld(unsigned* p)              { return __hip_atomic_load(p, __ATOMIC_RELAXED, __HIP_MEMORY_SCOPE_AGENT); }
__device__ __forceinline__ unsigned xb_add(unsigned* p, unsigned v) { return __hip_atomic_fetch_add(p, v, __ATOMIC_RELAXED, __HIP_MEMORY_SCOPE_AGENT); }
__device__ __forceinline__ unsigned xb_xcc_id() { return (unsigned)__builtin_amdgcn_s_getreg((3 << 11) | 20) & 0xFu; }
#define XB_SPIN(cond, bar) do { unsigned _sp = 0; while (cond) { __builtin_amdgcn_s_sleep(1); \
    if ((++_sp & 255u) == 0u) { if (xb_ld(&(bar)[XB_TMO])) break; if (_sp > XB_SPIN_CAP) { atomicAdd(&(bar)[XB_TMO], 1u); break; } } } } while (0)
struct XcdBarrier { unsigned* bar; unsigned x; volatile LAS unsigned* st; };
__device__ __forceinline__ XcdBarrier xcd_barrier_post(unsigned* bar, volatile LAS unsigned* st) {
    XcdBarrier b; b.bar = bar; b.x = xb_xcc_id(); b.st = st;
    if (threadIdx.x == 0) (void)xb_add(&bar[XB_XCNT(b.x)], 1u);
    return b;
}
__device__ __forceinline__ void xcd_barrier_complete(unsigned* bar, unsigned x, unsigned& nloc, unsigned& nx) {
    const unsigned G = gridDim.x * gridDim.y * gridDim.z;
    unsigned sum, cnt, mine, sp = 0u;
    for (;;) {
        sum = 0u; cnt = 0u; mine = 0u;
#pragma unroll
        for (unsigned j = 0; j < 16; ++j) { const unsigned c = xb_ld(&bar[XB_XCNT(j)]); sum += c; cnt += (c > 0u) ? 1u : 0u; mine = (j == x) ? c : mine; }
        if (sum == G) break;
        __builtin_amdgcn_s_sleep(1);
        if ((++sp & 255u) == 0u) { if (xb_ld(&bar[XB_TMO])) break; if (sp > XB_SPIN_CAP) { atomicAdd(&bar[XB_TMO], 1u); break; } }
    }
    nloc = mine > 0u ? mine : 1u; nx = cnt > 0u ? cnt : 1u;
}
__device__ __forceinline__ void xcd_barrier(const XcdBarrier& b) {
    asm volatile("s_waitcnt vmcnt(0)" ::: "memory");
    __syncthreads();
    if (threadIdx.x == 0) {
        unsigned* bar = b.bar;
        __builtin_amdgcn_s_waitcnt(0);
        unsigned nloc = b.st[0], nx = b.st[1];
        if (nloc == 0u) { xcd_barrier_complete(bar, b.x, nloc, nx); b.st[0] = nloc; b.st[1] = nx; }
        const unsigned old = xb_add(&bar[XB_XSUB(b.x)], 1u);
        const unsigned gen = old / nloc;
        if (old + 1u == (gen + 1u) * nloc) {
            __builtin_amdgcn_fence(__ATOMIC_RELEASE, "agent");
            asm volatile("s_waitcnt vmcnt(0)" ::: "memory");
            const unsigned og = xb_add(&bar[XB_TOP], 1u);
            const unsigned tg = og / nx;
            if (og + 1u == (tg + 1u) * nx) xb_add(&bar[XB_TOPGEN], 1u);
            else XB_SPIN(xb_ld(&bar[XB_TOPGEN]) == tg, bar);
            __builtin_amdgcn_fence(__ATOMIC_ACQUIRE, "agent");
            xb_add(&bar[XB_XGEN(b.x)], 1u);
            asm volatile("s_waitcnt vmcnt(0)" ::: "memory");
        } else {
            XB_SPIN(xb_ld(&bar[XB_XGEN(b.x)]) == gen, bar);
            __builtin_amdgcn_fence(__ATOMIC_ACQUIRE, "agent");
            asm volatile("s_waitcnt vmcnt(0)" ::: "memory");
        }
    }
    __syncthreads();
}

struct Args {
    const float *x_prompt, *x_sample, *cache_k, *cache_v, *state_f, *state_b, *cvec, *c_ctx, *w_ada, *b_ada, *norm1, *w_in, *q_norm, *k_norm, *w_fourier, *w_attn,
                *w_gate_f, *b_gate_f, *w_gate_b, *b_gate_b, *gla_norm, *w_gla, *w_out, *norm2, *w_up, *conv_w, *conv_b, *w_down, *final_norm;
    float* out; unsigned char* ws;
    int s_lo, s_hi, li, pad;
};
constexpr size_t OUT_YP = 0, OUT_YS = (size_t)NCTX * DM, OUT_CK = (size_t)NTOK * DM, OUT_CV = OUT_CK + (size_t)BCTX * DEPTH * TC * 256,
                 OUT_SF = OUT_CV + (size_t)BCTX * DEPTH * TC * 256, OUT_SB = OUT_SF + (size_t)BCTX * DEPTH * 4 * 128 * 256, OUT_END = OUT_SB + (size_t)BCTX * DEPTH * 4 * 128 * 256;

struct Frame { LAS unsigned char* lds; int tid, lane, wave, G, bid; };
__device__ __forceinline__ Frame frame_now(LAS unsigned char* lds) {
    Frame F; F.lds = lds; F.tid = opaque_tid(); F.lane = F.tid & 63; F.wave = __builtin_amdgcn_readfirstlane(F.tid >> 6); F.G = gridDim.x; F.bid = blockIdx.x; return F; }

__device__ __forceinline__ void transpose_item(const float* __restrict__ W, int N, bf16* __restrict__ WT, int ldd, int koff, int kb, int nb, int row_shift_from, int row_shift, LAS unsigned char* scr, int lane) {
    const int k0 = kb * 128, n0 = nb * 32, c4 = lane & 7, kr = lane >> 3;
#pragma unroll 4
    for (int i = 0; i < 16; ++i) { const int k = 8 * i + kr; const f32x4 v = *(const f32x4*)(W + (size_t)(k0 + k) * N + n0 + 4 * c4);
#pragma unroll
        for (int j = 0; j < 4; ++j) *(LAS bf16*)(scr + (4 * c4 + j) * 272 + k * 2) = f2act(v[j]); }
    LDS_WAIT(); asm volatile("" ::: "memory");
    const int kc = lane & 15;
#pragma unroll
    for (int j = 0; j < 8; ++j) { const int n = (lane >> 4) + 4 * j; const u32x4 o = *(const LAS u32x4*)(scr + n * 272 + kc * 16);
        int row = n0 + n; if (row >= row_shift_from) row += row_shift;
        *(u32x4*)(WT + (size_t)row * ldd + koff + k0 + kc * 8) = o; }
    LDS_WAIT(); asm volatile("" ::: "memory");
}
constexpr int TI_IN = 16 * 369, TI_F = 8 * 64, TI_AT = 8 * 64, TI_GL = 8 * 64, TI_OUT = 16 * 64, TI_UP = 16 * 352, TI_DN = 44 * 64;
constexpr int TI_LAYER = TI_IN + TI_F + TI_AT + TI_GL + TI_OUT + TI_UP + TI_DN;

__device__ __forceinline__ void phase_prologue_a(LAS unsigned char* lds_, const Args& a) {
    const Frame F = frame_now(lds_);
    unsigned char* ws = a.ws;
    {
        LAS unsigned char* scr = F.lds + F.wave * 8704;
        const int gw = F.bid * NWAVES + F.wave, NGW = F.G * NWAVES;
        for (int it = gw; it < DEPTH * TI_LAYER; it += NGW) {
            const int l = it / TI_LAYER; int r = it - l * TI_LAYER;
            if (r < TI_IN) { transpose_item(a.w_in + (size_t)l * DM * N_IN, N_IN, (bf16*)(ws + WS_WIN + l * SZ_WIN), DM, 0, r / 369, r % 369, ZPAD, ZGATE - ZPAD, scr, F.lane); continue; } r -= TI_IN;
            if (r < TI_F) { transpose_item(a.w_fourier + (size_t)l * 1024 * DM, DM, (bf16*)(ws + WS_WFT + l * SZ_WFT), 1024, 0, r / 64, r % 64, 1 << 30, 0, scr, F.lane); continue; } r -= TI_F;
            if (r < TI_AT) { transpose_item(a.w_attn + (size_t)l * 1024 * DM, DM, (bf16*)(ws + WS_WMRG + l * SZ_WMRG), KMRG, 2048, r / 64, r % 64, 1 << 30, 0, scr, F.lane); continue; } r -= TI_AT;
            if (r < TI_GL) { transpose_item(a.w_gla + (size_t)l * 1024 * DM, DM, (bf16*)(ws + WS_WMRG + l * SZ_WMRG), KMRG, 3072, r / 64, r % 64, 1 << 30, 0, scr, F.lane); continue; } r -= TI_GL;
            if (r < TI_OUT) { transpose_item(a.w_out + (size_t)l * DM * DM, DM, (bf16*)(ws + WS_WOUT + l * SZ_WOUT), DM, 0, r / 64, r % 64, 1 << 30, 0, scr, F.lane); continue; } r -= TI_OUT;
            if (r < TI_UP) { transpose_item(a.w_up + (size_t)l * DM * NUP, NUP, (bf16*)(ws + WS_WUP + l * SZ_WUP), DM, 0, r / 352, r % 352, 1 << 30, 0, scr, F.lane); continue; } r -= TI_UP;
            transpose_item(a.w_down + (size_t)l * DFF * DM, DM, (bf16*)(ws + WS_WDN + l * SZ_WDN), DFF, 0, r / 64, r % 64, 1 << 30, 0, scr, F.lane);
        }
    }
    const size_t gt = (size_t)F.bid * 512 + F.tid, NGT = (size_t)F.G * 512;
    for (size_t i = gt; i < (size_t)DEPTH * (ZGATE - ZPAD) * DM / 8; i += NGT) { const size_t l = i / ((ZGATE - ZPAD) * DM / 8), r = i % ((ZGATE - ZPAD) * DM / 8);
        *(u32x4*)(ws + WS_WIN + l * SZ_WIN + (size_t)ZPAD * DM * 2 + r * 16) = (u32x4){0u, 0u, 0u, 0u}; }
    for (size_t i = gt; i < (size_t)2048 * 1024; i += NGT) {
        const int kp = (int)(i >> 10), j = (int)(i & 1023), cs = kp >> 10, g = (kp >> 7) & 7, c = kp & 127, g2 = j >> 7, jj = j & 127; float v = 0.f;
        if (g == g2) { const int m = (c * jj) & 127; const float ang = (float)m * (1.f / 128.f); v = (cs ? -sinpif(2.f * ang) : cospif(2.f * ang)) * 0.088388347648318440f; }
        ((bf16*)(ws + WS_DT))[i] = f2act(v); }
    for (size_t i = gt; i < (size_t)512 * 256; i += NGT) { const int kp = (int)(i >> 8), t = (int)(i & 255), cs = kp >> 8, k = kp & 255, m = (k * t) & 255; const float ang = (float)m * (1.f / 256.f);
        ((bf16*)(ws + WS_ACTX))[i] = f2act((cs ? sinpif(2.f * ang) : cospif(2.f * ang)) * 0.0625f); }
    for (size_t i = gt; i < (size_t)2048 * 1024; i += NGT) { const int kp = (int)(i >> 10), t = (int)(i & 1023), cs = kp >> 10, k = kp & 1023, m = (k * t) & 1023; const float ang = (float)m * (1.f / 1024.f);
        ((bf16*)(ws + WS_ALAT))[i] = f2act((cs ? sinpif(2.f * ang) : cospif(2.f * ang)) * 0.03125f); }
    __syncthreads();
    {
        LAS float* SC = (LAS float*)F.lds;
        for (int i = F.tid; i < NMODV * DM; i += 512) { const int j = i >> 11, k = i & 2047; const float cv = j == 0 ? a.c_ctx[k] : a.cvec[(j - 1) * DM + k]; SC[i] = siluf_(cv); }
        __syncthreads();
        float* MP = (float*)(ws + WS_MODP);
        for (int u = F.bid; u < DEPTH * 16 * 6; u += F.G) {
            const int l = u / 96, kc = (u % 96) / 6, nb = u % 6, n = nb * 2048 + F.tid * 4;
            f32x4 acc[NMODV];
#pragma unroll
            for (int j = 0; j < NMODV; ++j) acc[j] = (f32x4){0.f, 0.f, 0.f, 0.f};
            const float* wp = a.w_ada + ((size_t)l * DM + kc * 128) * NMOD + n;
#pragma unroll 8
            for (int k = 0; k < 128; ++k) { const f32x4 wv = *(const f32x4*)(wp + (size_t)k * NMOD);
#pragma unroll
                for (int j = 0; j < NMODV; ++j) acc[j] = acc[j] + wv * SC[j * DM + kc * 128 + k]; }
#pragma unroll
            for (int j = 0; j < NMODV; ++j) *(f32x4*)(MP + (((size_t)kc * DEPTH + l) * NMODV + j) * NMOD + n) = acc[j];
        }
        __syncthreads();
    }
}
__device__ __forceinline__ void phase_mod_reduce(LAS unsigned char* lds_, const Args& a) {
    const Frame F = frame_now(lds_);
    const float* MP = (const float*)(a.ws + WS_MODP); float* MOD = (float*)(a.ws + WS_MOD);
    for (size_t i = (size_t)F.bid * 512 + F.tid; i < (size_t)DEPTH * NMODV * NMOD / 4; i += (size_t)F.G * 512) {
        const size_t e = i * 4; const int n = (int)(e % NMOD), l = (int)(e / ((size_t)NMODV * NMOD));
        f32x4 s = *(const f32x4*)(a.b_ada + (size_t)l * NMOD + n);
#pragma unroll
        for (int kc = 0; kc < 16; ++kc) s = s + *(const f32x4*)(MP + (size_t)kc * DEPTH * NMODV * NMOD + e);
        *(f32x4*)(MOD + e) = s; }
}

__device__ __forceinline__ void phase_norm(LAS unsigned char* lds_, const Args& a, int l, int which, bool first) {
    const Frame F = frame_now(lds_);
    const float* MOD = (const float*)(a.ws + WS_MOD) + (size_t)l * NMODV * NMOD + (which ? 3 * DM : 0);
    const float* wn = (which ? a.norm2 : a.norm1) + (size_t)l * DM;
    float* X = (float*)(a.ws + WS_X); bf16* H = (bf16*)(a.ws + WS_H);
    const int gw = F.bid * NWAVES + F.wave, NGW = F.G * NWAVES;
    for (int r = gw; r < NTOK; r += NGW) {
        const float* src = first ? (r < NCTX ? a.x_prompt + (size_t)r * DM : a.x_sample + (size_t)(r - NCTX) * DM) : X + (size_t)r * DM;
        f32x4 v[8]; float ss = 0.f;
#pragma unroll
        for (int j = 0; j < 8; ++j) { v[j] = *(const f32x4*)(src + 4 * F.lane + 256 * j); ss += (v[j][0] * v[j][0] + v[j][1] * v[j][1]) + (v[j][2] * v[j][2] + v[j][3] * v[j][3]); }
        if (first) {
#pragma unroll
            for (int j = 0; j < 8; ++j) *(f32x4*)(X + (size_t)r * DM + 4 * F.lane + 256 * j) = v[j]; }
        const float rstd = rsqrtf(wave_sum(ss) * (1.f / DM) + EPS);
        const float* mr = MOD + (size_t)mod_row(r) * NMOD;
#pragma unroll
        for (int j = 0; j < 8; ++j) { const int c = 4 * F.lane + 256 * j; const f32x4 w4 = *(const f32x4*)(wn + c), sh = *(const f32x4*)(mr + c), sc = *(const f32x4*)(mr + DM + c);
            const f32x4 hval = v[j] * rstd * w4 * (sc + 1.f) + sh;
            u32x2 o = {pk_act(hval[0], hval[1]), pk_act(hval[2], hval[3])}; *(u32x2*)(H + (size_t)r * DM + c) = o; }
    }
}
__device__ __forceinline__ void phase_final_norm(LAS unsigned char* lds_, const Args& a) {
    const Frame F = frame_now(lds_);
    const float* X = (const float*)(a.ws + WS_X);
    const int gw = F.bid * NWAVES + F.wave, NGW = F.G * NWAVES;
    for (int r = gw; r < NTOK; r += NGW) {
        f32x4 v[8]; float ss = 0.f;
#pragma unroll
        for (int j = 0; j < 8; ++j) { v[j] = *(const f32x4*)(X + (size_t)r * DM + 4 * F.lane + 256 * j); ss += (v[j][0] * v[j][0] + v[j][1] * v[j][1]) + (v[j][2] * v[j][2] + v[j][3] * v[j][3]); }
        const float rstd = rsqrtf(wave_sum(ss) * (1.f / DM) + EPS);
#pragma unroll
        for (int j = 0; j < 8; ++j) { const int c = 4 * F.lane + 256 * j; f32x4 yv = v[j] * rstd * *(const f32x4*)(a.final_norm + c);
#ifdef MK_PROBE_NOISE
            { const unsigned hsh = ((unsigned)r * 2654435761u) ^ ((unsigned)c * 40503u); const float dn = 0.03f;
              yv[0] += (hsh & 1u) ? dn : -dn; yv[1] += (hsh & 2u) ? dn : -dn; yv[2] += (hsh & 4u) ? dn : -dn; yv[3] += (hsh & 8u) ? dn : -dn; }
#endif
            *(f32x4*)(a.out + OUT_YP + (size_t)r * DM + c) = yv; }
    }
}

__device__ __forceinline__ void phase_prep(LAS unsigned char* lds_, const Args& a, int l) {
    const Frame F = frame_now(lds_);
    const bf16* Z = (const bf16*)(a.ws + WS_Z);
    bf16* KC = (bf16*)(a.ws + WS_KC); bf16* VC = (bf16*)(a.ws + WS_VC); bf16* KL = (bf16*)(a.ws + WS_KL); bf16* VL = (bf16*)(a.ws + WS_VL);
    const int gw = F.bid * NWAVES + F.wave, NGW = F.G * NWAVES, lane = F.lane;
    LAS bf16* tile = (LAS bf16*)(F.lds + F.wave * 8448);
    for (int it = gw; it < NTOK + 1024 + 2048; it += NGW) {
        if (it < NTOK) {
            const int r = it, hh = lane >> 5, i = lane & 31; const bf16* zr = Z + (size_t)r * NZ;
            float kx[4]; float ss = 0.f;
#pragma unroll
            for (int q = 0; q < 4; ++q) { kx[q] = act2f(zr[ZK + hh * 128 + i + 32 * q]); ss += kx[q] * kx[q]; }
            ss = half_sum(ss);
            const float rstd = rsqrtf(ss * (1.f / 128.f) + EPS);
#pragma unroll
            for (int q = 0; q < 4; ++q) kx[q] *= rstd * a.k_norm[l * 128 + i + 32 * q];
            const u32x2 vv = *(const u32x2*)(zr + ZV + 4 * lane);
            {
                bf16* qo = (bf16*)(a.ws + WS_QN) + (size_t)r * 1024;
                const bool lat = r >= NCTX; const int tq = (r - NCTX) & 1023; const float prow = (float)(tq >> 6), pcol = (float)(tq & 63);
                const float inv = exp2f(-(float)i * 0.41524101186092029f);
                float sr = 0.f, cr = 1.f, sc2 = 0.f, cc2 = 1.f;
                if (lat) { sr = __sinf(prow * inv); cr = __cosf(prow * inv); sc2 = __sinf(pcol * inv); cc2 = __cosf(pcol * inv); }
                float qg[4];
#pragma unroll
                for (int q = 0; q < 4; ++q) qg[q] = a.q_norm[l * 128 + i + 32 * q];
#pragma unroll
                for (int hp = 0; hp < 4; ++hp) { const int hd = 2 * hp + hh; float qx[4]; float s2 = 0.f;
#pragma unroll
                    for (int q = 0; q < 4; ++q) { qx[q] = act2f(zr[ZQ + hd * 128 + i + 32 * q]); s2 += qx[q] * qx[q]; }
                    s2 = half_sum(s2);
                    const float rs = rsqrtf(s2 * (1.f / 128.f) + EPS);
#pragma unroll
                    for (int q = 0; q < 4; ++q) qx[q] *= rs * qg[q];
                    const float y0 = qx[0] * cr - qx[1] * sr, y1 = qx[1] * cr + qx[0] * sr, y2 = qx[2] * cc2 - qx[3] * sc2, y3 = qx[3] * cc2 + qx[2] * sc2;
                    qo[hd * 128 + i] = f2act(y0); qo[hd * 128 + i + 32] = f2act(y1); qo[hd * 128 + i + 64] = f2act(y2); qo[hd * 128 + i + 96] = f2act(y3); }
            }
            if (r < NCTX) {
                const int b = r >> 8, t = r & 255; const size_t oo = ((size_t)(b * DEPTH + l) * TC + t) * 256;
#pragma unroll
                for (int q = 0; q < 4; ++q) { KC[(size_t)r * 256 + hh * 128 + i + 32 * q] = f2act(kx[q]); a.out[OUT_CK + oo + hh * 128 + i + 32 * q] = kx[q]; }
                *(u32x2*)(VC + (size_t)r * 256 + 4 * lane) = vv;
                *(f32x4*)(a.out + OUT_CV + oo + 4 * lane) = (f32x4){lo_act(vv[0]), hi_act(vv[0]), lo_act(vv[1]), hi_act(vv[1])};
            } else {
                const int rr = r - NCTX, b = rr >> 10, t = rr & 1023; const float prow = (float)(t >> 6), pcol = (float)(t & 63);
                const float inv = exp2f(-(float)i * 0.41524101186092029f);
                { const float s = __sinf(prow * inv), c = __cosf(prow * inv), x1 = kx[0], x2 = kx[1]; kx[0] = x1 * c - x2 * s; kx[1] = x2 * c + x1 * s; }
                { const float s = __sinf(pcol * inv), c = __cosf(pcol * inv), x1 = kx[2], x2 = kx[3]; kx[2] = x1 * c - x2 * s; kx[3] = x2 * c + x1 * s; }
                const size_t ko = ((size_t)b * 1280 + 256 + t) * 256;
#pragma unroll
                for (int q = 0; q < 4; ++q) KL[ko + hh * 128 + i + 32 * q] = f2act(kx[q]);
                *(u32x2*)(VL + ko + 4 * lane) = vv;
            }
        } else if (it < NTOK + 1024) {
            const int rr = it - NTOK, b = rr >> 8, s = rr & 255; const size_t so = ((size_t)(b * DEPTH + l) * PAST + s) * 256 + 4 * lane, dst_o = ((size_t)b * 1280 + s) * 256 + 4 * lane;
            const f32x4 kk = *(const f32x4*)(a.cache_k + so), vv = *(const f32x4*)(a.cache_v + so);
            u32x2 ko = {pk_act(kk[0], kk[1]), pk_act(kk[2], kk[3])}, vo = {pk_act(vv[0], vv[1]), pk_act(vv[2], vv[3])};
            *(u32x2*)(KL + dst_o) = ko; *(u32x2*)(VL + dst_o) = vo;
        } else {
            const int ti = it - NTOK - 1024, tb = ti >> 4, cb = ti & 15, r0 = tb * 64, c0 = cb * 64;
#pragma unroll
            for (int j = 0; j < 8; ++j) { const int row = (lane >> 3) + 8 * j, cc = (lane & 7) * 8; const u32x4 w = *(const u32x4*)(Z + (size_t)(r0 + row) * NZ + ZF + c0 + cc);
#pragma unroll
                for (int q = 0; q < 4; ++q) *(LAS unsigned*)(tile + row * 66 + cc + 2 * q) = w[q]; }
            LDS_WAIT(); asm volatile("" ::: "memory");
            bf16* XT; int T, b, t0;
            if (r0 < NCTX) { XT = (bf16*)(a.ws + WS_XT); T = TC; b = r0 >> 8; t0 = r0 & 255; } else { XT = (bf16*)(a.ws + WS_XT) + (size_t)16384 * 256; T = TL; b = (r0 - NCTX) >> 10; t0 = (r0 - NCTX) & 1023; }
#pragma unroll
            for (int j = 0; j < 8; ++j) { const int ch = (lane >> 3) + 8 * j, tt = (lane & 7) * 8; unsigned o[4];
#pragma unroll
                for (int q = 0; q < 4; ++q) o[q] = (unsigned)tile[(tt + 2 * q) * 66 + ch] | ((unsigned)tile[(tt + 2 * q + 1) * 66 + ch] << 16);
                *(u32x4*)(XT + ((size_t)b * 1024 + c0 + ch) * T + t0 + tt) = (u32x4){o[0], o[1], o[2], o[3]}; }
            LDS_WAIT(); asm volatile("" ::: "memory");
        }
    }
}

__device__ __forceinline__ void phase_attn(LAS unsigned char* lds_, const Args& a, int l) {
    const Frame F = frame_now(lds_);
    bf16* AM = (bf16*)(a.ws + WS_AM);
    for (int u = F.bid; u < 256; u += F.G) {
        const bool lat = u < 128; const int uu = lat ? u : u - 128;
        const int b = lat ? (uu >> 5) : (uu >> 3), h = lat ? ((uu >> 2) & 7) : (uu & 7), qb = lat ? (uu & 3) : 0;
        const size_t row0 = lat ? (size_t)NCTX + b * 1024 + qb * 256 : (size_t)b * 256;
        const size_t kvo = (lat ? (size_t)b * 1280 * 256 : (size_t)b * 256 * 256) + (h >> 2) * 128;
        const bf16* Kp = (const bf16*)(a.ws + (lat ? WS_KL : WS_KC)) + kvo; const bf16* Vp = (const bf16*)(a.ws + (lat ? WS_VL : WS_VC)) + kvo;
        att::attn_dense_body((const bf16*)(a.ws + WS_QN) + row0 * 1024 + h * 128, Kp, Vp, AM + row0 * KMRG + 2048 + h * 128, lat ? 1280 : 256, (LAS char*)F.lds);
    }
}

__device__ __forceinline__ void phase_gla_g1(LAS unsigned char* lds_, const Args& a, int l) {
    const Frame F = frame_now(lds_);
    const bf16* Z = (const bf16*)(a.ws + WS_Z);
    for (int gi = F.bid; gi < gla::G1_ITEMS; gi += F.G) {
        const int chunk = gi >> 3, h = (gi >> 1) & 3, dir = gi & 1;
        const float* wg = (dir ? a.w_gate_b : a.w_gate_f) + (size_t)l * 16 * 512 + h * 128;
        const float* bg = (dir ? a.b_gate_b : a.b_gate_f) + (size_t)l * 512 + h * 128;
        gla::g1_item(F.lds, Z, wg, bg, (bf16*)(a.ws + WS_GQE) + (size_t)gi * gla::GW_QE_SZ, (bf16*)(a.ws + WS_GATT) + (size_t)gi * gla::GW_ATT_SZ,
                     (bf16*)(a.ws + WS_GKLT) + (size_t)gi * gla::GW_KLT_SZ, (float*)(a.ws + WS_GEB) + (size_t)gi * gla::GW_EB_SZ, chunk * 64, h, dir);
    }
}
__device__ __forceinline__ void phase_gla_g2(LAS unsigned char* lds_, const Args& a, int l) {
    const Frame F = frame_now(lds_);
    const bf16* Z = (const bf16*)(a.ws + WS_Z);
    const int first = F.G >= 256 ? F.bid - F.G / 2 : F.bid, stride = F.G >= 256 ? F.G / 2 : F.G;
    for (int slot = first; slot >= 0 && slot < 128; slot += stride) {
        for (int k = 0; k < 5; ++k) {
            int path, b, h, dir, dvq;
            if (k == 0) { path = 1; b = slot >> 5; h = (slot >> 3) & 3; dir = (slot >> 2) & 1; dvq = slot & 3; }
            else { const int it = slot * 4 + k - 1; path = 0; b = it >> 5; h = (it >> 3) & 3; dir = (it >> 2) & 1; dvq = it & 3; }
            float* OUT = (float*)(a.ws + (dir ? WS_OB : WS_OF));
            const size_t so = ((size_t)(b * DEPTH + l) * 4 + h) * 128 * 256;
            const float* st_in = path ? (dir ? a.state_b : a.state_f) + so : nullptr;
            float* st_out = path ? nullptr : a.out + (dir ? OUT_SB : OUT_SF) + so;
            gla::g2_item(F.lds, Z, OUT, (const bf16*)(a.ws + WS_GQE), (const bf16*)(a.ws + WS_GATT), (const bf16*)(a.ws + WS_GKLT), (const float*)(a.ws + WS_GEB),
                         st_in, st_out, path ? TL : TC, path ? NCTX + b * 1024 : b * 256, h, dir, dvq);
        }
    }
}
__device__ __forceinline__ void phase_gla_fin(LAS unsigned char* lds_, const Args& a, int l) {
    const Frame F = frame_now(lds_);
    const bf16* Z = (const bf16*)(a.ws + WS_Z); bf16* AM = (bf16*)(a.ws + WS_AM);
    const float* OF = (const float*)(a.ws + WS_OF); const float* OB = (const float*)(a.ws + WS_OB);
    const int gw = F.bid * NWAVES + F.wave, NGW = F.G * NWAVES;
    const f32x4 gn = *(const f32x4*)(a.gla_norm + l * 256 + 4 * F.lane);
    for (int it = gw; it < NTOK * 4; it += NGW) { const int r = it >> 2, h = it & 3; const size_t o = (size_t)r * 1024 + h * 256 + 4 * F.lane;
        const f32x4 v = *(const f32x4*)(OF + o) + *(const f32x4*)(OB + o);
        const float ss = wave_sum((v[0] * v[0] + v[1] * v[1]) + (v[2] * v[2] + v[3] * v[3]));
        const float rstd = rsqrtf(ss * (1.f / 256.f) + EPS);
        const u32x2 g = *(const u32x2*)(Z + (size_t)r * NZ + ZGR + h * 256 + 4 * F.lane);
        const f32x4 y = v * rstd * gn;
        u32x2 w = {pk_act(y[0] * siluf_(lo_act(g[0])), y[1] * siluf_(hi_act(g[0]))), pk_act(y[2] * siluf_(lo_act(g[1])), y[3] * siluf_(hi_act(g[1])))};
        *(u32x2*)(AM + (size_t)r * KMRG + 3072 + h * 256 + 4 * F.lane) = w; }
}
__device__ __forceinline__ void phase_conv(LAS unsigned char* lds_, const Args& a, int l) {
    const Frame F = frame_now(lds_);
    const bf16* U = (const bf16*)(a.ws + WS_Z); bf16* ACT = (bf16*)(a.ws + WS_ACT);
    const float* cw = a.conv_w + (size_t)l * 3 * NUP; const float* cb = a.conv_b + (size_t)l * NUP;
    constexpr int NCG = DFF / 8, STRIP = 32, NS = NTOK / STRIP;
    for (int it = F.bid * 512 + F.tid; it < NCG * NS; it += F.G * 512) {
        const int cg = it % NCG, st = it / NCG, c = cg * 8, r0 = st * STRIP; const int T = r0 < NCTX ? TC : TL;
        float wg[3][8], wv[3][8], bgv[8], bvv[8];
#pragma unroll
        for (int k = 0; k < 3; ++k) { const f32x4 a0 = *(const f32x4*)(cw + k * NUP + c), a1 = *(const f32x4*)(cw + k * NUP + c + 4), b0 = *(const f32x4*)(cw + k * NUP + DFF + c), b1 = *(const f32x4*)(cw + k * NUP + DFF + c + 4);
#pragma unroll
            for (int j = 0; j < 4; ++j) { wg[k][j] = a0[j]; wg[k][4 + j] = a1[j]; wv[k][j] = b0[j]; wv[k][4 + j] = b1[j]; } }
        { const f32x4 a0 = *(const f32x4*)(cb + c), a1 = *(const f32x4*)(cb + c + 4), b0 = *(const f32x4*)(cb + DFF + c), b1 = *(const f32x4*)(cb + DFF + c + 4);
#pragma unroll
          for (int j = 0; j < 4; ++j) { bgv[j] = a0[j]; bgv[4 + j] = a1[j]; bvv[j] = b0[j]; bvv[4 + j] = b1[j]; } }
        const u32x4 zero = {0u, 0u, 0u, 0u};
        u32x4 gp = zero, vp = zero, gc, vc;
        if ((r0 & (T - 1)) != 0) { gp = *(const u32x4*)(U + (size_t)(r0 - 1) * NUP + c); vp = *(const u32x4*)(U + (size_t)(r0 - 1) * NUP + DFF + c); }
        gc = *(const u32x4*)(U + (size_t)r0 * NUP + c); vc = *(const u32x4*)(U + (size_t)r0 * NUP + DFF + c);
        for (int i = 0; i < STRIP; i += 4) {
            u32x4 gnx[4], vnx[4];
#pragma unroll
            for (int e = 0; e < 4; ++e) { const int rn = r0 + i + e + 1;
                if ((rn & (T - 1)) != 0) { gnx[e] = *(const u32x4*)(U + (size_t)rn * NUP + c); vnx[e] = *(const u32x4*)(U + (size_t)rn * NUP + DFF + c); } else { gnx[e] = zero; vnx[e] = zero; } }
#pragma unroll
            for (int e = 0; e < 4; ++e) { const int r = r0 + i + e; const u32x4 gn = gnx[e], vn = vnx[e];
                float o[8];
#pragma unroll
                for (int q = 0; q < 4; ++q) {
                    const float g0 = wg[0][2 * q] * lo_act(gp[q]) + wg[1][2 * q] * lo_act(gc[q]) + wg[2][2 * q] * lo_act(gn[q]) + bgv[2 * q];
                    const float g1 = wg[0][2 * q + 1] * hi_act(gp[q]) + wg[1][2 * q + 1] * hi_act(gc[q]) + wg[2][2 * q + 1] * hi_act(gn[q]) + bgv[2 * q + 1];
                    const float v0 = wv[0][2 * q] * lo_act(vp[q]) + wv[1][2 * q] * lo_act(vc[q]) + wv[2][2 * q] * lo_act(vn[q]) + bvv[2 * q];
                    const float v1 = wv[0][2 * q + 1] * hi_act(vp[q]) + wv[1][2 * q + 1] * hi_act(vc[q]) + wv[2][2 * q + 1] * hi_act(vn[q]) + bvv[2 * q + 1];
                    o[2 * q] = siluf_(g0) * v0; o[2 * q + 1] = siluf_(g1) * v1; }
                *(u32x4*)(ACT + (size_t)r * DFF + c) = (u32x4){pk_act(o[0], o[1]), pk_act(o[2], o[3]), pk_act(o[4], o[5]), pk_act(o[6], o[7])};
                gp = gc; vp = vc; gc = gn; vc = vn; }
        }
    }
}

#ifdef MK_PROBE
constexpr size_t WS_DIAG = WS_END;
__device__ __forceinline__ void diag_max(float* slot, float v) { atomicMax((unsigned*)slot, __builtin_bit_cast(unsigned, fabsf(v))); }
__global__ void k_probe_zero(float* diag) { if (threadIdx.x < 4) diag[threadIdx.x] = 0.f; }
__global__ void k_probe_fill(float* out, const float* diag) {
    for (size_t i = (size_t)blockIdx.x * blockDim.x + threadIdx.x; i < OUT_END; i += (size_t)gridDim.x * blockDim.x) out[i] = 0.f;
    __syncthreads();
    if (blockIdx.x == 0 && threadIdx.x == 0) out[0] = 1e6f * diag[0] / fmaxf(diag[1], 1e-20f);
}
__global__ void k_probe_fill2(float* out, const float* diag) { if (blockIdx.x == 0 && threadIdx.x == 0) out[0] = 1e6f * diag[0] / fmaxf(diag[1], 1e-20f); }
__global__ void k_probe_z(Args a) {
    const bf16* H = (const bf16*)(a.ws + WS_H); const bf16* W = (const bf16*)(a.ws + WS_WIN); const bf16* Z = (const bf16*)(a.ws + WS_Z); float* diag = (float*)(a.ws + WS_DIAG);
    const unsigned id = blockIdx.x * blockDim.x + threadIdx.x; const unsigned hsh = id * 2654435761u + 12345u;
    const int r = (hsh >> 8) % NTOK, c = (hsh * 40503u >> 7) % NZ;
    float s = 0.f; for (int k = 0; k < DM; ++k) s += act2f(H[(size_t)r * DM + k]) * act2f(W[(size_t)c * DM + k]);
    const float z = act2f(Z[(size_t)r * NZ + c]); diag_max(diag, z - s); diag_max(diag + 1, s);
}
__global__ void k_probe_wt(Args a, int l) {
    const bf16* W = (const bf16*)(a.ws + WS_WIN + (size_t)l * SZ_WIN); float* diag = (float*)(a.ws + WS_DIAG);
    for (size_t i = (size_t)blockIdx.x * blockDim.x + threadIdx.x; i < (size_t)N_IN * DM; i += (size_t)gridDim.x * blockDim.x) {
        const int n = (int)(i / DM), k = (int)(i % DM); const int row = n >= ZPAD ? n + (ZGATE - ZPAD) : n;
        const float ref = act2f(f2act(a.w_in[((size_t)l * DM + k) * N_IN + n])); diag_max(diag, act2f(W[(size_t)row * DM + k]) - ref); diag_max(diag + 1, ref); }
}
__global__ void k_probe_gla(Args a) {
    __shared__ float red[4];
    const bf16* Z = (const bf16*)(a.ws + WS_Z); float* diag = (float*)(a.ws + WS_DIAG);
    const int l = 0, blk = blockIdx.x, b = blk & 15, h = (blk >> 4) & 3, dir = (blk >> 6) & 1, dv0 = ((blk >> 7) * 52 + 3) & 252;
    const int d = threadIdx.x & 127, dvi = threadIdx.x >> 7, dv = dv0 + dvi, T = TC, tokbase = b * TC;
    const float* wg = (dir ? a.w_gate_b : a.w_gate_f) + (size_t)l * 16 * 512 + h * 128; const float* bg = (dir ? a.b_gate_b : a.b_gate_f) + (size_t)l * 512 + h * 128;
    const float* OUT = (const float*)(a.ws + (dir ? WS_OB : WS_OF));
    float S = 0.f;
    for (int i = 0; i < T; ++i) { const int t = dir ? T - 1 - i : i; const bf16* zr = Z + (size_t)(tokbase + t) * NZ;
        float x = bg[d]; for (int r = 0; r < 16; ++r) x += act2f(zr[(dir ? ZGAB : ZGAF) + r]) * wg[r * 512 + d];
        const float la = (fminf(x, 0.f) - logf(1.f + expf(-fabsf(x)))) * 0.0625f;
        S = expf(la) * S + act2f(zr[ZGK + h * 128 + d]) * act2f(zr[ZGV + h * 256 + dv]);
        if (threadIdx.x < 4) red[threadIdx.x] = 0.f;
        __syncthreads();
        atomicAdd(&red[dvi], act2f(zr[ZGQ + h * 128 + d]) * 0.088388347648318440f * S);
        __syncthreads();
        if (d == 0) { const float o = OUT[(size_t)(tokbase + t) * 1024 + h * 256 + dv]; diag_max(diag, o - red[dvi]); diag_max(diag + 1, red[dvi]); }
        __syncthreads(); }
    const float sref = S, sgot = a.out[(dir ? OUT_SB : OUT_SF) + (((size_t)(b * DEPTH + l) * 4 + h) * 128 + d) * 256 + dv];
    diag_max(diag + 2, sgot - sref); diag_max(diag + 3, sref);
}

__global__ void k_probe_h(Args a) {
    const bf16* H = (const bf16*)(a.ws + WS_H); float* diag = (float*)(a.ws + WS_DIAG);
    const unsigned id = blockIdx.x * blockDim.x + threadIdx.x; const unsigned hsh = id * 2654435761u + 777u;
    const int r = (hsh >> 8) % NTOK, c = (hsh * 40503u >> 7) % DM, j = mod_row(r);
    const float* xr = r < NCTX ? a.x_prompt + (size_t)r * DM : a.x_sample + (size_t)(r - NCTX) * DM;
    float ss = 0.f, sh = a.b_ada[c], sc = a.b_ada[DM + c];
    for (int k = 0; k < DM; ++k) { ss += xr[k] * xr[k]; const float cv = j == 0 ? a.c_ctx[k] : a.cvec[(j - 1) * DM + k]; const float sl = cv / (1.f + expf(-cv));
        sh += sl * a.w_ada[(size_t)k * NMOD + c]; sc += sl * a.w_ada[(size_t)k * NMOD + DM + c]; }
    const float ref = xr[c] * (1.f / sqrtf(ss / DM + EPS)) * a.norm1[c] * (1.f + sc) + sh;
    diag_max(diag, act2f(H[(size_t)r * DM + c]) - ref); diag_max(diag + 1, ref);
}

__global__ void k_probe_mod(Args a, int l) {
    const float* MOD = (const float*)(a.ws + WS_MOD) + (size_t)l * NMODV * NMOD; float* diag = (float*)(a.ws + WS_DIAG);
    const unsigned id = blockIdx.x * blockDim.x + threadIdx.x; const int j = id % NMODV, n = (int)(((id / NMODV) * 2654435761u >> 8) % NMOD);
    float s = a.b_ada[(size_t)l * NMOD + n];
    for (int k = 0; k < DM; ++k) { const float cv = j == 0 ? a.c_ctx[k] : a.cvec[(j - 1) * DM + k]; s += cv / (1.f + expf(-cv)) * a.w_ada[((size_t)l * DM + k) * NMOD + n]; }
    diag_max(diag, MOD[(size_t)j * NMOD + n] - s); diag_max(diag + 1, s);
}
#endif

constexpr int STEPS_PER_LAYER = 11, STEP_L0 = 2, STEP_FINAL = STEP_L0 + DEPTH * STEPS_PER_LAYER, N_STEPS = STEP_FINAL + 1;
#ifndef MK_PH_MASK
#define MK_PH_MASK 0xFFFFFFFFu
#endif
#define EN(k) (((MK_PH_MASK) >> (k)) & 1u)
#ifndef MK_REP_MASK
#define MK_REP_MASK 0u
#endif
#define REP(k) (((MK_REP_MASK) >> (k)) & 1u)
#ifndef MK_SP2
#define MK_SP2 true
#endif
#ifndef MK_ALIGN
#define MK_ALIGN true
#endif
__global__ void __launch_bounds__(NWAVES * 64, 2) mk_fwd(Args a) {
    extern __shared__ __attribute__((aligned(16))) unsigned char lds_raw[];
    LAS unsigned char* const lds = (LAS unsigned char*)lds_raw;
    volatile LAS unsigned* MISC = (volatile LAS unsigned*)(lds + MISC_OFF);
    if (threadIdx.x < 64) MISC[threadIdx.x] = 0u;
    __syncthreads();
    unsigned* barw = (unsigned*)(a.ws + WS_CTL) + CW_BAR + a.li * XCD_BAR_WORDS;
    XcdBarrier bar = xcd_barrier_post(barw, MISC + 8);
    const int lo = a.s_lo, hi = a.s_hi;
#define IN(s) (lo <= (s) && (s) < hi)
#define SEAM(s) do { if (IN(s) && IN((s) + 1)) xcd_barrier(bar); else __syncthreads(); } while (0)
    unsigned char* ws = a.ws;
    const int G = gridDim.x, bid = blockIdx.x;

    if (EN(13) && IN(0)) { phase_prologue_a(lds, a); if (REP(13)) { xcd_barrier(bar); phase_prologue_a(lds, a); } SEAM(0); }
    if (EN(14) && IN(1)) {
        phase_mod_reduce(lds, a);
        pg8::Gemm g{(const bf16*)(ws + WS_WFT), (const bf16*)(ws + WS_DT), DEPTH * DM, 2048, 1024}; pg8::StaticOrder S; S.init(g.M, g.N, G, bid);
        pg8::EpiStoreBf16 E{(bf16*)(ws + WS_WMRG), KMRG};
        pg8::gemm_phase<pg8::EpiStoreBf16, pg8::StaticOrder, MK_ALIGN, MK_SP2>(lds, g, S, E);
        SEAM(1);
    }
    for (int l = 0; l < DEPTH; ++l) {
        const int sb = STEP_L0 + l * STEPS_PER_LAYER;
        if (hi <= sb || lo >= sb + STEPS_PER_LAYER) continue;
        const float* MODL = (const float*)(ws + WS_MOD) + (size_t)l * NMODV * NMOD;
        if (EN(0) && IN(sb + 0)) { phase_norm(lds, a, l, 0, l == 0); if (REP(0)) { xcd_barrier(bar); phase_norm(lds, a, l, 0, l == 0); } SEAM(sb + 0); }
        if (EN(1) && IN(sb + 1)) {
            pg8::Gemm g{(const bf16*)(ws + WS_H), (const bf16*)(ws + WS_WIN + l * SZ_WIN), NTOK, NZ, DM}; pg8::StaticOrder S; S.init(g.M, g.N, G, bid);
            pg8::EpiStoreZ E{(bf16*)(ws + WS_Z), NZ, ZGATE / 256};
            pg8::gemm_phase<pg8::EpiStoreZ, pg8::StaticOrder, MK_ALIGN, MK_SP2>(lds, g, S, E);
#ifdef MK_REP_Z
            xcd_barrier(bar); pg8::gemm_phase<pg8::EpiStoreZ, pg8::StaticOrder, MK_ALIGN, MK_SP2>(lds, g, S, E);
#endif
            SEAM(sb + 1);
        }
        if (EN(2) && IN(sb + 2)) { phase_gla_g1(lds, a, l); phase_prep(lds, a, l); if (REP(2)) { xcd_barrier(bar); phase_gla_g1(lds, a, l); phase_prep(lds, a, l); } SEAM(sb + 2); }
        if (EN(3) && IN(sb + 3)) {
            if (G >= 256 && bid >= G / 2) phase_gla_g2(lds, a, l);
            phase_attn(lds, a, l);
            { pg8::Gemm g{(const bf16*)(ws + WS_ALAT), (const bf16*)(ws + WS_XT) + (size_t)16384 * 256, 2048, 4096, 1024}; pg8::StaticOrder S; S.init(g.M, g.N, G, bid);
              pg8::EpiDft E{(bf16*)(ws + WS_AM), 10, NCTX};
              pg8::gemm_phase<pg8::EpiDft, pg8::StaticOrder, MK_ALIGN, MK_SP2>(lds, g, S, E); }
            { pg8::Gemm g{(const bf16*)(ws + WS_ACTX), (const bf16*)(ws + WS_XT), 512, 16384, 256}; pg8::StaticOrder S; S.init(g.M, g.N, G, bid);
              pg8::EpiDft E{(bf16*)(ws + WS_AM), 8, 0};
              pg8::gemm_phase<pg8::EpiDft, pg8::StaticOrder, MK_ALIGN, MK_SP2>(lds, g, S, E); }
            if (G < 256) phase_gla_g2(lds, a, l);
            SEAM(sb + 3);
        }
        if (EN(6) && IN(sb + 4)) { phase_gla_fin(lds, a, l); if (REP(6)) { xcd_barrier(bar); phase_gla_fin(lds, a, l); } SEAM(sb + 4); }
        if (EN(7) && IN(sb + 5)) {
            pg8::Gemm g{(const bf16*)(ws + WS_AM), (const bf16*)(ws + WS_WMRG + l * SZ_WMRG), NTOK, DM, KMRG}; pg8::StaticOrder S; S.init(g.M, g.N, G, bid);
            pg8::EpiMerged E{(bf16*)(ws + WS_MG), (const bf16*)(ws + WS_Z)};
            pg8::gemm_phase<pg8::EpiMerged, pg8::StaticOrder, MK_ALIGN, MK_SP2>(lds, g, S, E);
#if (MK_REP_MASK >> 7) & 1
            xcd_barrier(bar);
            {

            pg8::Gemm g{(const bf16*)(ws + WS_AM), (const bf16*)(ws + WS_WMRG + l * SZ_WMRG), NTOK, DM, KMRG}; pg8::StaticOrder S; S.init(g.M, g.N, G, bid);
            pg8::EpiMerged E{(bf16*)(ws + WS_MG), (const bf16*)(ws + WS_Z)};
            pg8::gemm_phase<pg8::EpiMerged, pg8::StaticOrder, MK_ALIGN, MK_SP2>(lds, g, S, E);
            }
#endif
                        SEAM(sb + 5);
        }
        if (EN(8) && IN(sb + 6)) {
            pg8::Gemm g{(const bf16*)(ws + WS_MG), (const bf16*)(ws + WS_WOUT + l * SZ_WOUT), NTOK, DM, DM}; pg8::StaticOrder S; S.init(g.M, g.N, G, bid);
            pg8::EpiResid E{(float*)(ws + WS_X), MODL + 2 * DM};
            pg8::gemm_phase<pg8::EpiResid, pg8::StaticOrder, MK_ALIGN, MK_SP2>(lds, g, S, E);
#if (MK_REP_MASK >> 8) & 1
            xcd_barrier(bar);
            {

            pg8::Gemm g{(const bf16*)(ws + WS_MG), (const bf16*)(ws + WS_WOUT + l * SZ_WOUT), NTOK, DM, DM}; pg8::StaticOrder S; S.init(g.M, g.N, G, bid);
            pg8::EpiResid E{(float*)(ws + WS_X), (const float*)(ws + WS_CTL + 512 * 1024)};
            pg8::gemm_phase<pg8::EpiResid, pg8::StaticOrder, MK_ALIGN, MK_SP2>(lds, g, S, E);
            }
#endif
            SEAM(sb + 6);
        }
        if (EN(9) && IN(sb + 7)) { phase_norm(lds, a, l, 1, false); if (REP(9)) { xcd_barrier(bar); phase_norm(lds, a, l, 1, false); } SEAM(sb + 7); }
        if (EN(10) && IN(sb + 8)) {
            pg8::Gemm g{(const bf16*)(ws + WS_H), (const bf16*)(ws + WS_WUP + l * SZ_WUP), NTOK, NUP, DM}; pg8::StaticOrder S; S.init(g.M, g.N, G, bid);
            pg8::EpiStoreBf16 E{(bf16*)(ws + WS_Z), NUP};
            pg8::gemm_phase<pg8::EpiStoreBf16, pg8::StaticOrder, MK_ALIGN, MK_SP2>(lds, g, S, E);
#if (MK_REP_MASK >> 10) & 1
            xcd_barrier(bar);
            {

            pg8::Gemm g{(const bf16*)(ws + WS_H), (const bf16*)(ws + WS_WUP + l * SZ_WUP), NTOK, NUP, DM}; pg8::StaticOrder S; S.init(g.M, g.N, G, bid);
            pg8::EpiStoreBf16 E{(bf16*)(ws + WS_Z), NUP};
            pg8::gemm_phase<pg8::EpiStoreBf16, pg8::StaticOrder, MK_ALIGN, MK_SP2>(lds, g, S, E);
            }
#endif
                        SEAM(sb + 8);
        }
        if (EN(11) && IN(sb + 9)) { phase_conv(lds, a, l); if (REP(11)) { xcd_barrier(bar); phase_conv(lds, a, l); } SEAM(sb + 9); }
        if (EN(12) && IN(sb + 10)) {
            pg8::Gemm g{(const bf16*)(ws + WS_ACT), (const bf16*)(ws + WS_WDN + l * SZ_WDN), NTOK, DM, DFF}; pg8::StaticOrder S; S.init(g.M, g.N, G, bid);
            pg8::EpiResid E{(float*)(ws + WS_X), MODL + 5 * DM};
            pg8::gemm_phase<pg8::EpiResid, pg8::StaticOrder, MK_ALIGN, MK_SP2>(lds, g, S, E);
#if (MK_REP_MASK >> 12) & 1
            xcd_barrier(bar);
            {

            pg8::Gemm g{(const bf16*)(ws + WS_ACT), (const bf16*)(ws + WS_WDN + l * SZ_WDN), NTOK, DM, DFF}; pg8::StaticOrder S; S.init(g.M, g.N, G, bid);
            pg8::EpiResid E{(float*)(ws + WS_X), (const float*)(ws + WS_CTL + 512 * 1024)};
            pg8::gemm_phase<pg8::EpiResid, pg8::StaticOrder, MK_ALIGN, MK_SP2>(lds, g, S, E);
            }
#endif
            SEAM(sb + 10);
        }
    }
    if (EN(15) && IN(STEP_FINAL)) phase_final_norm(lds, a);
#undef IN
#undef SEAM
}

#ifndef MK_LAUNCH_MODE
#define MK_LAUNCH_MODE 0
#endif
extern "C" void kernel_launch(void* const* d_in, const int* in_sizes, int n_in, void* d_out, int out_size, void* d_ws, size_t ws_size, hipStream_t stream) {
    static int grid = 0;
    if (grid == 0) {
        if (n_in != 29 || (size_t)out_size != OUT_END || ws_size < WS_END + 4096) { fprintf(stderr, "kernel_launch: unexpected shapes: n_in %d out %d ws %zu (need %zu)\n", n_in, out_size, ws_size, (size_t)WS_END); grid = -1; return; }
        int dev = 0, cus = 0;
        if (hipGetDevice(&dev) != hipSuccess || hipDeviceGetAttribute(&cus, hipDeviceAttributeMultiprocessorCount, dev) != hipSuccess) { grid = -1; return; }
        if (hipFuncSetAttribute((const void*)mk_fwd, hipFuncAttributeMaxDynamicSharedMemorySize, LDS_BYTES) != hipSuccess) { fprintf(stderr, "kernel_launch: hipFuncSetAttribute failed\n"); grid = -1; return; }
        int per_cu = 0;
        if (hipOccupancyMaxActiveBlocksPerMultiprocessor(&per_cu, (const void*)mk_fwd, NWAVES * 64, LDS_BYTES) != hipSuccess || per_cu < 1) { fprintf(stderr, "kernel_launch: occupancy query says %d\n", per_cu); }
        (void)hipGetLastError();
        grid = cus;
    }
    if (grid < 0) return;
    (void)hipMemsetAsync((char*)d_ws + WS_CTL, 0, CTL_ZERO_BYTES, stream);
    Args a{};
    const float** p = (const float**)&a;
    for (int i = 0; i < 29; ++i) p[i] = (const float*)d_in[i];
    a.out = (float*)d_out; a.ws = (unsigned char*)d_ws; a.pad = 0;
#ifdef MK_PROBE
    {
        constexpr int PROBE_STEPS = (MK_PROBE == 2) ? 1 : (MK_PROBE == 1) ? STEP_L0 + 2 : (MK_PROBE == 4) ? STEP_L0 + 1 : (MK_PROBE == 5) ? 2 : STEP_L0 + 6;
        float* diag = (float*)((char*)d_ws + WS_DIAG);
        for (int s = 0; s < PROBE_STEPS; ++s) { a.s_lo = s; a.s_hi = s + 1; a.li = s; hipLaunchKernelGGL(mk_fwd, dim3(grid), dim3(NWAVES * 64), LDS_BYTES, stream, a); }
        hipLaunchKernelGGL(k_probe_zero, dim3(1), dim3(64), 0, stream, diag);
        if (MK_PROBE == 1) hipLaunchKernelGGL(k_probe_z, dim3(128), dim3(512), 0, stream, a);
        if (MK_PROBE == 2) hipLaunchKernelGGL(k_probe_wt, dim3(1024), dim3(256), 0, stream, a, MK_PROBE_L);
        if (MK_PROBE == 4) hipLaunchKernelGGL(k_probe_h, dim3(32), dim3(512), 0, stream, a);
        if (MK_PROBE == 5) hipLaunchKernelGGL(k_probe_mod, dim3(40), dim3(512), 0, stream, a, MK_PROBE_L);
        if (MK_PROBE == 3) hipLaunchKernelGGL(k_probe_gla, dim3(512), dim3(512), 0, stream, a);
        hipLaunchKernelGGL(k_probe_fill, dim3(1024), dim3(256), 0, stream, (float*)d_out, (const float*)(diag + 2 * MK_PROBE_SEL));
        hipLaunchKernelGGL(k_probe_fill2, dim3(1), dim3(64), 0, stream, (float*)d_out, (const float*)(diag + 2 * MK_PROBE_SEL));
        return;
    }
#endif
#if MK_LAUNCH_MODE == 1
    a.s_lo = 0; a.s_hi = N_STEPS; a.li = 0;
    hipLaunchKernelGGL(mk_fwd, dim3(grid), dim3(NWAVES * 64), LDS_BYTES, stream, a);
#else
    for (int s = 0; s < N_STEPS; ++s) { a.s_lo = s; a.s_hi = s + 1; a.li = s;
        hipLaunchKernelGGL(mk_fwd, dim3(grid), dim3(NWAVES * 64), LDS_BYTES, stream, a); }
#endif
}
```
